# Optimizing an MI355X kernel written in HIP

```python
import math
import jax, jax.numpy as jnp
from jax import lax
import numpy as np

D_MODEL = 1024
BATCH = 8
SEQ = 4096
DEPTH = 4
DEC_BATCH = 32
DEC_SEQ = 16
PAST_LEN = 1024

CHUNK = 64
Q_BLOCK = 128
D_POOL = D_MODEL // 2
POOL_WINDOWS = (2, 4, 8, 16)
N_POOL_GROUPS = 4
POOL_GROUP = D_POOL // N_POOL_GROUPS
POOL_HIST = max(POOL_WINDOWS) - 1
N_HEADS = 8
HEAD_DIM = 64
QK_DIM = 2 * HEAD_DIM
V_DIM = 2 * HEAD_DIM
Q_WIDTH = N_HEADS * QK_DIM
D_ATT = N_HEADS * V_DIM
ROPE_THETA = 10000.0
LN_EPS = 1e-5
RMS_EPS = 1e-5
ALPHA = (2 * DEPTH) ** 0.25
BETA = (8 * DEPTH) ** -0.25
IN_WIDTHS = (D_POOL, D_POOL, Q_WIDTH, Q_WIDTH, D_ATT, D_ATT, D_MODEL, D_MODEL)
IN_SPLITS = tuple(int(s) for s in np.cumsum(IN_WIDTHS)[:-1])
D_IN = sum(IN_WIDTHS)

kernel_name = "pool_diffattn_deepnorm_stream_step"


def layer_norm(x, g, b):
    xf = x.astype(jnp.float32)
    mu = jnp.mean(xf, -1, keepdims=True)
    var = jnp.mean(jnp.square(xf - mu), -1, keepdims=True)
    y = (xf - mu) * lax.rsqrt(var + LN_EPS) * g.astype(jnp.float32) + b.astype(jnp.float32)
    return y.astype(x.dtype)


def rope(x, pos):
    half = HEAD_DIM // 2
    inv = ROPE_THETA ** (-jnp.arange(half, dtype=jnp.float32) / half)
    ang = pos.astype(jnp.float32)[:, None] * inv[None, :]
    shp = (ang.shape[0],) + (1,) * (x.ndim - 3) + (half,)
    cos = jnp.cos(ang).reshape(shp)
    sin = jnp.sin(ang).reshape(shp)
    xf = x.astype(jnp.float32)
    x1, x2 = xf[..., :half], xf[..., half:]
    return jnp.concatenate([x1 * cos - x2 * sin, x2 * cos + x1 * sin], -1).astype(x.dtype)


def pool_mix(u, hist, pos, w_pool, pool_scale):
    T = u.shape[1]
    ext = jnp.concatenate([hist.astype(u.dtype), u], 1)
    ef = ext.astype(jnp.float32)
    cs = jnp.concatenate([jnp.zeros_like(ef[:, :1]), lax.cumsum(ef, axis=1)], 1)
    uf = u.astype(jnp.float32)
    outs = []
    for g, w in enumerate(POOL_WINDOWS):
        sl = slice(g * POOL_GROUP, (g + 1) * POOL_GROUP)
        s = cs[:, POOL_HIST + 1:POOL_HIST + 1 + T, sl] - cs[:, POOL_HIST + 1 - w:POOL_HIST + 1 - w + T, sl]
        cnt = jnp.minimum(pos + 1, w).astype(jnp.float32)[None, :, None]
        pooled = (s / cnt - uf[..., sl]).astype(u.dtype)
        outs.append(jnp.einsum('btc,cd->btd', pooled, w_pool[g]))
    y = jnp.concatenate(outs, -1) * pool_scale
    return y, ext[:, -POOL_HIST:]


def diff_attend(q, k, v, lam, mask):
    s = jnp.einsum('bqhmd,bkhmd->bhmqk', q, k).astype(jnp.float32) * (HEAD_DIM ** -0.5)
    if mask is not None:
        s = jnp.where(mask, s, -jnp.inf)
    p = jax.nn.softmax(s, axis=-1)
    a = p[:, :, 0] - lam * p[:, :, 1]
    return jnp.einsum('bhqk,bkhv->bqhv', a.astype(v.dtype), v)


def prompt_diff_attention(q, k, v, lam):
    B, T = q.shape[0], q.shape[1]
    nb = T // Q_BLOCK
    qb = q.reshape(B, nb, Q_BLOCK, N_HEADS, 2, HEAD_DIM).transpose(1, 0, 2, 3, 4, 5)
    k_chunk = jnp.arange(T) // CHUNK

    def block(args):
        qi, i = args
        q_chunk = (i * Q_BLOCK + jnp.arange(Q_BLOCK)) // CHUNK
        mask = k_chunk[None, :] <= q_chunk[:, None]
        return diff_attend(qi, k, v, lam, mask)

    o = lax.map(block, (qb, jnp.arange(nb)))
    return o.transpose(1, 0, 2, 3, 4).reshape(B, T, N_HEADS, V_DIM)


def trunk_layer(x, pos, pool_hist, k_past, v_past, w_in, w_pool, pool_scale, lambda_qk,
                subln_w, w_a, w_b, w_o, ln_g, ln_b, layer_idx):
    B, T, _ = x.shape
    lam_init = 0.8 - 0.6 * math.exp(-0.3 * layer_idx)
    lq = lambda_qk.astype(jnp.float32)
    lam = jnp.exp(jnp.sum(lq[0] * lq[1])) - jnp.exp(jnp.sum(lq[2] * lq[3])) + lam_init

    h = jnp.einsum('btd,de->bte', x, w_in)
    px, pg, q, k, v, ag, ga, gb = jnp.split(h, IN_SPLITS, axis=-1)

    ya, new_hist = pool_mix(px, pool_hist, pos, w_pool, pool_scale)
    ya = ya * jax.nn.silu(pg)

    q = rope(q.reshape(B, T, N_HEADS, 2, HEAD_DIM), pos)
    k = rope(k.reshape(B, T, N_HEADS, 2, HEAD_DIM), pos)
    v = v.reshape(B, T, N_HEADS, V_DIM)
    if k_past is None:
        o = prompt_diff_attention(q, k, v, lam)
    else:
        P = k_past.shape[1]
        kc = jnp.concatenate([k_past.reshape(B, P, N_HEADS, 2, HEAD_DIM).astype(k.dtype), k], 1)
        vc = jnp.concatenate([v_past.astype(v.dtype), v], 1)
        o = diff_attend(q, kc, vc, lam, None)
    of = o.astype(jnp.float32)
    of = of * lax.rsqrt(jnp.mean(jnp.square(of), -1, keepdims=True) + RMS_EPS)
    of = of * subln_w.astype(jnp.float32) * (1.0 - lam_init)
    yb = of.astype(x.dtype).reshape(B, T, D_ATT) * jax.nn.silu(ag)

    merged = (jax.nn.sigmoid(ga) * jnp.einsum('btc,cd->btd', ya, w_a)
              + jax.nn.sigmoid(gb) * jnp.einsum('btc,cd->btd', yb, w_b))
    out = jnp.einsum('btd,de->bte', merged, w_o)
    x_new = layer_norm(ALPHA * x + out, ln_g, ln_b)
    return x_new, k.reshape(B, T, N_HEADS, QK_DIM), v, new_hist


def setup_inputs(seed: int = 0) -> dict:
    key = jax.random.key(seed)
    ks = jax.random.split(key, 20)
    f32 = jnp.float32
    nrm = lambda k, shp: jax.random.normal(k, shp, f32)
    return {
        'x_prompt': nrm(ks[0], (BATCH, SEQ, D_MODEL)),
        'x_sample': nrm(ks[1], (DEC_BATCH, DEC_SEQ, D_MODEL)),
        'cache_k': nrm(ks[2], (DEPTH, DEC_BATCH, PAST_LEN, N_HEADS, QK_DIM)),
        'cache_v': nrm(ks[3], (DEPTH, DEC_BATCH, PAST_LEN, N_HEADS, V_DIM)),
        'state_pool': nrm(ks[4], (DEPTH, DEC_BATCH, POOL_HIST, D_POOL)),
        'ln_in_g': 1.0 + 0.02 * nrm(ks[5], (D_MODEL,)),
        'ln_in_b': 0.02 * nrm(ks[6], (D_MODEL,)),
        'w_in': nrm(ks[7], (DEPTH, D_MODEL, D_IN)) * D_MODEL ** -0.5,
        'w_pool': nrm(ks[8], (DEPTH, N_POOL_GROUPS, POOL_GROUP, POOL_GROUP)) * POOL_GROUP ** -0.5,
        'pool_scale': 1.0 + 0.02 * nrm(ks[9], (DEPTH, D_POOL)),
        'lambda_qk': 0.1 * nrm(ks[10], (DEPTH, 4, HEAD_DIM)),
        'subln_w': 1.0 + 0.02 * nrm(ks[11], (DEPTH, V_DIM)),
        'w_a': nrm(ks[12], (DEPTH, D_POOL, D_MODEL)) * (D_POOL ** -0.5) * BETA,
        'w_b': nrm(ks[13], (DEPTH, D_ATT, D_MODEL)) * (D_ATT ** -0.5) * BETA,
        'w_o': nrm(ks[14], (DEPTH, D_MODEL, D_MODEL)) * (D_MODEL ** -0.5) * BETA,
        'ln_g': 1.0 + 0.02 * nrm(ks[15], (DEPTH, D_MODEL)),
        'ln_b': 0.02 * nrm(ks[16], (DEPTH, D_MODEL)),
    }


def reference(x_prompt, x_sample, cache_k, cache_v, state_pool, ln_in_g, ln_in_b, w_in, w_pool,
              pool_scale, lambda_qk, subln_w, w_a, w_b, w_o, ln_g, ln_b):
    xp = layer_norm(x_prompt, ln_in_g, ln_in_b)
    xs = layer_norm(x_sample, ln_in_g, ln_in_b)
    pos_p = jnp.arange(x_prompt.shape[1])
    pos_s = cache_k.shape[2] + jnp.arange(x_sample.shape[1])
    hist_p = jnp.zeros((x_prompt.shape[0], POOL_HIST, D_POOL), x_prompt.dtype)
    kp_l, vp_l, hp_l, ks_l, vs_l, hs_l = [], [], [], [], [], []
    for l in range(DEPTH):
        xp, kp, vp, hp = trunk_layer(xp, pos_p, hist_p, None, None, w_in[l], w_pool[l],
                                     pool_scale[l], lambda_qk[l], subln_w[l], w_a[l], w_b[l],
                                     w_o[l], ln_g[l], ln_b[l], l)
        xs, ks, vs, hs = trunk_layer(xs, pos_s, state_pool[l], cache_k[l], cache_v[l], w_in[l],
                                     w_pool[l], pool_scale[l], lambda_qk[l], subln_w[l], w_a[l],
                                     w_b[l], w_o[l], ln_g[l], ln_b[l], l)
        kp_l.append(kp); vp_l.append(vp); hp_l.append(hp)
        ks_l.append(ks); vs_l.append(vs); hs_l.append(hs)
    return (xp, xs, jnp.stack(kp_l), jnp.stack(vp_l), jnp.stack(hp_l),
            jnp.stack(ks_l), jnp.stack(vs_l), jnp.stack(hs_l))
```

```cpp
#include <hip/hip_runtime.h>
#include <hip/hip_bf16.h>
#include <cstdio>
#include <cstdint>
#include <cmath>

#ifndef DEBUG_CHECK
#define DEBUG_CHECK 0
#endif

constexpr int D_MODEL = 1024, BATCH = 8, SEQ = 4096, DEPTH = 4, DEC_BATCH = 32, DEC_SEQ = 16, PAST = 1024;
constexpr int D_POOL = 512, D_IN = 7168;
constexpr int MP = BATCH * SEQ, MS = DEC_BATCH * DEC_SEQ, M = MP + MS;
constexpr float LN_EPS = 1e-5f, RMS_EPS = 1e-5f;
constexpr float ALPHA = 1.681792830507429f;
constexpr float C2 = 0.125f * 1.4426950408889634f;
constexpr size_t O_Y = 0, O_KP = (size_t)M * 1024, O_VP = O_KP + (size_t)DEPTH * MP * 1024, O_PP = O_VP + (size_t)DEPTH * MP * 1024,
                 O_KS = O_PP + (size_t)DEPTH * BATCH * 15 * 512, O_VS = O_KS + (size_t)DEPTH * MS * 1024, O_PS = O_VS + (size_t)DEPTH * MS * 1024,
                 O_END = O_PS + (size_t)DEPTH * DEC_BATCH * 15 * 512;
constexpr size_t MiB = 1u << 20;
constexpr size_t RB2 = (size_t)M * 1024 * 2, RB4 = (size_t)M * 1024 * 4;
constexpr size_t WS_CTL = 0, CTL_ZERO_BYTES = 1 * MiB;
constexpr size_t WS_LAM = 1 * MiB;
constexpr size_t WS_ROPEC = 2 * MiB, WS_ROPES = WS_ROPEC + 512 * 1024;
constexpr size_t WS_WIN = 4 * MiB, WS_WA = 60 * MiB, WS_WB = 64 * MiB, WS_WO = 72 * MiB, WS_WP = 80 * MiB;
constexpr size_t WS_X = 96 * MiB;
constexpr size_t WS_XB = WS_X + RB4;
constexpr size_t WS_PXB = WS_XB + RB2;
constexpr size_t WS_SPG = WS_PXB + RB2 / 2;
constexpr size_t WS_QB = WS_SPG + RB2 / 2, WS_KB = WS_QB + RB2, WS_VB = WS_KB + RB2;
constexpr size_t WS_SAG = WS_VB + RB2, WS_SGA = WS_SAG + RB2, WS_SGB = WS_SGA + RB2;
constexpr size_t WS_O1 = WS_SGB + RB2, WS_O2 = WS_O1 + RB4;
constexpr size_t WS_YA = WS_O2 + RB4, WS_YB = WS_YA + RB2 / 2;
constexpr size_t WS_TMPA = WS_YB + RB2, WS_MG = WS_TMPA + RB4;
constexpr size_t WS_END = WS_MG + RB2;
static_assert(WS_END <= 1300 * MiB && WS_WP + 512 * 1024 <= WS_X && WS_WIN + (size_t)DEPTH * D_IN * 1024 * 2 <= WS_WA, "d_ws map");
constexpr int CW_BAR = 4096;
constexpr int RING_OFF = 0, RING_BYTES = 131072;
constexpr int LDSCTL_OFF = RING_BYTES, MISC_OFF = LDSCTL_OFF + 320;
constexpr int LDS_BYTES = 147456;
constexpr int NWAVES = 8;
namespace pg8 {
#define PG8_LAS __attribute__((address_space(3)))
typedef unsigned short bf16_t;
typedef short bf16x8 __attribute__((ext_vector_type(8)));
typedef float f32x4 __attribute__((ext_vector_type(4)));
typedef unsigned u32x4 __attribute__((ext_vector_type(4)));
constexpr int BM = 256, BK = 64, HALF = 128, HTB = HALF * BK * 2  , STAGE_BYTES = 8 * HTB, NXCD = 8, WGM = 8;

__host__ __device__ __forceinline__ int lds_byte(int r, int c) { const int st = (r >> 4) * 2 + (c >> 5), rr = r & 15, cc = c & 31, ob = rr * 64 + cc * 2; return st * 1024 + (ob ^ (((ob >> 9) & 1) << 5)); }
__host__ __device__ __forceinline__ void stage_rc(int b, int& R, int& C) { const int st = b / 1024, sb = b % 1024, swz = sb ^ (((sb >> 9) & 1) << 5); R = (st >> 1) * 16 + swz / 64; C = (st & 1) * 32 + (swz % 64) / 2; }
__host__ __device__ __forceinline__ int perm32(int rho) { const int n = rho >> 4, i = rho & 15; return 8 * (i >> 2) + 4 * n + (i & 3); }

struct Unit { int pm, pn; };
struct Gemm { const bf16_t* A; const bf16_t* Bt; int M, N, K; };

struct StaticOrder {
    int nM, nN, nwg, G, c;
    __host__ __device__ void init(int M, int N, int G_, int c_) { nM = M / BM; nN = N / BM; nwg = nM * nN; G = G_; c = c_; }
    __host__ __device__ bool next(int i, Unit& u) const {
        const long L = (long)i * G + c; if (L >= nwg) return false;
        int wgid = (int)L; { const int q = nwg / NXCD, r = nwg % NXCD, xcd = wgid % NXCD, off = wgid / NXCD; wgid = (xcd < r ? xcd * (q + 1) : r * (q + 1) + (xcd - r) * q) + off; }
        const int nig = WGM * nN, gid = wgid / nig, fm = gid * WGM, gsz = (nM - fm) < WGM ? (nM - fm) : WGM;
        u.pm = fm + ((wgid % nig) % gsz); u.pn = (wgid % nig) / gsz; return true;
    }
    __device__ __forceinline__ void a_ready(const Unit&) const {}
    __device__ __forceinline__ void done(const Unit&) const {}
};

__device__ __forceinline__ unsigned cvt_pk_bf16(float lo, float hi) { unsigned r; asm volatile("v_cvt_pk_bf16_f32 %0, %1, %2" : "=v"(r) : "v"(lo), "v"(hi)); return r; }
typedef float f32x2 __attribute__((ext_vector_type(2)));
template <class Epi, class Sched, bool ALIGN_EPI = false, bool SP2 = false>
__device__ __forceinline__ void gemm_phase(PG8_LAS unsigned char* lds, const Gemm g, const Sched& S, const Epi& E) {
    int tid_o = threadIdx.x; asm volatile("" : "+v"(tid_o));
    const int tid = tid_o, wid = __builtin_amdgcn_readfirstlane(tid >> 6), lane = tid & 63, wr = wid >> 2, wc = wid & 3, fr = lane & 15, fq = lane >> 4;
    const int K = g.K, nt = K / BK;
    unsigned voffA[2], voffB[2];
#pragma unroll
    for (int i = 0; i < 2; ++i) { int R, C; stage_rc(tid * 16 + i * 8192, R, C); const int Rb = Epi::PERM ? ((R & ~31) + perm32(R & 31)) : R;
        voffA[i] = (unsigned)(R * K + C) * 2u; voffB[i] = (unsigned)(Rb * K + C) * 2u; }
    const size_t kstep = (size_t)(BK * 2);
    const size_t hstep = (size_t)HALF * K * 2;
    const size_t tstep = 2 * hstep;
    const unsigned ldsw = (unsigned)wid * 1024u;
    const int aoff = lds_byte(wr * 64 + fr, fq * 8), boff = lds_byte(wc * 32 + fr, fq * 8);
#define PG8_SA(b, h) (((b) * 2 + (h)) * HTB)
#define PG8_SB(b, h) ((4 + (b) * 2 + (h)) * HTB)
#define PG8_STAGE(bufoff, gbase, voff) do { _Pragma("unroll") for (int _i = 0; _i < 2; ++_i) \
        __builtin_amdgcn_global_load_lds((const unsigned*)((const char*)(gbase) + (voff)[_i]), (PG8_LAS unsigned*)(lds + (bufoff) + ldsw + _i * 8192), 16, 0, 0); } while (0)
#define PG8_LDA(dst, b, h) do { _Pragma("unroll") for (int m = 0; m < 4; ++m) _Pragma("unroll") for (int k = 0; k < 2; ++k) dst[m][k] = *(const PG8_LAS bf16x8*)(lds + PG8_SA(b, h) + aoff + m * 2048 + k * 1024); } while (0)
#define PG8_LDB(dst, b, h) do { _Pragma("unroll") for (int n = 0; n < 2; ++n) _Pragma("unroll") for (int k = 0; k < 2; ++k) dst[n][k] = *(const PG8_LAS bf16x8*)(lds + PG8_SB(b, h) + boff + n * 2048 + k * 1024); } while (0)
#define PG8_MMA(ai, bj, At, Bt) do { __builtin_amdgcn_s_setprio(1); _Pragma("unroll") for (int m = 0; m < 4; ++m) _Pragma("unroll") for (int n = 0; n < 2; ++n) _Pragma("unroll") for (int k = 0; k < 2; ++k) \
        acc[ai][bj][m][n] = __builtin_amdgcn_mfma_f32_16x16x32_bf16(Bt[n][k], At[m][k], acc[ai][bj][m][n], 0, 0, 0); __builtin_amdgcn_s_setprio(0); } while (0)
#define PG8_WAIT_V(n) asm volatile("s_waitcnt vmcnt(" #n ")" ::: "memory")
#define PG8_WAIT_L(n) asm volatile("s_waitcnt lgkmcnt(" #n ")" ::: "memory")
#define PG8_BAR __builtin_amdgcn_s_barrier()
#define PG8_SCHED __builtin_amdgcn_sched_barrier(0)
    Unit cur, nxt; int ui = 0;
    if (!S.next(0, cur)) return;
    f32x4 acc[2][2][4][2];
#pragma unroll
    for (int a = 0; a < 2; ++a)
#pragma unroll
        for (int b = 0; b < 2; ++b)
#pragma unroll
            for (int m = 0; m < 4; ++m)
#pragma unroll
                for (int n = 0; n < 2; ++n) acc[a][b][m][n] = (f32x4){0.f, 0.f, 0.f, 0.f};
    bf16x8 At[4][2], B0[2][2], B1[2][2];
    const char* cA = (const char*)g.A + (size_t)cur.pm * tstep; const char* cB = (const char*)g.Bt + (size_t)cur.pn * tstep;
    S.a_ready(cur);
    if constexpr (SP2) {
        PG8_STAGE(PG8_SB(0, 0), cB, voffB); PG8_STAGE(PG8_SB(0, 1), cB + hstep, voffB); PG8_STAGE(PG8_SA(0, 0), cA, voffA); PG8_STAGE(PG8_SA(0, 1), cA + hstep, voffA);
        if (wr == 1) PG8_BAR;
        PG8_WAIT_V(2); PG8_BAR;
        PG8_STAGE(PG8_SB(1, 0), cB + kstep, voffB); PG8_STAGE(PG8_SA(1, 0), cA + kstep, voffA); PG8_STAGE(PG8_SB(1, 1), cB + hstep + kstep, voffB);
        PG8_WAIT_V(6); PG8_BAR;
    } else {
        PG8_STAGE(PG8_SB(0, 0), cB, voffB); PG8_STAGE(PG8_SA(0, 0), cA, voffA); PG8_STAGE(PG8_SB(0, 1), cB + hstep, voffB); PG8_STAGE(PG8_SA(0, 1), cA + hstep, voffA);
        if (wr == 1) PG8_BAR;
        PG8_WAIT_V(4); PG8_BAR;
        PG8_STAGE(PG8_SB(1, 0), cB + kstep, voffB); PG8_STAGE(PG8_SA(1, 0), cA + kstep, voffA); PG8_STAGE(PG8_SB(1, 1), cB + hstep + kstep, voffB);
        PG8_WAIT_V(6); PG8_BAR;
    }
    for (;;) {
        const bool has_next = S.next(ui + 1, nxt);
        const char* nA = has_next ? (const char*)g.A + (size_t)nxt.pm * tstep : cA; const char* nB = has_next ? (const char*)g.Bt + (size_t)nxt.pn * tstep : cB;
        for (int t = 0; t < nt; t += 2) {
            const bool last = (t == nt - 2);
            const char* a1 = cA + (size_t)(t + 1) * kstep;
            const char* a2 = last ? nA : cA + (size_t)(t + 2) * kstep; const char* b2 = last ? nB : cB + (size_t)(t + 2) * kstep;
            const char* a3 = a2 + kstep; const char* b3 = b2 + kstep;
            if (last && has_next) S.a_ready(nxt);
            if constexpr (SP2) {
            PG8_LDB(B0, 0, 0); PG8_LDB(B1, 0, 1); PG8_SCHED; PG8_LDA(At, 0, 0); PG8_STAGE(PG8_SA(1, 1), a1 + hstep, voffA);
            PG8_WAIT_V(8); PG8_WAIT_L(0); PG8_BAR; PG8_MMA(0, 0, At, B0); PG8_MMA(0, 1, At, B1); PG8_BAR; PG8_SCHED;
            PG8_LDA(At, 0, 1); PG8_STAGE(PG8_SB(0, 0), b2, voffB); PG8_STAGE(PG8_SB(0, 1), b2 + hstep, voffB); PG8_STAGE(PG8_SA(0, 0), a2, voffA);
            PG8_WAIT_V(8); PG8_WAIT_L(0); PG8_BAR; PG8_MMA(1, 0, At, B0); PG8_MMA(1, 1, At, B1); PG8_BAR; PG8_SCHED;
            PG8_LDB(B0, 1, 0); PG8_LDB(B1, 1, 1); PG8_SCHED; PG8_LDA(At, 1, 0); PG8_STAGE(PG8_SA(0, 1), a2 + hstep, voffA);
            PG8_WAIT_V(8); PG8_WAIT_L(0); PG8_BAR; PG8_MMA(0, 0, At, B0); PG8_MMA(0, 1, At, B1); PG8_BAR; PG8_SCHED;
            PG8_LDA(At, 1, 1); PG8_STAGE(PG8_SB(1, 0), b3, voffB); PG8_STAGE(PG8_SB(1, 1), b3 + hstep, voffB); PG8_STAGE(PG8_SA(1, 0), a3, voffA);
            PG8_WAIT_V(8); PG8_WAIT_L(0); PG8_BAR; PG8_MMA(1, 0, At, B0); PG8_MMA(1, 1, At, B1); PG8_BAR; PG8_SCHED;
            } else {
            PG8_LDB(B0, 0, 0); PG8_SCHED; PG8_LDA(At, 0, 0); PG8_STAGE(PG8_SA(1, 1), a1 + hstep, voffA);
            PG8_WAIT_L(8); PG8_BAR; PG8_WAIT_L(0); PG8_MMA(0, 0, At, B0); PG8_BAR; PG8_SCHED;
            PG8_LDB(B1, 0, 1); PG8_STAGE(PG8_SB(0, 0), b2, voffB);
            PG8_BAR; PG8_WAIT_L(0); PG8_MMA(0, 1, At, B1); PG8_BAR;
            PG8_LDA(At, 0, 1); PG8_STAGE(PG8_SA(0, 0), a2, voffA);
            PG8_BAR; PG8_WAIT_L(0); PG8_MMA(1, 0, At, B0); PG8_BAR; PG8_SCHED;
            PG8_STAGE(PG8_SB(0, 1), b2 + hstep, voffB);
            PG8_WAIT_V(6); PG8_BAR; PG8_MMA(1, 1, At, B1); PG8_BAR;
            PG8_LDB(B0, 1, 0); PG8_SCHED; PG8_LDA(At, 1, 0); PG8_STAGE(PG8_SA(0, 1), a2 + hstep, voffA);
            PG8_WAIT_L(8); PG8_BAR; PG8_WAIT_L(0); PG8_MMA(0, 0, At, B0); PG8_BAR; PG8_SCHED;
            PG8_LDB(B1, 1, 1); PG8_STAGE(PG8_SB(1, 0), b3, voffB);
            PG8_BAR; PG8_WAIT_L(0); PG8_MMA(0, 1, At, B1); PG8_BAR;
            PG8_LDA(At, 1, 1); PG8_STAGE(PG8_SA(1, 0), a3, voffA);
            PG8_BAR; PG8_WAIT_L(0); PG8_MMA(1, 0, At, B0); PG8_BAR; PG8_SCHED;
            PG8_STAGE(PG8_SB(1, 1), b3 + hstep, voffB);
            PG8_WAIT_V(6); PG8_BAR; PG8_MMA(1, 1, At, B1); PG8_BAR;
            }
        }
        if constexpr (ALIGN_EPI) { if (wr == 0) PG8_BAR; }
        if constexpr (!Epi::AFTER_DRAIN) { E(acc, cur, wr, wc, fr, fq); S.done(cur); }
        if (!has_next) break;
#pragma unroll
        for (int a = 0; a < 2; ++a)
#pragma unroll
            for (int b = 0; b < 2; ++b)
#pragma unroll
                for (int m = 0; m < 4; ++m)
#pragma unroll
                    for (int n = 0; n < 2; ++n) acc[a][b][m][n] = (f32x4){0.f, 0.f, 0.f, 0.f};
        cur = nxt; cA = nA; cB = nB; ++ui;
        if constexpr (ALIGN_EPI) { if (wr == 1) PG8_BAR; }
    }
    PG8_WAIT_V(0);
    if constexpr (!ALIGN_EPI) { if (wr == 0) PG8_BAR; }
    PG8_BAR;
    if constexpr (Epi::AFTER_DRAIN) { E.fused(acc, cur, wr, wc, fr, fq, lds, wid, lane); S.done(cur); }
#undef PG8_SA
#undef PG8_SB
#undef PG8_STAGE
#undef PG8_LDA
#undef PG8_LDB
#undef PG8_MMA
#undef PG8_WAIT_V
#undef PG8_WAIT_L
#undef PG8_BAR
#undef PG8_SCHED
}
}
#include <hip/hip_bf16.h>
#include <cmath>
namespace attn_body {
using bf16=__hip_bfloat16;
using bf16x8=__attribute__((ext_vector_type(8)))short;
using s16x4=__attribute__((ext_vector_type(4)))short;
using f32x16=__attribute__((ext_vector_type(16)))float;
using u32x4=__attribute__((ext_vector_type(4)))unsigned;
constexpr int D=64,DM=1024;
constexpr int NW=8,QBLK=32,QB=QBLK*NW,KVBLK=64;
constexpr int ATTN_PITCH=DM, ATTN_UNIT_ROWS=QB;
__device__ __forceinline__ int crow(int r,int hi){return (r&3)+8*(r>>2)+4*hi;}
#define SBAR() __builtin_amdgcn_sched_barrier(0)
__device__ __forceinline__ void cmask(f32x16&p0,f32x16&p1,int jb,int qchunk){
  const float NEG=-INFINITY;
  if(jb>qchunk){
  #pragma unroll
  for(int r=0;r<16;++r){p0[r]=NEG;p1[r]=NEG;} }
}
constexpr int NSLOT=3, SLOTB=8192;
constexpr int LDS_K=0, LDS_V=NSLOT*SLOTB, LDS_WS=2*NSLOT*SLOTB, LDS_OST=LDS_WS+NW*64*4, LDS_BYTES=LDS_OST+NW*8192;
constexpr float C2=0.125f*1.4426950408889634f;
__device__ __forceinline__ void glds16(const void*gsrc,unsigned lds_dst){unsigned keep;
  asm volatile("s_mov_b32 %0, m0\n\ts_mov_b32 m0, %2\n\ts_nop 0\n\tglobal_load_lds_dwordx4 %1, off\n\ts_mov_b32 m0, %0":"=&s"(keep):"v"(gsrc),"s"(lds_dst):"memory");}
__device__ __forceinline__ float max3f(float a,float b,float c){float r;asm("v_max3_f32 %0, %1, %2, %3":"=v"(r):"v"(a),"v"(b),"v"(c));return r;}
__device__ __forceinline__ float max2f(float a,float b){float r;asm("v_max_f32_e32 %0, %1, %2":"=v"(r):"v"(a),"v"(b));return r;}
__device__ __forceinline__ float fadd_s(float a,float b){float r;asm("v_add_f32_e32 %0, %1, %2":"=v"(r):"v"(a),"v"(b));return r;}
__device__ __forceinline__ float fsub_s(float a,float b){float r;asm("v_sub_f32_e32 %0, %1, %2":"=v"(r):"v"(a),"v"(b));return r;}
typedef float f32x2_t __attribute__((ext_vector_type(2))); typedef __bf16 bf16x2_t __attribute__((ext_vector_type(2)));
__device__ __forceinline__ unsigned cvtpk_s(float lo,float hi){f32x2_t v={lo,hi};bf16x2_t b=__builtin_convertvector(v,bf16x2_t);return __builtin_bit_cast(unsigned,b);}
#define WAIT_BAR(N) asm volatile("s_waitcnt vmcnt(" #N ") lgkmcnt(0)\n\ts_barrier":::"memory")

__device__ __forceinline__ void qkt(f32x16&p0,f32x16&p1,const char*Kslot,const bf16x8*qr,const f32x16&negm,int r32,int hi){
  const char*kb=Kslot+hi*1024+r32*16;
  #pragma unroll
  for(int d0=0;d0<4;++d0){
    const bf16x8 b0=*reinterpret_cast<const bf16x8*>(kb+d0*2048);
    const bf16x8 b1=*reinterpret_cast<const bf16x8*>(kb+d0*2048+512);
    if(d0==0){p0=__builtin_amdgcn_mfma_f32_32x32x16_bf16(b0,qr[0],negm,0,0,0);p1=__builtin_amdgcn_mfma_f32_32x32x16_bf16(b1,qr[0],negm,0,0,0);}
    else{p0=__builtin_amdgcn_mfma_f32_32x32x16_bf16(b0,qr[d0],p0,0,0,0);p1=__builtin_amdgcn_mfma_f32_32x32x16_bf16(b1,qr[d0],p1,0,0,0);}}
}
typedef __attribute__((address_space(3))) const char* lds_cptr;
typedef short v4i16_t __attribute__((ext_vector_type(4)));
__device__ __forceinline__ void kload8(bf16x8*kf,lds_cptr kp){
  kf[0]=*(const __attribute__((address_space(3))) bf16x8*)(kp);      kf[1]=*(const __attribute__((address_space(3))) bf16x8*)(kp+512);
  kf[2]=*(const __attribute__((address_space(3))) bf16x8*)(kp+2048); kf[3]=*(const __attribute__((address_space(3))) bf16x8*)(kp+2560);
  kf[4]=*(const __attribute__((address_space(3))) bf16x8*)(kp+4096); kf[5]=*(const __attribute__((address_space(3))) bf16x8*)(kp+4608);
  kf[6]=*(const __attribute__((address_space(3))) bf16x8*)(kp+6144); kf[7]=*(const __attribute__((address_space(3))) bf16x8*)(kp+6656);
}
__device__ __forceinline__ void kload2(bf16x8*kf,lds_cptr kp,int j){ kf[2*j]=*(const __attribute__((address_space(3))) bf16x8*)(kp+j*2048); kf[2*j+1]=*(const __attribute__((address_space(3))) bf16x8*)(kp+j*2048+512); }
__device__ __forceinline__ s16x4 vtr(lds_cptr p){ return __builtin_bit_cast(s16x4,__builtin_amdgcn_ds_read_tr16_b64_v4i16((__attribute__((address_space(3))) v4i16_t*)p)); }
__device__ __forceinline__ float rowmax(const f32x16&p0,const f32x16&p1){
  float a=max3f(p0[0],p0[1],p1[0]),b=max3f(p0[2],p0[3],p1[1]);a=max3f(a,p1[2],p1[3]);
  #pragma unroll
  for(int r=4;r<16;r+=4){a=max3f(a,p0[r],p0[r+1]);b=max3f(b,p0[r+2],p0[r+3]);a=max3f(a,p1[r],p1[r+1]);b=max3f(b,p1[r+2],p1[r+3]);}
  const float m=max2f(a,b);
  auto rr=__builtin_amdgcn_permlane32_swap(__float_as_uint(m),__float_as_uint(m),false,false);
  return max2f(__uint_as_float(rr[0]),__uint_as_float(rr[1]));
}
__device__ __forceinline__ void pv(f32x16*o,int vb,bf16x8 pa0,bf16x8 pa1,bf16x8 pa2,bf16x8 pa3){
  #pragma unroll
  for(int d0=0;d0<2;++d0){s16x4 lo[4],hi[4];
    #pragma unroll
    for(int ks=0;ks<4;++ks){
      asm volatile("ds_read_b64_tr_b16 %0,%1 offset:%c2":"=&v"(lo[ks]):"v"(vb),"i"(d0*4096+ks*1024):"memory");
      asm volatile("ds_read_b64_tr_b16 %0,%1 offset:%c2":"=&v"(hi[ks]):"v"(vb),"i"(d0*4096+ks*1024+512):"memory");}
    asm volatile("s_waitcnt lgkmcnt(0)":::"memory");SBAR();
    #define PK(k) (bf16x8){lo[k][0],lo[k][1],lo[k][2],lo[k][3],hi[k][0],hi[k][1],hi[k][2],hi[k][3]}
    o[d0]=__builtin_amdgcn_mfma_f32_32x32x16_bf16(pa0,PK(0),o[d0],0,0,0);
    o[d0]=__builtin_amdgcn_mfma_f32_32x32x16_bf16(pa1,PK(1),o[d0],0,0,0);
    o[d0]=__builtin_amdgcn_mfma_f32_32x32x16_bf16(pa2,PK(2),o[d0],0,0,0);
    o[d0]=__builtin_amdgcn_mfma_f32_32x32x16_bf16(pa3,PK(3),o[d0],0,0,0);
    #undef PK
  }
}

#ifndef ATTN_STORE16
#define ATTN_STORE16(p,v) (*(u32x4*)(p)=(v))
#endif
template<int THRL> __device__ __forceinline__ void attn_unit(int qb,const bf16*Q,const bf16*__restrict__ K,const bf16*__restrict__ V,float*O,char*shm){
  int tid_o=threadIdx.x; asm volatile("":"+v"(tid_o));
  const int tid=tid_o,lane=tid&63,r32=lane&31,hi=lane>>5; const int wid=__builtin_amdgcn_readfirstlane(tid>>6);
  const int q0=qb*QB;
  const bf16*Qw=Q+(long)(q0+wid*QBLK)*DM;
  const bf16*Kh=K,*Vh=V;
  const unsigned lds0=(unsigned)(uintptr_t)shm;
  float*wsf=(float*)(shm+LDS_WS)+wid*64;
  const bf16*ksrc=Kh+(long)lane*DM+wid*8;
  const bf16*vsrc=Vh+(long)(16*(wid&3)+(lane>>2))*DM+(wid>>2)*32+(lane&3)*8;
  const unsigned kdst=lds0+LDS_K+wid*1024, vdst=lds0+LDS_V+wid*1024;
  #define DMA_K(t,slot) glds16(ksrc+(long)(t)*KVBLK*DM,(unsigned)__builtin_amdgcn_readfirstlane(kdst+(slot)))
  #define DMA_V(t,slot) glds16(vsrc+(long)(t)*KVBLK*DM,(unsigned)__builtin_amdgcn_readfirstlane(vdst+(slot)))
  const int vb0=(int)(lds0+LDS_V)+((lane>>4)&1)*32+(lane&3)*8+(4*hi+((lane&15)>>2))*64;
  const char*Kbase=shm+LDS_K; bf16x8 kf[8];
  const lds_cptr shm3=(lds_cptr)shm; const lds_cptr kp0=shm3+LDS_K+hi*1024+r32*16; const lds_cptr vp0=shm3+LDS_V+((lane>>4)&1)*32+(lane&3)*8+(4*hi+((lane&15)>>2))*64;
  const int NT=(q0+QB)/KVBLK;
  DMA_K(0,0);DMA_V(0,0);DMA_K(1,SLOTB);
  bf16x8 qr[4];
  #pragma unroll
  for(int d0=0;d0<4;++d0)qr[d0]=*reinterpret_cast<const bf16x8*>(&Qw[(long)r32*DM+d0*16+hi*8]);
  float mhat=0.f,l_reg=0.f;f32x16 o[2];o[0]=f32x16{};o[1]=f32x16{};f32x16 negm=f32x16{};asm volatile("":"+v"(negm));

  #define CMASK(P0,P1,t) do{int jb_=(t)-(NT-4); if(jb_>=0)cmask(P0,P1,jb_,wid>>1);}while(0)
  bool resc=false;
  #define START(P0,P1) do{ const float rm=rowmax(P0,P1); resc=false; \
    { const float dl=rm; mhat=fadd_s(mhat,dl); \
      _Pragma("unroll") for(int r=0;r<16;++r){P0[r]=fsub_s(P0[r],dl);P1[r]=fsub_s(P1[r],dl);} \
      _Pragma("unroll") for(int r=0;r<16;++r)negm[r]=-mhat; asm volatile("":"+v"(negm)); } \
    _Pragma("unroll") for(int r=0;r<16;++r)P0[r]=__builtin_amdgcn_exp2f(P0[r]); }while(0)
  #define RESC() do{ if(resc){ asm volatile("s_waitcnt lgkmcnt(0)":::"memory"); \
      _Pragma("unroll") for(int d_=0;d_<2;++d_) _Pragma("unroll") for(int r=0;r<16;++r)o[d_][r]*=wsf[crow(r,hi)]; } }while(0)
  f32x16 pA0,pA1,pB0,pB1;
  int sl_prev=0,sl_cur=0,sl_next=SLOTB;
  #define ROT() do{sl_prev=sl_cur;sl_cur=sl_next;sl_next=(sl_next==(NSLOT-1)*SLOTB)?0:sl_next+SLOTB;}while(0)
  DMA_K(2,2*SLOTB);
  WAIT_BAR(3);
  qkt(pA0,pA1,Kbase,qr,negm,r32,hi);asm volatile("s_nop 15\n\ts_nop 7":"+v"(pA0),"+v"(pA1));CMASK(pA0,pA1,0);
  START(pA0,pA1);
  _Pragma("unroll") for(int r=0;r<16;++r)pA1[r]=__builtin_amdgcn_exp2f(pA1[r]);
  WAIT_BAR(0);
  DMA_K(3,0);DMA_V(1,SLOTB);
  ROT();
  kload8(kf,kp0+sl_cur);
  WAIT_BAR(2);
  s16x4 vlo[8],vhi[8]; u32x4 pw0,pw1,pw2,pw3;
  #define PKW(P,B) cvtpk_s(P[B],P[B+1])
  #define PAF(k) __builtin_bit_cast(bf16x8,pw##k)
  #define VFR(i) (bf16x8){vlo[i][0],vlo[i][1],vlo[i][2],vlo[i][3],vhi[i][0],vhi[i][1],vhi[i][2],vhi[i][3]}
  #define PIN(x) asm volatile("":"+v"(x))
  #define MX3(a,b,c) __builtin_fmaxf(__builtin_fmaxf((a),(b)),(c))
  #define GAPA(MF,A0,A1,A2,A3,W0,W1,PW) do{ MF; sacc+=A0; sacc+=A1; sacc+=A2; sacc+=A3; PIN(sacc); W0; W1; PIN(PW); SBAR(); }while(0)
  #define EX(v) __builtin_amdgcn_exp2f(v)
  #define GAPB(MF,X,B) do{ MF; X[B]=EX(X[B]); X[B+1]=EX(X[B+1]); X[B+2]=EX(X[B+2]); X[B+3]=EX(X[B+3]); PIN(X); SBAR(); }while(0)
  #define VRD(i) do{ vlo[i]=vtr(vp_+(((i)>>2)*4096+((i)&3)*1024)); vhi[i]=vtr(vp_+(((i)>>2)*4096+((i)&3)*1024+512)); }while(0)
  #define KRD(G,j) do{ if(G){ kload2(kf,kp0+sl_next,j); SBAR(); } }while(0)
  #define STEP(C0,C1,P0,P1,t,GK,GV,GL) do{ SBAR(); \
    const lds_cptr vp_=vp0+sl_prev; \
    VRD(0); SBAR(); float sacc=(P0[0]+P0[1]); \
    GAPA(C0=__builtin_amdgcn_mfma_f32_32x32x16_bf16(kf[0],qr[0],negm,0,0,0), P0[2],P0[3],P0[4],P0[5],     pw0[0]=PKW(P0,0), pw0[1]=PKW(P0,2), pw0); \
    VRD(4); SBAR(); GAPA(C1=__builtin_amdgcn_mfma_f32_32x32x16_bf16(kf[1],qr[0],negm,0,0,0), P0[6],P0[7],P0[8],P0[9],     pw0[2]=PKW(P0,4), pw0[3]=PKW(P0,6), pw0); \
    VRD(1); SBAR(); GAPA(C0=__builtin_amdgcn_mfma_f32_32x32x16_bf16(kf[2],qr[1],C0,0,0,0),   P0[10],P0[11],P0[12],P0[13], pw1[0]=PKW(P0,8), pw1[1]=PKW(P0,10), pw1); \
    VRD(5); SBAR(); GAPA(C1=__builtin_amdgcn_mfma_f32_32x32x16_bf16(kf[3],qr[1],C1,0,0,0),   P0[14],P0[15],P1[0],P1[1],   pw1[2]=PKW(P0,12),pw1[3]=PKW(P0,14), pw1); \
    VRD(2); SBAR(); GAPA(C0=__builtin_amdgcn_mfma_f32_32x32x16_bf16(kf[4],qr[2],C0,0,0,0),   P1[2],P1[3],P1[4],P1[5],     pw2[0]=PKW(P1,0), pw2[1]=PKW(P1,2), pw2); \
    VRD(6); SBAR(); GAPA(C1=__builtin_amdgcn_mfma_f32_32x32x16_bf16(kf[5],qr[2],C1,0,0,0),   P1[6],P1[7],P1[8],P1[9],     pw2[2]=PKW(P1,4), pw2[3]=PKW(P1,6), pw2); \
    VRD(3); SBAR(); GAPA(C0=__builtin_amdgcn_mfma_f32_32x32x16_bf16(kf[6],qr[3],C0,0,0,0),   P1[10],P1[11],P1[12],P1[13], pw3[0]=PKW(P1,8), pw3[1]=PKW(P1,10), pw3); \
    VRD(7); SBAR(); GAPA(C1=__builtin_amdgcn_mfma_f32_32x32x16_bf16(kf[7],qr[3],C1,0,0,0),   P1[14],P1[15],0.f,0.f,       pw3[2]=PKW(P1,12),pw3[3]=PKW(P1,14), pw3); \
    l_reg+=sacc; \
    if(GK){DMA_K((t)+3,sl_cur);} if(GV){DMA_V((t)+1,sl_next);} \
    CMASK(C0,C1,t); \
    { float a=MX3(C0[0],C0[1],C1[0]),b=MX3(C0[2],C0[3],C1[1]); a=MX3(a,C1[2],C1[3]); \
      _Pragma("unroll") for(int r=4;r<16;r+=4){a=MX3(a,C0[r],C0[r+1]);b=MX3(b,C0[r+2],C0[r+3]);a=MX3(a,C1[r],C1[r+1]);b=MX3(b,C1[r+2],C1[r+3]);} \
      float rm=__builtin_fmaxf(a,b); { auto rr=__builtin_amdgcn_permlane32_swap(__float_as_uint(rm),__float_as_uint(rm),false,false); rm=__builtin_fmaxf(__uint_as_float(rr[0]),__uint_as_float(rr[1])); } \
      resc=false; \
      if(__builtin_expect(__any(rm>(float)THRL),0)){ const float dl=__builtin_fmaxf(rm,0.f); mhat+=dl; \
        _Pragma("unroll") for(int r=0;r<16;++r){C0[r]-=dl;C1[r]-=dl;} \
        _Pragma("unroll") for(int r=0;r<16;++r)negm[r]=-mhat; asm volatile("":"+v"(negm)); \
        const float f=__builtin_amdgcn_exp2f(-dl); l_reg*=f; if(hi==0)wsf[r32]=f; resc=true; } } \
    SBAR(); \
    GAPB(o[0]=__builtin_amdgcn_mfma_f32_32x32x16_bf16(PAF(0),VFR(0),o[0],0,0,0), C0,0); \
    GAPB(o[1]=__builtin_amdgcn_mfma_f32_32x32x16_bf16(PAF(0),VFR(4),o[1],0,0,0), C0,4); \
    KRD(GL,0); GAPB(o[0]=__builtin_amdgcn_mfma_f32_32x32x16_bf16(PAF(1),VFR(1),o[0],0,0,0), C0,8); \
    KRD(GL,1); GAPB(o[1]=__builtin_amdgcn_mfma_f32_32x32x16_bf16(PAF(1),VFR(5),o[1],0,0,0), C0,12); \
    KRD(GL,2); GAPB(o[0]=__builtin_amdgcn_mfma_f32_32x32x16_bf16(PAF(2),VFR(2),o[0],0,0,0), C1,0); \
    KRD(GL,3); GAPB(o[1]=__builtin_amdgcn_mfma_f32_32x32x16_bf16(PAF(2),VFR(6),o[1],0,0,0), C1,4); \
    GAPB(o[0]=__builtin_amdgcn_mfma_f32_32x32x16_bf16(PAF(3),VFR(3),o[0],0,0,0), C1,8); \
    GAPB(o[1]=__builtin_amdgcn_mfma_f32_32x32x16_bf16(PAF(3),VFR(7),o[1],0,0,0), C1,12); \
    }while(0)
  int t=1;
  #undef CMASK
  #define CMASK(P0,P1,t) do{}while(0)
  for(;t+5<NT;t+=2){
    STEP(pB0,pB1,pA0,pA1,t,true,true,true);     WAIT_BAR(2); RESC(); ROT();
    STEP(pA0,pA1,pB0,pB1,t+1,true,true,true);   WAIT_BAR(2); RESC(); ROT();
  }
  #undef CMASK
  #define CMASK(P0,P1,t) do{int jb_=(t)-(NT-4); if(jb_>=0)cmask(P0,P1,jb_,wid>>1);}while(0)
  #define ENDW(tt) do{ if((tt)+3<NT){WAIT_BAR(2);} else if((tt)+2<NT){WAIT_BAR(1);} else {WAIT_BAR(0);} }while(0)
  for(;t+1<NT;t+=2){
    STEP(pB0,pB1,pA0,pA1,t,(t+3<NT),(t+1<NT),(t+1<NT));       ENDW(t);   RESC(); ROT();
    STEP(pA0,pA1,pB0,pB1,t+1,(t+4<NT),(t+2<NT),(t+2<NT));     ENDW(t+1); RESC(); ROT();
  }
  STEP(pB0,pB1,pA0,pA1,NT-1,false,false,false); RESC();
  { float sacc=pB0[0]+pB0[1]; _Pragma("unroll") for(int r=2;r<16;++r)sacc+=pB0[r]; _Pragma("unroll") for(int r=0;r<16;++r)sacc+=pB1[r]; l_reg+=sacc;
    pw0=(u32x4){PKW(pB0,0),PKW(pB0,2),PKW(pB0,4),PKW(pB0,6)};pw1=(u32x4){PKW(pB0,8),PKW(pB0,10),PKW(pB0,12),PKW(pB0,14)};pw2=(u32x4){PKW(pB1,0),PKW(pB1,2),PKW(pB1,4),PKW(pB1,6)};pw3=(u32x4){PKW(pB1,8),PKW(pB1,10),PKW(pB1,12),PKW(pB1,14)};
    SBAR(); pv(o,vb0+sl_cur,PAF(0),PAF(1),PAF(2),PAF(3)); }
  #undef PKW
  #undef PAF
  #undef VFR
  #undef PIN
  #undef MX3
  #undef GAPA
  #undef GAPB
  #undef EX
  #undef VRD
  #undef KRD
  #undef STEP
  #undef ENDW
  {auto rr=__builtin_amdgcn_permlane32_swap(__float_as_uint(l_reg),__float_as_uint(l_reg),false,false);l_reg=__uint_as_float(rr[0])+__uint_as_float(rr[1]);}
  if(hi==0)wsf[32+r32]=l_reg;asm volatile("s_waitcnt lgkmcnt(0)":::"memory");
  float rli[16];
  #pragma unroll
  for(int r=0;r<16;++r)rli[r]=__builtin_amdgcn_rcpf(wsf[32+crow(r,hi)]);
  float*Ow=O+(long)(q0+wid*QBLK)*DM;
  { float*stg=(float*)(shm+LDS_OST)+wid*2048;
    #pragma unroll
    for(int r=0;r<16;++r){const int orow=crow(r,hi);
      #pragma unroll
      for(int d0=0;d0<2;++d0)stg[orow*64+d0*32+r32]=o[d0][r]*rli[r];}
    asm volatile("s_waitcnt lgkmcnt(0)":::"memory");
    #pragma unroll
    for(int i=0;i<8;++i){const int row=i*4+(lane>>4),ch=lane&15; const u32x4 v=*(const u32x4*)(stg+row*64+ch*4); *(u32x4*)(Ow+(long)row*DM+ch*4)=v;} }
  asm volatile("s_waitcnt lgkmcnt(0)\n\ts_barrier":::"memory");
  #undef DMA_K
  #undef DMA_V
  #undef CMASK
  #undef START
  #undef RESC
  #undef ROT
}
constexpr int ATTN_LDS_BYTES=LDS_BYTES;
#undef SBAR
#undef WAIT_BAR
}
#define GAS __attribute__((address_space(1)))
#define LAS __attribute__((address_space(3)))
typedef unsigned short bf16;
typedef unsigned v4u __attribute__((ext_vector_type(4)));
typedef float f32x4 __attribute__((ext_vector_type(4)));
typedef short bf16x8 __attribute__((ext_vector_type(8)));
typedef GAS unsigned gu32;
typedef GAS unsigned long long gu64;
#define RLX_AGENT __ATOMIC_RELAXED, __HIP_MEMORY_SCOPE_AGENT
#define LDS_WAIT() asm volatile("s_waitcnt lgkmcnt(0)" ::: "memory")
#define VM_WAIT() asm volatile("s_waitcnt vmcnt(0)" ::: "memory")
__device__ __forceinline__ unsigned long long rt() { return __builtin_amdgcn_s_memrealtime(); }
__device__ __forceinline__ unsigned f2bf(float f) { unsigned u = __builtin_bit_cast(unsigned, f); return (u + 0x7fffu + ((u >> 16) & 1u)) >> 16; }
__device__ __forceinline__ unsigned pk2(float lo, float hi) { return f2bf(lo) | (f2bf(hi) << 16); }

#define XB_TMO      128
#define XB_XCNT(j)  (256  + 64 * (j))
#define XB_XSUB(j)  (1280 + 64 * (j))
#define XB_XGEN(j)  (2304 + 64 * (j))
#define XB_TOP      3328
#define XB_TOPGEN   3392
#define XCD_BAR_WORDS 3456
#define XB_SPIN_CAP (1u << 18)

__device__ __forceinline__ unsigned xb_ld(unsigned* p)              { return __hip_atomic_load(p, __ATOMIC_RELAXED, __HIP_MEMORY_SCOPE_AGENT); }
__device__ __forceinline__ unsigned xb_add(unsigned* p, unsigned v) { return __hip_atomic_fetch_add(p, v, __ATOMIC_RELAXED, __HIP_MEMORY_SCOPE_AGENT); }
__device__ __forceinline__ unsigned xb_xcc_id() { return (unsigned)__builtin_amdgcn_s_getreg((3 << 11) | 20) & 0xFu; }
#define XB_SPIN(cond, bar) do { unsigned _sp = 0; while (cond) { __builtin_amdgcn_s_sleep(1); \
    if ((++_sp & 255u) == 0u) { if (xb_ld(&(bar)[XB_TMO])) break; if (_sp > XB_SPIN_CAP) { atomicAdd(&(bar)[XB_TMO], 1u); break; } } } } while (0)

struct XcdBarrier {
    unsigned* bar; unsigned x;
    volatile LAS unsigned* st;
};

__device__ __forceinline__ XcdBarrier xcd_barrier_post(unsigned* bar, volatile LAS unsigned* st) {
    XcdBarrier b; b.bar = bar; b.x = xb_xcc_id(); b.st = st;
    if (threadIdx.x == 0) (void)xb_add(&bar[XB_XCNT(b.x)], 1u);
    return b;
}
__device__ __forceinline__ void xcd_barrier_complete(unsigned* bar, unsigned x, unsigned& nloc, unsigned& nx) {
    const unsigned G = gridDim.x * gridDim.y * gridDim.z;
    unsigned sum, cnt, mine, sp = 0u;
    for (;;) {
        sum = 0u; cnt = 0u; mine = 0u;
#pragma unroll
        for (unsigned j = 0; j < 16; ++j) { const unsigned c = xb_ld(&bar[XB_XCNT(j)]); sum += c; cnt += (c > 0u) ? 1u : 0u; mine = (j == x) ? c : mine; }
        if (sum == G) break;
        __builtin_amdgcn_s_sleep(1);
        if ((++sp & 255u) == 0u) { if (xb_ld(&bar[XB_TMO])) break; if (sp > XB_SPIN_CAP) { atomicAdd(&bar[XB_TMO], 1u); break; } }
    }
    nloc = mine > 0u ? mine : 1u; nx = cnt > 0u ? cnt : 1u;
}

__device__ __forceinline__ void xcd_barrier(const XcdBarrier& b) {
    asm volatile("s_waitcnt vmcnt(0)" ::: "memory");
    __syncthreads();
    if (threadIdx.x == 0) {
        unsigned* bar = b.bar;
        __builtin_amdgcn_s_waitcnt(0);
        unsigned nloc = b.st[0], nx = b.st[1];
        if (nloc == 0u) { xcd_barrier_complete(bar, b.x, nloc, nx); b.st[0] = nloc; b.st[1] = nx; }
        const unsigned old = xb_add(&bar[XB_XSUB(b.x)], 1u);
        const unsigned gen = old / nloc;
        if (old + 1u == (gen + 1u) * nloc) {
            __builtin_amdgcn_fence(__ATOMIC_RELEASE, "agent");
            asm volatile("s_waitcnt vmcnt(0)" ::: "memory");
            const unsigned og = xb_add(&bar[XB_TOP], 1u);
            const unsigned tg = og / nx;
            if (og + 1u == (tg + 1u) * nx) xb_add(&bar[XB_TOPGEN], 1u);
            else XB_SPIN(xb_ld(&bar[XB_TOPGEN]) == tg, bar);
            __builtin_amdgcn_fence(__ATOMIC_ACQUIRE, "agent");
            xb_add(&bar[XB_XGEN(b.x)], 1u);
            asm volatile("s_waitcnt vmcnt(0)" ::: "memory");
        } else {
            XB_SPIN(xb_ld(&bar[XB_XGEN(b.x)]) == gen, bar);
            __builtin_amdgcn_fence(__ATOMIC_ACQUIRE, "agent");
            asm volatile("s_waitcnt vmcnt(0)" ::: "memory");
        }
    }
    __syncthreads();
}
typedef unsigned short bf16_t;
typedef float f32x4 __attribute__((ext_vector_type(4)));
typedef float f32x16 __attribute__((ext_vector_type(16)));
typedef unsigned u32x2 __attribute__((ext_vector_type(2)));
typedef unsigned u32x4v __attribute__((ext_vector_type(4)));
typedef short bf16x8 __attribute__((ext_vector_type(8)));
__device__ __forceinline__ float bflo(unsigned w) { return __uint_as_float(w << 16); }
__device__ __forceinline__ float bfhi(unsigned w) { return __uint_as_float(w & 0xffff0000u); }
__device__ __forceinline__ unsigned pkbf(float lo, float hi) { return pg8::cvt_pk_bf16(lo, hi); }
__device__ __forceinline__ float sigm(float x) { return __builtin_amdgcn_rcpf(1.f + __builtin_amdgcn_exp2f(-1.4426950408889634f * x)); }
__device__ __forceinline__ float wave_sum(float v) {
#pragma unroll
    for (int o = 1; o < 64; o <<= 1) v += __shfl_xor(v, o);
    return v;
}
__device__ __forceinline__ int crow16(int r, int hi) { return (r & 3) + 8 * (r >> 2) + 4 * hi; }

struct EpiIn {
    static constexpr bool PERM = false, AFTER_DRAIN = false;
    bf16_t *PXB, *SPG, *QB, *KB, *VB, *SAG, *SGA, *SGB; float* out; const float* rc; const float* rs; int layer;
    __device__ __forceinline__ void operator()(const pg8::f32x4 (&acc)[2][2][4][2], const pg8::Unit& u, int wr, int wc, int fr, int fq) const {
        const int pn = u.pn, row0 = u.pm * 256 + wr * 64 + fr;
        const bool samp = u.pm >= MP / 256;
        if (pn >= 4 && pn < 12) {
            const bool isk = pn >= 8;
            const int cbase = (pn - (isk ? 8 : 4)) * 256 + (wc >> 1) * 64 + (wc & 1) * 16 + 4 * fq;
            const int i0 = (wc & 1) * 16 + 4 * fq;
            bf16_t* dstb = isk ? KB : QB; const float sc = isk ? 1.f : C2;
#pragma unroll
            for (int ai = 0; ai < 2; ++ai)
#pragma unroll
                for (int m = 0; m < 4; ++m) {
                    const int row = row0 + ai * 128 + m * 16;
                    const int pos = samp ? PAST + ((row - MP) & 15) : (row & (SEQ - 1));
                    const f32x4 c = *(const f32x4*)(rc + pos * 32 + i0), s = *(const f32x4*)(rs + pos * 32 + i0);
                    float* ko = samp ? out + O_KS + ((size_t)layer * MS + (row - MP)) * 1024 : out + O_KP + ((size_t)layer * MP + row) * 1024;
#pragma unroll
                    for (int bj = 0; bj < 2; ++bj) {
                        const f32x4 x1 = acc[ai][bj][m][0], x2 = acc[ai][bj][m][1];
                        const f32x4 r1 = x1 * c - x2 * s, r2 = x2 * c + x1 * s;
                        const int col = cbase + bj * 128;
                        if (isk) { *(f32x4*)(ko + col) = r1; *(f32x4*)(ko + col + 32) = r2; }
                        u32x2 w1, w2; w1.x = pkbf(r1[0] * sc, r1[1] * sc); w1.y = pkbf(r1[2] * sc, r1[3] * sc); w2.x = pkbf(r2[0] * sc, r2[1] * sc); w2.y = pkbf(r2[2] * sc, r2[3] * sc);
                        *(u32x2*)(dstb + (size_t)row * 1024 + col) = w1; *(u32x2*)(dstb + (size_t)row * 1024 + col + 32) = w2;
                    }
                }
        } else {
            int mode, ld, cb; bf16_t* dst;
            if (pn < 2) { dst = PXB; ld = 512; cb = pn * 256; mode = 0; }
            else if (pn < 4) { dst = SPG; ld = 512; cb = (pn - 2) * 256; mode = 1; }
            else if (pn < 16) { dst = VB; ld = 1024; cb = (pn - 12) * 256; mode = 0; }
            else if (pn < 20) { dst = SAG; ld = 1024; cb = (pn - 16) * 256; mode = 1; }
            else if (pn < 24) { dst = SGA; ld = 1024; cb = (pn - 20) * 256; mode = 2; }
            else { dst = SGB; ld = 1024; cb = (pn - 24) * 256; mode = 2; }
            cb += 32 * wc + 8 * fq;
            const bool isv = pn >= 12 && pn < 16, ispx = pn < 2;
#pragma unroll
            for (int ai = 0; ai < 2; ++ai)
#pragma unroll
                for (int m = 0; m < 4; ++m) {
                    const int row = row0 + ai * 128 + m * 16;
                    float* fo = nullptr;
                    if (isv) fo = samp ? out + O_VS + ((size_t)layer * MS + (row - MP)) * 1024 : out + O_VP + ((size_t)layer * MP + row) * 1024;
                    else if (ispx) {
                        if (!samp) { const int t = row & (SEQ - 1); if (t >= SEQ - 15) fo = out + O_PP + (((size_t)layer * BATCH + (row >> 12)) * 15 + (t - (SEQ - 15))) * 512; }
                        else { const int rs_ = row - MP, j = rs_ & 15; if (j >= 1) fo = out + O_PS + (((size_t)layer * DEC_BATCH + (rs_ >> 4)) * 15 + (j - 1)) * 512; }
                    }
#pragma unroll
                    for (int bj = 0; bj < 2; ++bj) {
                        f32x4 v0 = acc[ai][bj][m][0], v1 = acc[ai][bj][m][1];
                        const int col = cb + bj * 128;
                        if (fo) { *(f32x4*)(fo + col) = v0; *(f32x4*)(fo + col + 4) = v1; }
                        if (mode == 1) {
#pragma unroll
                            for (int k = 0; k < 4; ++k) { v0[k] = v0[k] * sigm(v0[k]); v1[k] = v1[k] * sigm(v1[k]); }
                        } else if (mode == 2) {
#pragma unroll
                            for (int k = 0; k < 4; ++k) { v0[k] = sigm(v0[k]); v1[k] = sigm(v1[k]); }
                        }
                        u32x4v w; w.x = pkbf(v0[0], v0[1]); w.y = pkbf(v0[2], v0[3]); w.z = pkbf(v1[0], v1[1]); w.w = pkbf(v1[2], v1[3]);
                        *(u32x4v*)(dst + (size_t)row * ld + col) = w;
                    }
                }
        }
    }
};
struct EpiMergeA {
    static constexpr bool PERM = false, AFTER_DRAIN = false;
    const bf16_t* SGA; float* TMPA;
    __device__ __forceinline__ void operator()(const pg8::f32x4 (&acc)[2][2][4][2], const pg8::Unit& u, int wr, int wc, int fr, int fq) const {
        const int row0 = u.pm * 256 + wr * 64 + fr, col0 = u.pn * 256 + wc * 32 + 4 * fq;
#pragma unroll
        for (int ai = 0; ai < 2; ++ai)
#pragma unroll
            for (int m = 0; m < 4; ++m) { const size_t ro = (size_t)(row0 + ai * 128 + m * 16) * 1024 + col0;
#pragma unroll
                for (int bj = 0; bj < 2; ++bj)
#pragma unroll
                    for (int n = 0; n < 2; ++n) { const size_t o = ro + bj * 128 + n * 16; const u32x2 g = *(const u32x2*)(SGA + o);
                        const f32x4 a = acc[ai][bj][m][n]; f32x4 r; r[0] = a[0] * bflo(g.x); r[1] = a[1] * bfhi(g.x); r[2] = a[2] * bflo(g.y); r[3] = a[3] * bfhi(g.y);
                        *(f32x4*)(TMPA + o) = r; } }
    }
};
struct EpiMergeB {
    static constexpr bool PERM = false, AFTER_DRAIN = false;
    const bf16_t* SGB; const float* TMPA; bf16_t* MG;
    __device__ __forceinline__ void operator()(const pg8::f32x4 (&acc)[2][2][4][2], const pg8::Unit& u, int wr, int wc, int fr, int fq) const {
        const int row0 = u.pm * 256 + wr * 64 + fr, col0 = u.pn * 256 + wc * 32 + 4 * fq;
#pragma unroll
        for (int ai = 0; ai < 2; ++ai)
#pragma unroll
            for (int m = 0; m < 4; ++m) { const size_t ro = (size_t)(row0 + ai * 128 + m * 16) * 1024 + col0;
#pragma unroll
                for (int bj = 0; bj < 2; ++bj)
#pragma unroll
                    for (int n = 0; n < 2; ++n) { const size_t o = ro + bj * 128 + n * 16; const u32x2 g = *(const u32x2*)(SGB + o); const f32x4 t = *(const f32x4*)(TMPA + o);
                        const f32x4 a = acc[ai][bj][m][n]; f32x4 r; r[0] = t[0] + a[0] * bflo(g.x); r[1] = t[1] + a[1] * bfhi(g.x); r[2] = t[2] + a[2] * bflo(g.y); r[3] = t[3] + a[3] * bfhi(g.y);
                        u32x2 w; w.x = pkbf(r[0], r[1]); w.y = pkbf(r[2], r[3]); *(u32x2*)(MG + o) = w; } }
    }
};
struct EpiOut {
    static constexpr bool PERM = false, AFTER_DRAIN = false;
    float* X;
    __device__ __forceinline__ void operator()(const pg8::f32x4 (&acc)[2][2][4][2], const pg8::Unit& u, int wr, int wc, int fr, int fq) const {
        const int row0 = u.pm * 256 + wr * 64 + fr, col0 = u.pn * 256 + wc * 32 + 4 * fq;
#pragma unroll
        for (int ai = 0; ai < 2; ++ai)
#pragma unroll
            for (int m = 0; m < 4; ++m) { const size_t ro = (size_t)(row0 + ai * 128 + m * 16) * 1024 + col0;
#pragma unroll
                for (int bj = 0; bj < 2; ++bj)
#pragma unroll
                    for (int n = 0; n < 2; ++n) { const size_t o = ro + bj * 128 + n * 16; const f32x4 x = *(const f32x4*)(X + o); *(f32x4*)(X + o) = x * ALPHA + acc[ai][bj][m][n]; } }
    }
};

__device__ __forceinline__ int inv_perm_S(int a) { const int bj = a >> 7, wc = (a >> 5) & 3, fq = (a >> 3) & 3, n = (a >> 2) & 1, j = a & 3; return 128 * bj + 32 * wc + 16 * n + 4 * fq + j; }
__device__ __forceinline__ int inv_perm_R(int a) { const int bj = a >> 7, wch = (a >> 6) & 1, n = (a >> 5) & 1, wcl = (a >> 4) & 1, fq = (a >> 2) & 3, j = a & 3; return 128 * bj + 32 * (2 * wch + wcl) + 16 * n + 4 * fq + j; }
template <int PM>
__device__ __forceinline__ void p0_transpose_item(const float* W, int K, int N, bf16_t* WT, LAS float* scr, int item, int lane) {
    const int nblk = N / 32, kb = item / nblk, nb = item % nblk, k0 = 64 * kb, n0 = 32 * nb;
#pragma unroll 8
    for (int i = 0; i < 32; ++i) { const int kk = 2 * i + (lane >> 5); scr[kk * 33 + (lane & 31)] = W[(size_t)(k0 + kk) * N + n0 + (lane & 31)]; }
    LDS_WAIT(); asm volatile("" ::: "memory");
    const int c = lane & 7;
#pragma unroll
    for (int j = 0; j < 4; ++j) { const int n = (lane >> 3) + 8 * j; const LAS float* s = scr + (8 * c) * 33 + n;
        v4u o; o.x = pkbf(s[0 * 33], s[1 * 33]); o.y = pkbf(s[2 * 33], s[3 * 33]); o.z = pkbf(s[4 * 33], s[5 * 33]); o.w = pkbf(s[6 * 33], s[7 * 33]);
        int nr = n0 + n;
        if (PM == 1) { const int tile = nr >> 8, a = nr & 255; nr = (nr & ~255) + ((tile >= 4 && tile < 12) ? inv_perm_R(a) : inv_perm_S(a)); }
        *(GAS v4u*)(WT + (size_t)nr * K + k0 + 8 * c) = o; }
    LDS_WAIT(); asm volatile("" ::: "memory");
}
__device__ __forceinline__ void ln_row(const float* xrow, const float* g, const float* b, float* of, bf16_t* ob, int lane) {
    asm volatile("" : "+v"(lane));
    const GAS f32x4* xr = (const GAS f32x4*)xrow + lane;
    f32x4 v[4]; float s = 0.f;
#pragma unroll
    for (int j = 0; j < 4; ++j) { v[j] = xr[64 * j]; s += (v[j].x + v[j].y) + (v[j].z + v[j].w); }
    const float mean = wave_sum(s) * (1.f / 1024.f); float s2 = 0.f;
#pragma unroll
    for (int j = 0; j < 4; ++j) { v[j] = v[j] - mean; s2 += (v[j].x * v[j].x + v[j].y * v[j].y) + (v[j].z * v[j].z + v[j].w * v[j].w); }
    const float rstd = 1.f / sqrtf(wave_sum(s2) * (1.f / 1024.f) + LN_EPS);
    GAS f32x4* o4 = (GAS f32x4*)of + lane; GAS u32x2* o8 = (GAS u32x2*)ob + lane;
#pragma unroll
    for (int j = 0; j < 4; ++j) { const f32x4 gg = ((const GAS f32x4*)g + lane)[64 * j], bb = ((const GAS f32x4*)b + lane)[64 * j];
        const f32x4 y = v[j] * rstd * gg + bb; o4[64 * j] = y; u32x2 w; w.x = pkbf(y.x, y.y); w.y = pkbf(y.z, y.w); o8[64 * j] = w; }
}

struct Params { const float* in[17]; float* out; unsigned char* ws; int l_lo, l_hi, do_pro, bar_region; };
enum { I_XP = 0, I_XS, I_CK, I_CV, I_SP, I_LIG, I_LIB, I_WIN, I_WPOOL, I_PSC, I_LQK, I_SUBLN, I_WA, I_WB, I_WO, I_LNG, I_LNB };

__device__ __forceinline__ void pool_item(int item, int layer, const Params& P, int lane) {
    asm volatile("" : "+v"(lane));
    const int blk = item >> 2, g = item & 3, w = 2 << g;
    const int r = lane & 31, hi = lane >> 5, row = blk * 32 + r;
    const bool samp = row >= MP;
    const bf16_t* PXB = (const bf16_t*)(P.ws + WS_PXB); const bf16_t* SPG = (const bf16_t*)(P.ws + WS_SPG); bf16_t* YA = (bf16_t*)(P.ws + WS_YA);
    const bf16_t* WpT = (const bf16_t*)(P.ws + WS_WP) + (size_t)(layer * 4 + g) * 128 * 128;
    int navail, cnt;
    if (!samp) { navail = (row & (SEQ - 1)) + 1; cnt = navail < w ? navail : w; } else { navail = ((row - MP) & 15) + 1; cnt = w; }
    const bf16_t* px = PXB + (size_t)row * 512 + g * 128 + 8 * hi;
    const float* hist = P.in[I_SP] + (((size_t)layer * DEC_BATCH + (samp ? ((row - MP) >> 4) : 0)) * 15) * 512 + g * 128 + 8 * hi;
    const float rcnt = 1.f / (float)cnt;
    bf16x8 bfr[8];
#pragma unroll
    for (int s = 0; s < 8; ++s) {
        const u32x4v tk = *(const u32x4v*)(px + 16 * s);
        float a[8] = {bflo(tk.x), bfhi(tk.x), bflo(tk.y), bfhi(tk.y), bflo(tk.z), bfhi(tk.z), bflo(tk.w), bfhi(tk.w)};
        float t0[8];
#pragma unroll
        for (int k = 0; k < 8; ++k) t0[k] = a[k];
        for (int d = 1; d < w; ++d) {
            if (d < navail) { const u32x4v v = *(const u32x4v*)(px - (size_t)d * 512 + 16 * s);
                a[0] += bflo(v.x); a[1] += bfhi(v.x); a[2] += bflo(v.y); a[3] += bfhi(v.y); a[4] += bflo(v.z); a[5] += bfhi(v.z); a[6] += bflo(v.w); a[7] += bfhi(v.w); }
            else if (samp) { const float* hp = hist + (size_t)(15 + navail - 1 - d) * 512 + 16 * s; const f32x4 h0 = *(const f32x4*)hp, h1 = *(const f32x4*)(hp + 4);
                a[0] += h0[0]; a[1] += h0[1]; a[2] += h0[2]; a[3] += h0[3]; a[4] += h1[0]; a[5] += h1[1]; a[6] += h1[2]; a[7] += h1[3]; }
        }
        u32x4v pk; pk.x = pkbf(a[0] * rcnt - t0[0], a[1] * rcnt - t0[1]); pk.y = pkbf(a[2] * rcnt - t0[2], a[3] * rcnt - t0[3]);
        pk.z = pkbf(a[4] * rcnt - t0[4], a[5] * rcnt - t0[5]); pk.w = pkbf(a[6] * rcnt - t0[6], a[7] * rcnt - t0[7]);
        bfr[s] = __builtin_bit_cast(bf16x8, pk);
    }
    const float* psc = P.in[I_PSC] + (size_t)layer * 512 + g * 128;
#pragma unroll
    for (int db = 0; db < 4; ++db) {
        f32x16 acc = {};
#pragma unroll
        for (int s = 0; s < 8; ++s) { const bf16x8 af = *(const bf16x8*)(WpT + (size_t)(32 * db + r) * 128 + 16 * s + 8 * hi); acc = __builtin_amdgcn_mfma_f32_32x32x16_bf16(af, bfr[s], acc, 0, 0, 0); }
#pragma unroll
        for (int q = 0; q < 4; ++q) { const int d0 = 32 * db + 8 * q + 4 * hi;
            const f32x4 sc = *(const f32x4*)(psc + d0); const u32x2 gt = *(const u32x2*)(SPG + (size_t)row * 512 + g * 128 + d0);
            u32x2 o; o.x = pkbf(acc[4 * q] * sc[0] * bflo(gt.x), acc[4 * q + 1] * sc[1] * bfhi(gt.x)); o.y = pkbf(acc[4 * q + 2] * sc[2] * bflo(gt.y), acc[4 * q + 3] * sc[3] * bfhi(gt.y));
            *(u32x2*)(YA + (size_t)row * 512 + g * 128 + d0) = o; }
    }
}

__device__ __forceinline__ void combine_rows(size_t rowbase, int h, int layer, const Params& P, int tid) {
    const float* O1 = (const float*)(P.ws + WS_O1); const float* O2 = (const float*)(P.ws + WS_O2);
    const bf16_t* SAG = (const bf16_t*)(P.ws + WS_SAG); bf16_t* YB = (bf16_t*)(P.ws + WS_YB);
    const float* LAM = (const float*)(P.ws + WS_LAM); const float lam = LAM[layer], li = LAM[4 + layer];
    asm volatile("" : "+v"(tid));
    const int rsub = tid >> 4, c8 = (tid & 15) * 8;
    const float* sl = P.in[I_SUBLN] + (size_t)layer * 128 + c8;
    const f32x4 s0 = *(const f32x4*)sl, s1 = *(const f32x4*)(sl + 4);
#pragma unroll 2
    for (int p = 0; p < 8; ++p) {
        const size_t base = (rowbase + p * 32 + rsub) * 1024 + h * 128 + c8;
        const f32x4 a0 = *(const f32x4*)(O1 + base) - lam * *(const f32x4*)(O2 + base), a1 = *(const f32x4*)(O1 + base + 4) - lam * *(const f32x4*)(O2 + base + 4);
        float ss = (a0[0] * a0[0] + a0[1] * a0[1]) + (a0[2] * a0[2] + a0[3] * a0[3]) + (a1[0] * a1[0] + a1[1] * a1[1]) + (a1[2] * a1[2] + a1[3] * a1[3]);
        ss += __shfl_xor(ss, 1); ss += __shfl_xor(ss, 2); ss += __shfl_xor(ss, 4); ss += __shfl_xor(ss, 8);
        const float rr = (1.f - li) / sqrtf(ss * (1.f / 128.f) + RMS_EPS);
        const u32x4v gt = *(const u32x4v*)(SAG + base);
        u32x4v o; o.x = pkbf(a0[0] * rr * s0[0] * bflo(gt.x), a0[1] * rr * s0[1] * bfhi(gt.x)); o.y = pkbf(a0[2] * rr * s0[2] * bflo(gt.y), a0[3] * rr * s0[3] * bfhi(gt.y));
        o.z = pkbf(a1[0] * rr * s1[0] * bflo(gt.z), a1[1] * rr * s1[1] * bfhi(gt.z)); o.w = pkbf(a1[2] * rr * s1[2] * bflo(gt.w), a1[3] * rr * s1[3] * bfhi(gt.w));
        *(u32x4v*)(YB + base) = o;
    }
}

__device__ __forceinline__ void sample_unit(int b, int h, int layer, const Params& P, LAS unsigned char* L, int tid, int lane, int wave) {
    asm volatile("" : "+v"(lane)); asm volatile("" : "+v"(tid));
    const int r = lane & 31, hi = lane >> 5;
    const bf16_t* QB = (const bf16_t*)(P.ws + WS_QB);
    const bf16_t* qrow = QB + (size_t)(MP + b * 16 + (r & 15)) * 1024 + h * 128 + 8 * hi;
    bf16x8 qf[8];
#pragma unroll
    for (int s = 0; s < 8; ++s) { const bool nz = (s < 4) ? (r < 16) : (r >= 16); bf16x8 z = {}; qf[s] = nz ? *(const bf16x8*)(qrow + 16 * s) : z; }
    f32x16 ot[4]; ot[0] = f32x16{}; ot[1] = f32x16{}; ot[2] = f32x16{}; ot[3] = f32x16{};
    float mrun = -INFINITY, lrun = 0.f;
    const float* ck = P.in[I_CK] + ((size_t)(layer * DEC_BATCH + b) * PAST) * 1024 + h * 128;
    const float* cv = P.in[I_CV] + ((size_t)(layer * DEC_BATCH + b) * PAST) * 1024 + h * 128;
    const float* nk = P.out + O_KS + ((size_t)layer * MS + b * 16) * 1024 + h * 128;
    const float* nv = P.out + O_VS + ((size_t)layer * MS + b * 16) * 1024 + h * 128;
    const int ntile = (wave == 0) ? 5 : 4;
    for (int ti = 0; ti < ntile; ++ti) {
        const bool newt = ti == 4;
        const float* kb = newt ? nk : ck + (size_t)(32 * (wave + 8 * ti)) * 1024;
        const float* vb = newt ? nv : cv + (size_t)(32 * (wave + 8 * ti)) * 1024;
        const int rmask = newt ? 15 : 31;
        const float* kr = kb + (size_t)(r & rmask) * 1024 + 8 * hi;
        f32x16 st = {};
#pragma unroll
        for (int s = 0; s < 8; ++s) { const f32x4 k0 = *(const f32x4*)(kr + 16 * s), k1 = *(const f32x4*)(kr + 16 * s + 4);
            u32x4v pk; pk.x = pkbf(k0[0], k0[1]); pk.y = pkbf(k0[2], k0[3]); pk.z = pkbf(k1[0], k1[1]); pk.w = pkbf(k1[2], k1[3]);
            st = __builtin_amdgcn_mfma_f32_32x32x16_bf16(__builtin_bit_cast(bf16x8, pk), qf[s], st, 0, 0, 0); }
        if (newt) {
#pragma unroll
            for (int q = 8; q < 16; ++q) st[q] = -INFINITY;
        }
        float tm = st[0];
#pragma unroll
        for (int q = 1; q < 16; ++q) tm = fmaxf(tm, st[q]);
        tm = fmaxf(tm, __shfl_xor(tm, 32));
        const float mnew = fmaxf(mrun, tm), f = __builtin_amdgcn_exp2f(mrun - mnew);
        mrun = mnew; lrun *= f;
#pragma unroll
        for (int c = 0; c < 4; ++c) ot[c] = ot[c] * f;
        float ps = 0.f;
#pragma unroll
        for (int q = 0; q < 16; ++q) { st[q] = __builtin_amdgcn_exp2f(st[q] - mnew); ps += st[q]; }
        lrun += ps;
        bf16x8 pf[2];
#pragma unroll
        for (int sp = 0; sp < 2; ++sp) { u32x4v pk; pk.x = pkbf(st[8 * sp], st[8 * sp + 1]); pk.y = pkbf(st[8 * sp + 2], st[8 * sp + 3]); pk.z = pkbf(st[8 * sp + 4], st[8 * sp + 5]); pk.w = pkbf(st[8 * sp + 6], st[8 * sp + 7]);
            pf[sp] = __builtin_bit_cast(bf16x8, pk); }
#pragma unroll
        for (int sp = 0; sp < 2; ++sp) {
#pragma unroll
            for (int c = 0; c < 4; ++c) {
                float vv[8];
#pragma unroll
                for (int j = 0; j < 8; ++j) { const int key = (16 * sp + 8 * (j >> 2) + 4 * hi + (j & 3)) & rmask; vv[j] = vb[(size_t)key * 1024 + 32 * c + r]; }
                u32x4v pk; pk.x = pkbf(vv[0], vv[1]); pk.y = pkbf(vv[2], vv[3]); pk.z = pkbf(vv[4], vv[5]); pk.w = pkbf(vv[6], vv[7]);
                ot[c] = __builtin_amdgcn_mfma_f32_32x32x16_bf16(__builtin_bit_cast(bf16x8, pk), pf[sp], ot[c], 0, 0, 0);
            }
        }
    }
    lrun += __shfl_xor(lrun, 32);
    LAS float* SM_M = (LAS float*)(L + RING_OFF);
    LAS float* SM_R = (LAS float*)(L + RING_OFF + 1024);
    LAS float* SM_O = (LAS float*)(L + RING_OFF + 1024 + 4 * 64 * 65 * 4);
    if (hi == 0) SM_M[wave * 32 + r] = mrun;
    __syncthreads();
    float mfin = SM_M[r];
#pragma unroll
    for (int w2 = 1; w2 < 8; ++w2) mfin = fmaxf(mfin, SM_M[w2 * 32 + r]);
    { const float sc = __builtin_amdgcn_exp2f(mrun - mfin); lrun *= sc;
#pragma unroll
      for (int c = 0; c < 4; ++c) ot[c] = ot[c] * sc; }
#pragma unroll
    for (int step = 4; step >= 1; step >>= 1) {
        if (wave >= step && wave < 2 * step) { LAS float* dst = SM_R + ((wave - step) * 64 + lane) * 65; dst[64] = lrun;
#pragma unroll
            for (int c = 0; c < 4; ++c)
#pragma unroll
                for (int q = 0; q < 16; ++q) dst[c * 16 + q] = ot[c][q]; }
        __syncthreads();
        if (wave < step) { const LAS float* src = SM_R + (wave * 64 + lane) * 65; lrun += src[64];
#pragma unroll
            for (int c = 0; c < 4; ++c)
#pragma unroll
                for (int q = 0; q < 16; ++q) ot[c][q] += src[c * 16 + q]; }
        __syncthreads();
    }
    if (wave == 0) { const float il = 1.f / lrun;
#pragma unroll
        for (int c = 0; c < 4; ++c)
#pragma unroll
            for (int q = 0; q < 16; ++q) SM_O[r * 129 + 32 * c + crow16(q, hi)] = ot[c][q] * il; }
    __syncthreads();
    {
        const float* LAM = (const float*)(P.ws + WS_LAM); const float lam = LAM[layer], li = LAM[4 + layer];
        const int q = tid >> 5, vd0 = (tid & 31) * 4;
        float a[4]; float ss = 0.f;
#pragma unroll
        for (int k = 0; k < 4; ++k) { a[k] = SM_O[q * 129 + vd0 + k] - lam * SM_O[(q + 16) * 129 + vd0 + k]; ss += a[k] * a[k]; }
        ss += __shfl_xor(ss, 1); ss += __shfl_xor(ss, 2); ss += __shfl_xor(ss, 4); ss += __shfl_xor(ss, 8); ss += __shfl_xor(ss, 16);
        const float rr = (1.f - li) / sqrtf(ss * (1.f / 128.f) + RMS_EPS);
        const size_t base = (size_t)(MP + b * 16 + q) * 1024 + h * 128 + vd0;
        const f32x4 sl = *(const f32x4*)(P.in[I_SUBLN] + (size_t)layer * 128 + vd0);
        const u32x2 gt = *(const u32x2*)((const bf16_t*)(P.ws + WS_SAG) + base);
        u32x2 o; o.x = pkbf(a[0] * rr * sl[0] * bflo(gt.x), a[1] * rr * sl[1] * bfhi(gt.x)); o.y = pkbf(a[2] * rr * sl[2] * bflo(gt.y), a[3] * rr * sl[3] * bfhi(gt.y));
        *(u32x2*)((bf16_t*)(P.ws + WS_YB) + base) = o;
    }
    __syncthreads();
}

__global__ void __launch_bounds__(NWAVES * 64, 2) mk_fwd(Params P) {
    extern __shared__ __attribute__((aligned(16))) unsigned char lds[];
    LAS unsigned char* L = (LAS unsigned char*)lds;
    const int tid = threadIdx.x, lane = tid & 63, wave = __builtin_amdgcn_readfirstlane(tid >> 6);
    const int G = gridDim.x, bx = blockIdx.x, vcu = (G % 8 == 0) ? (bx % 8) * (G / 8) + bx / 8 : bx;
    const int gw = vcu * NWAVES + wave, NGW = G * NWAVES;
    for (int u = tid; u < (LDS_BYTES - LDSCTL_OFF) / 4; u += NWAVES * 64) ((LAS unsigned*)(L + LDSCTL_OFF))[u] = 0u;
    __syncthreads();
    unsigned char* ws = P.ws;
    XcdBarrier bar = xcd_barrier_post((unsigned*)(ws + WS_CTL) + CW_BAR + P.bar_region * XCD_BAR_WORDS, (volatile LAS unsigned*)(L + MISC_OFF) + 8);
    bf16_t* WinT = (bf16_t*)(ws + WS_WIN); bf16_t* WaT = (bf16_t*)(ws + WS_WA); bf16_t* WbT = (bf16_t*)(ws + WS_WB); bf16_t* WoT = (bf16_t*)(ws + WS_WO); bf16_t* WpT = (bf16_t*)(ws + WS_WP);
    float* X = (float*)(ws + WS_X); bf16_t* XB = (bf16_t*)(ws + WS_XB);
    float* ropec = (float*)(ws + WS_ROPEC); float* ropes = (float*)(ws + WS_ROPES);

#ifndef NO_P0
    if (P.do_pro) {
        LAS float* scr = (LAS float*)(L + RING_OFF + wave * 16384);
        constexpr int I_IN = 16 * (D_IN / 32), I_A = 8 * 32, I_B = 16 * 32, I_P = 2 * 4;
        constexpr int N_IN = DEPTH * I_IN, N_A = DEPTH * I_A, N_B = DEPTH * I_B, N_P = DEPTH * 4 * I_P;
        constexpr int NITEMS = N_IN + N_A + 2 * N_B + N_P;
        for (int it = gw; it < NITEMS; it += NGW) {
            int rr = it;
            if (rr < N_IN) { const int l = rr / I_IN; p0_transpose_item<1>(P.in[I_WIN] + (size_t)l * 1024 * D_IN, 1024, D_IN, WinT + (size_t)l * D_IN * 1024, scr, rr % I_IN, lane); continue; } rr -= N_IN;
            if (rr < N_A) { const int l = rr / I_A; p0_transpose_item<0>(P.in[I_WA] + (size_t)l * 512 * 1024, 512, 1024, WaT + (size_t)l * 1024 * 512, scr, rr % I_A, lane); continue; } rr -= N_A;
            if (rr < N_B) { const int l = rr / I_B; p0_transpose_item<0>(P.in[I_WB] + (size_t)l * 1024 * 1024, 1024, 1024, WbT + (size_t)l * 1024 * 1024, scr, rr % I_B, lane); continue; } rr -= N_B;
            if (rr < N_B) { const int l = rr / I_B; p0_transpose_item<0>(P.in[I_WO] + (size_t)l * 1024 * 1024, 1024, 1024, WoT + (size_t)l * 1024 * 1024, scr, rr % I_B, lane); continue; } rr -= N_B;
            { const int lg = rr / I_P; p0_transpose_item<0>(P.in[I_WPOOL] + (size_t)lg * 128 * 128, 128, 128, WpT + (size_t)lg * 128 * 128, scr, rr % I_P, lane); }
        }
        for (int e = gw * 64 + lane; e < SEQ * 32; e += NGW * 64) {
            const int pos = e >> 5, i = e & 31;
            const double inv = exp(-(double)i * (9.210340371976184 / 32.0)), ang = (double)pos * inv;
            ropec[e] = (float)cos(ang); ropes[e] = (float)sin(ang);
        }
        if (bx == 0 && tid < DEPTH) {
            const float* lq = P.in[I_LQK] + tid * 256; float s1 = 0.f, s2 = 0.f;
            for (int i = 0; i < 64; ++i) { s1 += lq[i] * lq[64 + i]; s2 += lq[128 + i] * lq[192 + i]; }
            const float li = 0.8f - 0.6f * expf(-0.3f * (float)tid);
            float* LAM = (float*)(ws + WS_LAM); LAM[tid] = expf(s1) - expf(s2) + li; LAM[4 + tid] = li;
        }
        for (int m = gw; m < M; m += NGW) {
            const float* xr = (m < MP) ? P.in[I_XP] + (size_t)m * 1024 : P.in[I_XS] + (size_t)(m - MP) * 1024;
            ln_row(xr, P.in[I_LIG], P.in[I_LIB], X + (size_t)m * 1024, XB + (size_t)m * 1024, lane);
        }
        xcd_barrier(bar);
    }
#endif

    for (int l = P.l_lo; l < P.l_hi; ++l) {
#ifndef NO_P1
        {
            pg8::Gemm g{XB, WinT + (size_t)l * D_IN * 1024, M, D_IN, 1024}; pg8::StaticOrder S; S.init(M, D_IN, G, bx);
            EpiIn E{(bf16_t*)(ws + WS_PXB), (bf16_t*)(ws + WS_SPG), (bf16_t*)(ws + WS_QB), (bf16_t*)(ws + WS_KB), (bf16_t*)(ws + WS_VB), (bf16_t*)(ws + WS_SAG), (bf16_t*)(ws + WS_SGA), (bf16_t*)(ws + WS_SGB),
                    P.out, ropec, ropes, l};
            pg8::gemm_phase<EpiIn, pg8::StaticOrder, true, true>(L + RING_OFF, g, S, E);
        }
#endif
        xcd_barrier(bar);
#ifndef NO_SAMPLE
        for (int su = vcu; su < DEC_BATCH * 8; su += G) sample_unit(su >> 3, su & 7, l, P, L, tid, lane, wave);
#endif
#ifndef NO_POOL
        for (int it = gw; it < (M / 32) * 4; it += NGW) pool_item(it, l, P, lane);
#endif
#ifndef NO_ATTN
        for (int su = vcu; su < 256; su += G) {
            const int bh = su >> 2, s4 = su & 3, b = bh >> 3, h = bh & 7;
            const size_t bo = (size_t)b * SEQ * 1024 + h * 128;
            for (int i = 0; i < 4; ++i) {
                const int qb = (i == 0) ? s4 : (i == 1) ? 7 - s4 : (i == 2) ? 8 + s4 : 15 - s4;
                for (int sub = 0; sub < 4; ++sub) {
                    const int mp = sub >> 1, vh = sub & 1;
                    attn_body::attn_unit<8>(qb, (const attn_body::bf16*)(ws + WS_QB) + bo + mp * 64, (const attn_body::bf16*)(ws + WS_KB) + bo + mp * 64,
                                            (const attn_body::bf16*)(ws + WS_VB) + bo + vh * 64, (float*)(ws + (mp ? WS_O2 : WS_O1)) + bo + vh * 64, (char*)lds + RING_OFF);
                }
                asm volatile("s_waitcnt vmcnt(0)" ::: "memory"); __syncthreads();
                combine_rows((size_t)b * SEQ + (size_t)qb * 256, h, l, P, tid);
            }
        }
#endif
        xcd_barrier(bar);
#ifndef NO_P3
        {
            pg8::Gemm g{(const bf16_t*)(ws + WS_YA), WaT + (size_t)l * 1024 * 512, M, 1024, 512}; pg8::StaticOrder S; S.init(M, 1024, G, bx);
            EpiMergeA E{(const bf16_t*)(ws + WS_SGA), (float*)(ws + WS_TMPA)};
            pg8::gemm_phase<EpiMergeA, pg8::StaticOrder, true, true>(L + RING_OFF, g, S, E);
        }
        {
            pg8::Gemm g{(const bf16_t*)(ws + WS_YB), WbT + (size_t)l * 1024 * 1024, M, 1024, 1024}; pg8::StaticOrder S; S.init(M, 1024, G, bx);
            EpiMergeB E{(const bf16_t*)(ws + WS_SGB), (const float*)(ws + WS_TMPA), (bf16_t*)(ws + WS_MG)};
            pg8::gemm_phase<EpiMergeB, pg8::StaticOrder, true, true>(L + RING_OFF, g, S, E);
        }
#endif
        xcd_barrier(bar);
#ifndef NO_P4
        {
            pg8::Gemm g{(const bf16_t*)(ws + WS_MG), WoT + (size_t)l * 1024 * 1024, M, 1024, 1024}; pg8::StaticOrder S; S.init(M, 1024, G, bx);
            EpiOut E{X};
            pg8::gemm_phase<EpiOut, pg8::StaticOrder, true, true>(L + RING_OFF, g, S, E);
        }
#endif
        xcd_barrier(bar);
        {
            float* dst = (l == DEPTH - 1) ? P.out + O_Y : X;
            for (int m = gw; m < M; m += NGW) ln_row(X + (size_t)m * 1024, P.in[I_LNG] + (size_t)l * 1024, P.in[I_LNB] + (size_t)l * 1024, dst + (size_t)m * 1024, XB + (size_t)m * 1024, lane);
        }
        if (l + 1 < P.l_hi) xcd_barrier(bar);
    }
}
static int mk_grid_setup() {
    static int grid = 0;
    if (grid == 0) {
        int dev = 0, cus = 0;
        if (hipGetDevice(&dev) != hipSuccess || hipDeviceGetAttribute(&cus, hipDeviceAttributeMultiprocessorCount, dev) != hipSuccess || cus < 8) { fprintf(stderr, "kernel_launch: device query failed\n"); grid = -1; return grid; }
        if (hipFuncSetAttribute((const void*)mk_fwd, hipFuncAttributeMaxDynamicSharedMemorySize, LDS_BYTES) != hipSuccess) { fprintf(stderr, "kernel_launch: hipFuncSetAttribute failed\n"); grid = -1; return grid; }
        int per_cu = 0;
        if (hipOccupancyMaxActiveBlocksPerMultiprocessor(&per_cu, (const void*)mk_fwd, NWAVES * 64, LDS_BYTES) != hipSuccess || per_cu < 1) fprintf(stderr, "kernel_launch: occupancy query reports %d\n", per_cu);
        (void)hipGetLastError();
        grid = cus;
    }
    return grid;
}
static void mk_launch(void* const* d_in, float* out, void* d_ws, int l_lo, int l_hi, int do_pro, int region, hipStream_t stream) {
    const int grid = mk_grid_setup(); if (grid < 0) return;
    Params p{};
    for (int i = 0; i < 17; ++i) p.in[i] = (const float*)d_in[i];
    p.out = out; p.ws = (unsigned char*)d_ws; p.l_lo = l_lo; p.l_hi = l_hi; p.do_pro = do_pro; p.bar_region = region;
    hipLaunchKernelGGL(mk_fwd, dim3(grid), dim3(NWAVES * 64), LDS_BYTES, stream, p);
    const hipError_t le = hipPeekAtLastError();
    if (le != hipSuccess) fprintf(stderr, "kernel_launch: launch failed: %s\n", hipGetErrorName(le));
}

#if !DEBUG_CHECK
extern "C" void kernel_launch(void* const* d_in, const int* in_sizes, int n_in, void* d_out, int out_size, void* d_ws, size_t ws_size, hipStream_t stream) {
    if (n_in != 17 || (size_t)out_size != O_END || ws_size < WS_END || in_sizes[0] != MP * 1024) { fprintf(stderr, "kernel_launch: unexpected sizes n_in %d out %d ws %zu\n", n_in, out_size, ws_size); return; }
    if (hipMemsetAsync((char*)d_ws + WS_CTL, 0, CTL_ZERO_BYTES, stream) != hipSuccess) return;
    mk_launch(d_in, (float*)d_out, d_ws, 0, DEPTH, 1, 0, stream);
}
#else
constexpr int C_PX = 0, C_PG = 512, C_Q = 1024, C_K = 2048, C_V = 3072, C_AG = 4096, C_GA = 5120, C_GB = 6144;
__device__ __forceinline__ float silu_f(float x) { return x / (1.f + __expf(-x)); }
__device__ __forceinline__ float sigmoid_f(float x) { return 1.f / (1.f + __expf(-x)); }
__global__ void __launch_bounds__(256) nv_ln(const float* in, const float* add, float alpha, const float* g, const float* b, float* out, int rows) {
    const int row = blockIdx.x * 4 + (threadIdx.x >> 6), lane = threadIdx.x & 63;
    if (row >= rows) return;
    const float4* xi = (const float4*)(in + (size_t)row * 1024) + lane;
    float4 v[4]; float s = 0.f;
#pragma unroll
    for (int j = 0; j < 4; ++j) {
        v[j] = xi[64 * j];
        if (add) { const float4 a = ((const float4*)(add + (size_t)row * 1024) + lane)[64 * j]; v[j].x = alpha * v[j].x + a.x; v[j].y = alpha * v[j].y + a.y; v[j].z = alpha * v[j].z + a.z; v[j].w = alpha * v[j].w + a.w; }
        s += (v[j].x + v[j].y) + (v[j].z + v[j].w);
    }
    const float mean = wave_sum(s) * (1.f / 1024.f); float s2 = 0.f;
#pragma unroll
    for (int j = 0; j < 4; ++j) { v[j].x -= mean; v[j].y -= mean; v[j].z -= mean; v[j].w -= mean; s2 += (v[j].x * v[j].x + v[j].y * v[j].y) + (v[j].z * v[j].z + v[j].w * v[j].w); }
    const float rstd = 1.f / sqrtf(wave_sum(s2) * (1.f / 1024.f) + LN_EPS);
    float4* o = (float4*)(out + (size_t)row * 1024) + lane;
#pragma unroll
    for (int j = 0; j < 4; ++j) { const float4 gg = ((const float4*)g + lane)[64 * j], bb = ((const float4*)b + lane)[64 * j];
        float4 r; r.x = v[j].x * rstd * gg.x + bb.x; r.y = v[j].y * rstd * gg.y + bb.y; r.z = v[j].z * rstd * gg.z + bb.z; r.w = v[j].w * rstd * gg.w + bb.w; o[64 * j] = r; }
}
__global__ void __launch_bounds__(256) nv_gemm(const float* __restrict__ A, int lda, const float* __restrict__ W, int ldw, float* __restrict__ C, int ldc, int K) {
    __shared__ float As[8][132];
    __shared__ float Ws[8][128];
    const int bm = blockIdx.y * 128, bn = blockIdx.x * 128, tid = threadIdx.x, tx = tid & 15, ty = tid >> 4;
    float acc[8][8];
#pragma unroll
    for (int i = 0; i < 8; ++i)
#pragma unroll
        for (int j = 0; j < 8; ++j) acc[i][j] = 0.f;
    const float* Ap = A + (size_t)(bm + (tid >> 1)) * lda + (tid & 1) * 4;
    const float* Wp = W + (size_t)(tid >> 5) * ldw + bn + (tid & 31) * 4;
    for (int k0 = 0; k0 < K; k0 += 8) {
        const float4 a = *(const float4*)(Ap + k0);
        const float4 w = *(const float4*)(Wp + (size_t)k0 * ldw);
        As[(tid & 1) * 4 + 0][tid >> 1] = a.x; As[(tid & 1) * 4 + 1][tid >> 1] = a.y; As[(tid & 1) * 4 + 2][tid >> 1] = a.z; As[(tid & 1) * 4 + 3][tid >> 1] = a.w;
        *(float4*)&Ws[tid >> 5][(tid & 31) * 4] = w;
        __syncthreads();
#pragma unroll
        for (int kk = 0; kk < 8; ++kk) {
            float av[8], bv[8];
#pragma unroll
            for (int i = 0; i < 8; ++i) av[i] = As[kk][ty * 8 + i];
#pragma unroll
            for (int j = 0; j < 8; ++j) bv[j] = Ws[kk][tx * 8 + j];
#pragma unroll
            for (int i = 0; i < 8; ++i)
#pragma unroll
                for (int j = 0; j < 8; ++j) acc[i][j] += av[i] * bv[j];
        }
        __syncthreads();
    }
#pragma unroll
    for (int i = 0; i < 8; ++i) {
        float* cp = C + (size_t)(bm + ty * 8 + i) * ldc + bn + tx * 8;
        *(float4*)cp = make_float4(acc[i][0], acc[i][1], acc[i][2], acc[i][3]);
        *(float4*)(cp + 4) = make_float4(acc[i][4], acc[i][5], acc[i][6], acc[i][7]);
    }
}
__global__ void nv_lambda(const float* lq, float* lam) {
    const int l = threadIdx.x;
    if (l < DEPTH) {
        float s1 = 0.f, s2 = 0.f;
        for (int i = 0; i < 64; ++i) { s1 += lq[l * 256 + i] * lq[l * 256 + 64 + i]; s2 += lq[l * 256 + 128 + i] * lq[l * 256 + 192 + i]; }
        const float li = 0.8f - 0.6f * expf(-0.3f * (float)l);
        lam[l] = expf(s1) - expf(s2) + li; lam[4 + l] = li;
    }
}
__global__ void __launch_bounds__(256) nv_rope_split(float* H, float* out, int layer) {
    const int row = blockIdx.x;
    const bool samp = row >= MP;
    const int pos = samp ? PAST + ((row - MP) & 15) : (row & (SEQ - 1));
    float* h = H + (size_t)row * D_IN;
    float* ko = samp ? out + O_KS + ((size_t)layer * MS + (row - MP)) * 1024 : out + O_KP + ((size_t)layer * MP + row) * 1024;
    float* vo = samp ? out + O_VS + ((size_t)layer * MS + (row - MP)) * 1024 : out + O_VP + ((size_t)layer * MP + row) * 1024;
    for (int p = threadIdx.x; p < 1024; p += 256) {
        const int pp = p & 511, blk = pp >> 5, i = pp & 31;
        const int c = (p < 512 ? C_Q : C_K) + blk * 64 + i;
        const double inv = exp(-(double)i / 32.0 * 9.210340371976184);
        const double ang = (double)pos * inv;
        const float cs = (float)cos(ang), sn = (float)sin(ang);
        const float x1 = h[c], x2 = h[c + 32];
        const float r1 = x1 * cs - x2 * sn, r2 = x2 * cs + x1 * sn;
        h[c] = r1; h[c + 32] = r2;
        if (p >= 512) { ko[blk * 64 + i] = r1; ko[blk * 64 + i + 32] = r2; }
    }
    for (int c = threadIdx.x; c < 1024; c += 256) vo[c] = h[C_V + c];
    if (!samp) { const int t = row & (SEQ - 1), b = row >> 12;
        if (t >= SEQ - 15) { float* po = out + O_PP + (((size_t)layer * BATCH + b) * 15 + (t - (SEQ - 15))) * 512; for (int c = threadIdx.x; c < 512; c += 256) po[c] = h[C_PX + c]; }
    } else { const int j = (row - MP) & 15, b = (row - MP) >> 4;
        if (j >= 1) { float* po = out + O_PS + (((size_t)layer * DEC_BATCH + b) * 15 + (j - 1)) * 512; for (int c = threadIdx.x; c < 512; c += 256) po[c] = h[C_PX + c]; }
    }
}
__global__ void __launch_bounds__(256) nv_pool(const float* H, const float* state_pool_l, float* pooled) {
    const int row = blockIdx.x;
    const bool samp = row >= MP;
    for (int c = threadIdx.x; c < 512; c += 256) {
        const int g = c >> 7, w = 2 << g;
        float s = 0.f; int cnt;
        if (!samp) { const int t = row & (SEQ - 1); cnt = (t + 1 < w) ? t + 1 : w;
            for (int d = 0; d < cnt; ++d) s += H[(size_t)(row - d) * D_IN + C_PX + c];
        } else { const int j = (row - MP) & 15, b = (row - MP) >> 4; cnt = w;
            for (int d = 0; d < w; ++d) { const int jj = j - d;
                s += (jj >= 0) ? H[(size_t)(row - d) * D_IN + C_PX + c] : state_pool_l[((size_t)b * 15 + (15 + jj)) * 512 + c]; }
        }
        pooled[(size_t)row * 512 + c] = s / (float)cnt - H[(size_t)row * D_IN + C_PX + c];
    }
}
__global__ void __launch_bounds__(256) nv_ya_gate(float* ya, const float* H, const float* pool_scale_l) {
    const int row = blockIdx.x;
    for (int c = threadIdx.x; c < 512; c += 256) ya[(size_t)row * 512 + c] *= pool_scale_l[c] * silu_f(H[(size_t)row * D_IN + C_PG + c]);
}
__global__ void __launch_bounds__(64) nv_attn(const float* __restrict__ H, int rowbase0, int rows_per_batch, int nq,
                                             const float* __restrict__ cK, const float* __restrict__ cV, int n1, int causal, float* O1, float* O2) {
    __shared__ float Ks[16][64];
    __shared__ float Vs[16][128];
    const int qb = blockIdx.x, hm = blockIdx.y, b = blockIdx.z, h = hm >> 1, mp = hm & 1, t = threadIdx.x;
    const int rowb = rowbase0 + b * rows_per_batch;
    const int qrow = rowb + qb * 64 + t;
    const bool act = t < nq;
    float q[64];
#pragma unroll
    for (int d = 0; d < 64; ++d) q[d] = act ? H[(size_t)qrow * D_IN + C_Q + h * 128 + mp * 64 + d] * 0.125f : 0.f;
    float o[128];
#pragma unroll
    for (int d = 0; d < 128; ++d) o[d] = 0.f;
    float mx = -INFINITY, l = 0.f;
    const int n2 = causal ? (qb + 1) * 64 : rows_per_batch;
    const int ntot = n1 + n2;
    for (int k0 = 0; k0 < ntot; k0 += 16) {
        __syncthreads();
#pragma unroll
        for (int i = 0; i < 16; ++i) { const int idx = i * 64 + t, kj = idx >> 6, d = idx & 63, key = k0 + kj;
            float v = 0.f;
            if (key < ntot) v = (key < n1) ? cK[((size_t)b * n1 + key) * 1024 + h * 128 + mp * 64 + d] : H[(size_t)(rowb + key - n1) * D_IN + C_K + h * 128 + mp * 64 + d];
            Ks[kj][d] = v; }
#pragma unroll
        for (int i = 0; i < 32; ++i) { const int idx = i * 64 + t, kj = idx >> 7, d = idx & 127, key = k0 + kj;
            float v = 0.f;
            if (key < ntot) v = (key < n1) ? cV[((size_t)b * n1 + key) * 1024 + h * 128 + d] : H[(size_t)(rowb + key - n1) * D_IN + C_V + h * 128 + d];
            Vs[kj][d] = v; }
        __syncthreads();
        const int kend = (ntot - k0 < 16) ? ntot - k0 : 16;
        for (int kj = 0; kj < kend; ++kj) {
            float s = 0.f;
#pragma unroll
            for (int d = 0; d < 64; ++d) s += q[d] * Ks[kj][d];
            const float mn = fmaxf(mx, s), f = __expf(mx - mn), p = __expf(s - mn);
            l = l * f + p; mx = mn;
#pragma unroll
            for (int d = 0; d < 128; ++d) o[d] = o[d] * f + p * Vs[kj][d];
        }
    }
    if (act) { float* O = (mp ? O2 : O1) + (size_t)qrow * 1024 + h * 128; const float il = 1.f / l;
#pragma unroll
        for (int d = 0; d < 128; d += 4) *(float4*)(O + d) = make_float4(o[d] * il, o[d + 1] * il, o[d + 2] * il, o[d + 3] * il); }
}
__global__ void __launch_bounds__(256) nv_combine(const float* O1, const float* O2, const float* lam, int layer, const float* subln_l, const float* H, float* YB) {
    const int idx = blockIdx.x * 4 + (threadIdx.x >> 6), lane = threadIdx.x & 63;
    const int row = idx >> 3, h = idx & 7;
    const float lm = lam[layer], li = lam[4 + layer];
    const size_t base = (size_t)row * 1024 + h * 128;
    const float a0 = O1[base + lane] - lm * O2[base + lane], a1 = O1[base + 64 + lane] - lm * O2[base + 64 + lane];
    const float ms = wave_sum(a0 * a0 + a1 * a1) * (1.f / 128.f);
    const float r = 1.f / sqrtf(ms + RMS_EPS) * (1.f - li);
    YB[base + lane] = a0 * r * subln_l[lane] * silu_f(H[(size_t)row * D_IN + C_AG + h * 128 + lane]);
    YB[base + 64 + lane] = a1 * r * subln_l[64 + lane] * silu_f(H[(size_t)row * D_IN + C_AG + h * 128 + 64 + lane]);
}
__global__ void __launch_bounds__(256) nv_merge(float* TA, const float* TB, const float* H) {
    const int row = blockIdx.x;
    for (int c = threadIdx.x; c < 1024; c += 256) { const size_t i = (size_t)row * 1024 + c;
        TA[i] = sigmoid_f(H[(size_t)row * D_IN + C_GA + c]) * TA[i] + sigmoid_f(H[(size_t)row * D_IN + C_GB + c]) * TB[i]; }
}
__global__ void __launch_bounds__(256) dbg_cmp(const void* a, int a_bf16, int lda, const float* b, int ldb, int rows, int cols, float ascale, int bact, float* err, int slot) {
    __shared__ float red[2][4];
    float num = 0.f, den = 0.f;
    const size_t n = (size_t)rows * cols;
    for (size_t i = (size_t)blockIdx.x * 256 + threadIdx.x; i < n; i += (size_t)gridDim.x * 256) {
        const size_t r = i / cols, c = i % cols;
        float av = a_bf16 ? __uint_as_float((unsigned)((const unsigned short*)a)[r * lda + c] << 16) : ((const float*)a)[r * lda + c];
        float bv = b[r * ldb + c];
        if (bact == 1) bv = silu_f(bv); else if (bact == 2) bv = sigmoid_f(bv);
        const float d = av * ascale - bv; num += d * d; den += bv * bv;
    }
    num = wave_sum(num); den = wave_sum(den);
    if ((threadIdx.x & 63) == 0) { red[0][threadIdx.x >> 6] = num; red[1][threadIdx.x >> 6] = den; }
    __syncthreads();
    if (threadIdx.x == 0) { atomicAdd(err + 2 * slot, red[0][0] + red[0][1] + red[0][2] + red[0][3]); atomicAdd(err + 2 * slot + 1, red[1][0] + red[1][1] + red[1][2] + red[1][3]); }
}
#ifndef DBG_SLOT
#define DBG_SLOT -1
#endif
__global__ void dbg_final(const float* err, int nslots, float tol, float* pool_sample, int n) {
    __shared__ float sc;
    if (threadIdx.x == 0) {
        float s = 1.f;
        if (DBG_SLOT >= 0) { const float e = err[2 * DBG_SLOT] / fmaxf(err[2 * DBG_SLOT + 1], 1e-30f); s = 1.f + sqrtf(fminf(e, 4.f)); }
        else { for (int i = 0; i < nslots; ++i) { const float e = err[2 * i] / fmaxf(err[2 * i + 1], 1e-30f); if (!(e <= tol)) { s = 1.f + 0.01f * (float)(i + 1); break; } } }
        sc = s;
    }
    __syncthreads();
    for (int i = blockIdx.x * 256 + threadIdx.x; i < n; i += gridDim.x * 256) pool_sample[i] *= sc;
}
#define NSLOT_L 24
extern "C" void kernel_launch(void* const* d_in, const int* in_sizes, int n_in, void* d_out, int out_size, void* d_ws, size_t ws_size, hipStream_t stream) {
    const float* x_prompt = (const float*)d_in[0]; const float* x_sample = (const float*)d_in[1];
    const float* cache_k = (const float*)d_in[2]; const float* cache_v = (const float*)d_in[3]; const float* state_pool = (const float*)d_in[4];
    const float* ln_in_g = (const float*)d_in[5]; const float* ln_in_b = (const float*)d_in[6]; const float* w_in = (const float*)d_in[7];
    const float* w_pool = (const float*)d_in[8]; const float* pool_scale = (const float*)d_in[9]; const float* lambda_qk = (const float*)d_in[10];
    const float* subln_w = (const float*)d_in[11]; const float* w_a = (const float*)d_in[12]; const float* w_b = (const float*)d_in[13];
    const float* w_o = (const float*)d_in[14]; const float* ln_g = (const float*)d_in[15]; const float* ln_b = (const float*)d_in[16];
    float* out = (float*)d_out;
    const size_t R = RB4;
    const size_t NV0 = 1300 * MiB;
    const size_t NV_END = NV0 + 4096 + R + (size_t)M * D_IN * 4 + 7 * R;
    const size_t OUT2 = NV_END;
    const size_t need = OUT2 + O_END * 4;
    if (n_in != 17 || (size_t)out_size != O_END || ws_size < need) { fprintf(stderr, "kernel_launch: unexpected sizes n_in %d out %d ws %zu need %zu\n", n_in, out_size, ws_size, need); return; }
    unsigned char* ws = (unsigned char*)d_ws;
    hipMemsetAsync(ws + WS_CTL, 0, CTL_ZERO_BYTES, stream);
    float* ERR = (float*)(ws + WS_CTL + 512 * 1024);
    float* LAM = (float*)(ws + NV0);
    float* X = (float*)(ws + NV0 + 4096);
    float* H = (float*)(ws + NV0 + 4096 + R);
    unsigned char* p = ws + NV0 + 4096 + R + (size_t)M * D_IN * 4;
    float* POOLED = (float*)p; float* YA = (float*)(p + R / 2);
    float* O1 = (float*)(p + R); float* O2 = (float*)(p + 2 * R); float* YB = (float*)(p + 3 * R);
    float* TA = (float*)(p + 4 * R); float* TB = (float*)(p + 5 * R); float* OUTB = (float*)(p + 6 * R);
    float* out2 = (float*)(ws + OUT2);
    const void* oXB = ws + WS_XB; const void* oPXB = ws + WS_PXB; const void* oSPG = ws + WS_SPG; const void* oQB = ws + WS_QB; const void* oKB = ws + WS_KB; const void* oVB = ws + WS_VB;
    const void* oSAG = ws + WS_SAG; const void* oSGA = ws + WS_SGA; const void* oSGB = ws + WS_SGB; const void* oO1 = ws + WS_O1; const void* oO2 = ws + WS_O2;
    const void* oYA = ws + WS_YA; const void* oYB = ws + WS_YB; const void* oMG = ws + WS_MG; const void* oX = ws + WS_X;
#define CMP(slot, a, abf, lda, b, ldb, rows, cols, asc, bact) dbg_cmp<<<1024, 256, 0, stream>>>(a, abf, lda, b, ldb, rows, cols, asc, bact, ERR, slot)

    nv_lambda<<<1, 64, 0, stream>>>(lambda_qk, LAM);
    nv_ln<<<MP / 4, 256, 0, stream>>>(x_prompt, nullptr, 1.f, ln_in_g, ln_in_b, X, MP);
    nv_ln<<<MS / 4, 256, 0, stream>>>(x_sample, nullptr, 1.f, ln_in_g, ln_in_b, X + (size_t)MP * 1024, MS);
    for (int l = 0; l < DEPTH; ++l) {
        const int s0 = l * NSLOT_L;
        mk_launch(d_in, out2, d_ws, l, l + 1, l == 0, l, stream);
        nv_gemm<<<dim3(D_IN / 128, M / 128), 256, 0, stream>>>(X, 1024, w_in + (size_t)l * 1024 * D_IN, D_IN, H, D_IN, 1024);
        nv_rope_split<<<M, 256, 0, stream>>>(H, out, l);
        nv_pool<<<M, 256, 0, stream>>>(H, state_pool + (size_t)l * DEC_BATCH * 15 * 512, POOLED);
        for (int g = 0; g < 4; ++g)
            nv_gemm<<<dim3(1, M / 128), 256, 0, stream>>>(POOLED + g * 128, 512, w_pool + ((size_t)l * 4 + g) * 128 * 128, 128, YA + g * 128, 512, 128);
        nv_ya_gate<<<M, 256, 0, stream>>>(YA, H, pool_scale + (size_t)l * 512);
        nv_attn<<<dim3(SEQ / 64, 16, BATCH), 64, 0, stream>>>(H, 0, SEQ, 64, nullptr, nullptr, 0, 1, O1, O2);
        nv_attn<<<dim3(1, 16, DEC_BATCH), 64, 0, stream>>>(H, MP, DEC_SEQ, DEC_SEQ, cache_k + (size_t)l * DEC_BATCH * PAST * 1024, cache_v + (size_t)l * DEC_BATCH * PAST * 1024, PAST, 0, O1, O2);
        nv_combine<<<M * 8 / 4, 256, 0, stream>>>(O1, O2, LAM, l, subln_w + (size_t)l * 128, H, YB);
        nv_gemm<<<dim3(1024 / 128, M / 128), 256, 0, stream>>>(YA, 512, w_a + (size_t)l * 512 * 1024, 1024, TA, 1024, 512);
        nv_gemm<<<dim3(1024 / 128, M / 128), 256, 0, stream>>>(YB, 1024, w_b + (size_t)l * 1024 * 1024, 1024, TB, 1024, 1024);
        nv_merge<<<M, 256, 0, stream>>>(TA, TB, H);
        nv_gemm<<<dim3(1024 / 128, M / 128), 256, 0, stream>>>(TA, 1024, w_o + (size_t)l * 1024 * 1024, 1024, OUTB, 1024, 1024);
        nv_ln<<<M / 4, 256, 0, stream>>>(X, OUTB, ALPHA, ln_g + (size_t)l * 1024, ln_b + (size_t)l * 1024, (l == DEPTH - 1) ? out + O_Y : X, M);
        CMP(s0 + 1, oPXB, 1, 512, H + C_PX, D_IN, M, 512, 1.f, 0);
        CMP(s0 + 2, oSPG, 1, 512, H + C_PG, D_IN, M, 512, 1.f, 1);
        CMP(s0 + 3, oVB, 1, 1024, H + C_V, D_IN, M, 1024, 1.f, 0);
        CMP(s0 + 4, oSAG, 1, 1024, H + C_AG, D_IN, M, 1024, 1.f, 1);
        CMP(s0 + 5, oSGA, 1, 1024, H + C_GA, D_IN, M, 1024, 1.f, 2);
        CMP(s0 + 6, oSGB, 1, 1024, H + C_GB, D_IN, M, 1024, 1.f, 2);
        CMP(s0 + 7, oKB, 1, 1024, H + C_K, D_IN, M, 1024, 1.f, 0);
        CMP(s0 + 8, oQB, 1, 1024, H + C_Q, D_IN, M, 1024, 1.f / C2, 0);
        CMP(s0 + 9, out2 + O_KP + (size_t)l * MP * 1024, 0, 1024, out + O_KP + (size_t)l * MP * 1024, 1024, MP, 1024, 1.f, 0);
        CMP(s0 + 10, out2 + O_VP + (size_t)l * MP * 1024, 0, 1024, out + O_VP + (size_t)l * MP * 1024, 1024, MP, 1024, 1.f, 0);
        CMP(s0 + 11, out2 + O_PP + (size_t)l * BATCH * 15 * 512, 0, 512, out + O_PP + (size_t)l * BATCH * 15 * 512, 512, BATCH * 15, 512, 1.f, 0);
        CMP(s0 + 12, out2 + O_KS + (size_t)l * MS * 1024, 0, 1024, out + O_KS + (size_t)l * MS * 1024, 1024, MS, 1024, 1.f, 0);
        CMP(s0 + 13, out2 + O_VS + (size_t)l * MS * 1024, 0, 1024, out + O_VS + (size_t)l * MS * 1024, 1024, MS, 1024, 1.f, 0);
        CMP(s0 + 14, out2 + O_PS + (size_t)l * DEC_BATCH * 15 * 512, 0, 512, out + O_PS + (size_t)l * DEC_BATCH * 15 * 512, 512, DEC_BATCH * 15, 512, 1.f, 0);
        CMP(s0 + 15, oYA, 1, 512, YA, 512, M, 512, 1.f, 0);
        CMP(s0 + 16, oO1, 0, 1024, O1, 1024, MP, 1024, 1.f, 0);
        CMP(s0 + 17, oO2, 0, 1024, O2, 1024, MP, 1024, 1.f, 0);
        CMP(s0 + 18, oYB, 1, 1024, YB, 1024, MP, 1024, 1.f, 0);
        CMP(s0 + 19, (const unsigned short*)oYB + (size_t)MP * 1024, 1, 1024, YB + (size_t)MP * 1024, 1024, MS, 1024, 1.f, 0);
        CMP(s0 + 20, oMG, 1, 1024, TA, 1024, M, 1024, 1.f, 0);
        CMP(s0 + 21, (l == DEPTH - 1) ? (const void*)(out2 + O_Y) : oX, 0, 1024, (l == DEPTH - 1) ? out + O_Y : X, 1024, M, 1024, 1.f, 0);
    }
    dbg_final<<<64, 256, 0, stream>>>(ERR, DEPTH * NSLOT_L, 1e-3f, out + O_PS, DEPTH * DEC_BATCH * 15 * 512);
}
#endif
```

```cpp
#include <hip/hip_runtime.h>
#include <hip/hip_bf16.h>
#include <cstdio>
#include <cstdint>
#include <cmath>

#ifndef DEBUG_CHECK
#define DEBUG_CHECK 0
#endif

constexpr int D_MODEL = 1024, BATCH = 8, SEQ = 4096, DEPTH = 4, DEC_BATCH = 32, DEC_SEQ = 16, PAST = 1024;
constexpr int D_POOL = 512, D_IN = 7168;
constexpr int MP = BATCH * SEQ, MS = DEC_BATCH * DEC_SEQ, M = MP + MS;
constexpr float LN_EPS = 1e-5f, RMS_EPS = 1e-5f;
constexpr float ALPHA = 1.681792830507429f;
constexpr float C2 = 0.125f * 1.4426950408889634f;
constexpr size_t O_Y = 0, O_KP = (size_t)M * 1024, O_VP = O_KP + (size_t)DEPTH * MP * 1024, O_PP = O_VP + (size_t)DEPTH * MP * 1024,
                 O_KS = O_PP + (size_t)DEPTH * BATCH * 15 * 512, O_VS = O_KS + (size_t)DEPTH * MS * 1024, O_PS = O_VS + (size_t)DEPTH * MS * 1024,
                 O_END = O_PS + (size_t)DEPTH * DEC_BATCH * 15 * 512;
constexpr size_t MiB = 1u << 20;
constexpr size_t RB2 = (size_t)M * 1024 * 2, RB4 = (size_t)M * 1024 * 4;
constexpr size_t WS_CTL = 0, CTL_ZERO_BYTES = 1 * MiB;
constexpr size_t WS_LAM = 1 * MiB;
constexpr size_t WS_ROPEC = 2 * MiB, WS_ROPES = WS_ROPEC + 512 * 1024;
constexpr size_t WS_WIN = 4 * MiB, WS_WA = 60 * MiB, WS_WB = 64 * MiB, WS_WO = 72 * MiB, WS_WP = 80 * MiB;
constexpr size_t WS_X = 96 * MiB;
constexpr size_t WS_XB = WS_X + RB4;
constexpr size_t WS_PXB = WS_XB + RB2;
constexpr size_t WS_SPG = WS_PXB + RB2 / 2;
constexpr size_t WS_QB = WS_SPG + RB2 / 2, WS_KB = WS_QB + RB2, WS_VB = WS_KB + RB2;
constexpr size_t WS_SAG = WS_VB + RB2, WS_SGA = WS_SAG + RB2, WS_SGB = WS_SGA + RB2;
constexpr size_t WS_O1 = WS_SGB + RB2, WS_O2 = WS_O1 + RB4;
constexpr size_t WS_YA = WS_O2 + RB4, WS_YB = WS_YA + RB2 / 2;
constexpr size_t WS_TMPA = WS_YB + RB2, WS_MG = WS_TMPA + RB4;
constexpr size_t WS_END = WS_MG + RB2;
static_assert(WS_END <= 1300 * MiB && WS_WP + 512 * 1024 <= WS_X && WS_WIN + (size_t)DEPTH * D_IN * 1024 * 2 <= WS_WA, "d_ws map");
constexpr int CW_BAR = 4096;
constexpr int RING_OFF = 0, RING_BYTES = 131072;
constexpr int LDSCTL_OFF = RING_BYTES, MISC_OFF = LDSCTL_OFF + 320;
constexpr int LDS_BYTES = 147456;
constexpr int NWAVES = 8;
#ifndef REP_P0
#define REP_P0 1
#endif
#ifndef REP_P1
#define REP_P1 1
#endif
#ifndef REP_SAMPLE
#define REP_SAMPLE 1
#endif
#ifndef REP_POOL
#define REP_POOL 1
#endif
#ifndef REP_ATTN
#define REP_ATTN 1
#endif
#ifndef REP_P3
#define REP_P3 1
#endif
namespace pg8 {
#define PG8_LAS __attribute__((address_space(3)))
typedef unsigned short bf16_t;
typedef short bf16x8 __attribute__((ext_vector_type(8)));
typedef float f32x4 __attribute__((ext_vector_type(4)));
typedef unsigned u32x4 __attribute__((ext_vector_type(4)));
constexpr int BM = 256, BK = 64, HALF = 128, HTB = HALF * BK * 2  , STAGE_BYTES = 8 * HTB, NXCD = 8, WGM = 8;

__host__ __device__ __forceinline__ int lds_byte(int r, int c) { const int st = (r >> 4) * 2 + (c >> 5), rr = r & 15, cc = c & 31, ob = rr * 64 + cc * 2; return st * 1024 + (ob ^ (((ob >> 9) & 1) << 5)); }
__host__ __device__ __forceinline__ void stage_rc(int b, int& R, int& C) { const int st = b / 1024, sb = b % 1024, swz = sb ^ (((sb >> 9) & 1) << 5); R = (st >> 1) * 16 + swz / 64; C = (st & 1) * 32 + (swz % 64) / 2; }
__host__ __device__ __forceinline__ int perm32(int rho) { const int n = rho >> 4, i = rho & 15; return 8 * (i >> 2) + 4 * n + (i & 3); }

struct Unit { int pm, pn; };
struct Gemm { const bf16_t* A; const bf16_t* Bt; int M, N, K; };

struct StaticOrder {
    int nM, nN, nwg, G, c;
    __host__ __device__ void init(int M, int N, int G_, int c_) { nM = M / BM; nN = N / BM; nwg = nM * nN; G = G_; c = c_; }
    __host__ __device__ bool next(int i, Unit& u) const {
        const long L = (long)i * G + c; if (L >= nwg) return false;
        int wgid = (int)L; { const int q = nwg / NXCD, r = nwg % NXCD, xcd = wgid % NXCD, off = wgid / NXCD; wgid = (xcd < r ? xcd * (q + 1) : r * (q + 1) + (xcd - r) * q) + off; }
        const int nig = WGM * nN, gid = wgid / nig, fm = gid * WGM, gsz = (nM - fm) < WGM ? (nM - fm) : WGM;
        u.pm = fm + ((wgid % nig) % gsz); u.pn = (wgid % nig) / gsz; return true;
    }
    __device__ __forceinline__ void a_ready(const Unit&) const {}
    __device__ __forceinline__ void done(const Unit&) const {}
};

__device__ __forceinline__ unsigned cvt_pk_bf16(float lo, float hi) { unsigned r; asm volatile("v_cvt_pk_bf16_f32 %0, %1, %2" : "=v"(r) : "v"(lo), "v"(hi)); return r; }
typedef float f32x2 __attribute__((ext_vector_type(2)));
template <class Epi, class Sched, bool ALIGN_EPI = false, bool SP2 = false>
__device__ __forceinline__ void gemm_phase(PG8_LAS unsigned char* lds, const Gemm g, const Sched& S, const Epi& E) {
    int tid_o = threadIdx.x; asm volatile("" : "+v"(tid_o));
    const int tid = tid_o, wid = __builtin_amdgcn_readfirstlane(tid >> 6), lane = tid & 63, wr = wid >> 2, wc = wid & 3, fr = lane & 15, fq = lane >> 4;
    const int K = g.K, nt = K / BK;
    unsigned voffA[2], voffB[2];
#pragma unroll
    for (int i = 0; i < 2; ++i) { int R, C; stage_rc(tid * 16 + i * 8192, R, C); const int Rb = Epi::PERM ? ((R & ~31) + perm32(R & 31)) : R;
        voffA[i] = (unsigned)(R * K + C) * 2u; voffB[i] = (unsigned)(Rb * K + C) * 2u; }
    const size_t kstep = (size_t)(BK * 2);
    const size_t hstep = (size_t)HALF * K * 2;
    const size_t tstep = 2 * hstep;
    const unsigned ldsw = (unsigned)wid * 1024u;
    const int aoff = lds_byte(wr * 64 + fr, fq * 8), boff = lds_byte(wc * 32 + fr, fq * 8);
#define PG8_SA(b, h) (((b) * 2 + (h)) * HTB)
#define PG8_SB(b, h) ((4 + (b) * 2 + (h)) * HTB)
#define PG8_STAGE(bufoff, gbase, voff) do { _Pragma("unroll") for (int _i = 0; _i < 2; ++_i) \
        __builtin_amdgcn_global_load_lds((const unsigned*)((const char*)(gbase) + (voff)[_i]), (PG8_LAS unsigned*)(lds + (bufoff) + ldsw + _i * 8192), 16, 0, 0); } while (0)
#define PG8_LDA(dst, b, h) do { _Pragma("unroll") for (int m = 0; m < 4; ++m) _Pragma("unroll") for (int k = 0; k < 2; ++k) dst[m][k] = *(const PG8_LAS bf16x8*)(lds + PG8_SA(b, h) + aoff + m * 2048 + k * 1024); } while (0)
#define PG8_LDB(dst, b, h) do { _Pragma("unroll") for (int n = 0; n < 2; ++n) _Pragma("unroll") for (int k = 0; k < 2; ++k) dst[n][k] = *(const PG8_LAS bf16x8*)(lds + PG8_SB(b, h) + boff + n * 2048 + k * 1024); } while (0)
#define PG8_MMA(ai, bj, At, Bt) do { __builtin_amdgcn_s_setprio(1); _Pragma("unroll") for (int m = 0; m < 4; ++m) _Pragma("unroll") for (int n = 0; n < 2; ++n) _Pragma("unroll") for (int k = 0; k < 2; ++k) \
        acc[ai][bj][m][n] = __builtin_amdgcn_mfma_f32_16x16x32_bf16(Bt[n][k], At[m][k], acc[ai][bj][m][n], 0, 0, 0); __builtin_amdgcn_s_setprio(0); } while (0)
#define PG8_WAIT_V(n) asm volatile("s_waitcnt vmcnt(" #n ")" ::: "memory")
#define PG8_WAIT_L(n) asm volatile("s_waitcnt lgkmcnt(" #n ")" ::: "memory")
#define PG8_BAR __builtin_amdgcn_s_barrier()
#define PG8_SCHED __builtin_amdgcn_sched_barrier(0)
    Unit cur, nxt; int ui = 0;
    if (!S.next(0, cur)) return;
    f32x4 acc[2][2][4][2];
#pragma unroll
    for (int a = 0; a < 2; ++a)
#pragma unroll
        for (int b = 0; b < 2; ++b)
#pragma unroll
            for (int m = 0; m < 4; ++m)
#pragma unroll
                for (int n = 0; n < 2; ++n) acc[a][b][m][n] = (f32x4){0.f, 0.f, 0.f, 0.f};
    bf16x8 At[4][2], B0[2][2], B1[2][2];
    const char* cA = (const char*)g.A + (size_t)cur.pm * tstep; const char* cB = (const char*)g.Bt + (size_t)cur.pn * tstep;
    S.a_ready(cur);
    if constexpr (SP2) {
        PG8_STAGE(PG8_SB(0, 0), cB, voffB); PG8_STAGE(PG8_SB(0, 1), cB + hstep, voffB); PG8_STAGE(PG8_SA(0, 0), cA, voffA); PG8_STAGE(PG8_SA(0, 1), cA + hstep, voffA);
        if (wr == 1) PG8_BAR;
        PG8_WAIT_V(2); PG8_BAR;
        PG8_STAGE(PG8_SB(1, 0), cB + kstep, voffB); PG8_STAGE(PG8_SA(1, 0), cA + kstep, voffA); PG8_STAGE(PG8_SB(1, 1), cB + hstep + kstep, voffB);
        PG8_WAIT_V(6); PG8_BAR;
    } else {
        PG8_STAGE(PG8_SB(0, 0), cB, voffB); PG8_STAGE(PG8_SA(0, 0), cA, voffA); PG8_STAGE(PG8_SB(0, 1), cB + hstep, voffB); PG8_STAGE(PG8_SA(0, 1), cA + hstep, voffA);
        if (wr == 1) PG8_BAR;
        PG8_WAIT_V(4); PG8_BAR;
        PG8_STAGE(PG8_SB(1, 0), cB + kstep, voffB); PG8_STAGE(PG8_SA(1, 0), cA + kstep, voffA); PG8_STAGE(PG8_SB(1, 1), cB + hstep + kstep, voffB);
        PG8_WAIT_V(6); PG8_BAR;
    }
    for (;;) {
        const bool has_next = S.next(ui + 1, nxt);
        const char* nA = has_next ? (const char*)g.A + (size_t)nxt.pm * tstep : cA; const char* nB = has_next ? (const char*)g.Bt + (size_t)nxt.pn * tstep : cB;
        for (int t = 0; t < nt; t += 2) {
            const bool last = (t == nt - 2);
            const char* a1 = cA + (size_t)(t + 1) * kstep;
            const char* a2 = last ? nA : cA + (size_t)(t + 2) * kstep; const char* b2 = last ? nB : cB + (size_t)(t + 2) * kstep;
            const char* a3 = a2 + kstep; const char* b3 = b2 + kstep;
            if (last && has_next) S.a_ready(nxt);
            if constexpr (SP2) {
            PG8_LDB(B0, 0, 0); PG8_LDB(B1, 0, 1); PG8_SCHED; PG8_LDA(At, 0, 0); PG8_STAGE(PG8_SA(1, 1), a1 + hstep, voffA);
            PG8_WAIT_V(8); PG8_WAIT_L(0); PG8_BAR; PG8_MMA(0, 0, At, B0); PG8_MMA(0, 1, At, B1); PG8_BAR; PG8_SCHED;
            PG8_LDA(At, 0, 1); PG8_STAGE(PG8_SB(0, 0), b2, voffB); PG8_STAGE(PG8_SB(0, 1), b2 + hstep, voffB); PG8_STAGE(PG8_SA(0, 0), a2, voffA);
            PG8_WAIT_V(8); PG8_WAIT_L(0); PG8_BAR; PG8_MMA(1, 0, At, B0); PG8_MMA(1, 1, At, B1); PG8_BAR; PG8_SCHED;
            PG8_LDB(B0, 1, 0); PG8_LDB(B1, 1, 1); PG8_SCHED; PG8_LDA(At, 1, 0); PG8_STAGE(PG8_SA(0, 1), a2 + hstep, voffA);
            PG8_WAIT_V(8); PG8_WAIT_L(0); PG8_BAR; PG8_MMA(0, 0, At, B0); PG8_MMA(0, 1, At, B1); PG8_BAR; PG8_SCHED;
            PG8_LDA(At, 1, 1); PG8_STAGE(PG8_SB(1, 0), b3, voffB); PG8_STAGE(PG8_SB(1, 1), b3 + hstep, voffB); PG8_STAGE(PG8_SA(1, 0), a3, voffA);
            PG8_WAIT_V(8); PG8_WAIT_L(0); PG8_BAR; PG8_MMA(1, 0, At, B0); PG8_MMA(1, 1, At, B1); PG8_BAR; PG8_SCHED;
            } else {
            PG8_LDB(B0, 0, 0); PG8_SCHED; PG8_LDA(At, 0, 0); PG8_STAGE(PG8_SA(1, 1), a1 + hstep, voffA);
            PG8_WAIT_L(8); PG8_BAR; PG8_WAIT_L(0); PG8_MMA(0, 0, At, B0); PG8_BAR; PG8_SCHED;
            PG8_LDB(B1, 0, 1); PG8_STAGE(PG8_SB(0, 0), b2, voffB);
            PG8_BAR; PG8_WAIT_L(0); PG8_MMA(0, 1, At, B1); PG8_BAR;
            PG8_LDA(At, 0, 1); PG8_STAGE(PG8_SA(0, 0), a2, voffA);
            PG8_BAR; PG8_WAIT_L(0); PG8_MMA(1, 0, At, B0); PG8_BAR; PG8_SCHED;
            PG8_STAGE(PG8_SB(0, 1), b2 + hstep, voffB);
            PG8_WAIT_V(6); PG8_BAR; PG8_MMA(1, 1, At, B1); PG8_BAR;
            PG8_LDB(B0, 1, 0); PG8_SCHED; PG8_LDA(At, 1, 0); PG8_STAGE(PG8_SA(0, 1), a2 + hstep, voffA);
            PG8_WAIT_L(8); PG8_BAR; PG8_WAIT_L(0); PG8_MMA(0, 0, At, B0); PG8_BAR; PG8_SCHED;
            PG8_LDB(B1, 1, 1); PG8_STAGE(PG8_SB(1, 0), b3, voffB);
            PG8_BAR; PG8_WAIT_L(0); PG8_MMA(0, 1, At, B1); PG8_BAR;
            PG8_LDA(At, 1, 1); PG8_STAGE(PG8_SA(1, 0), a3, voffA);
            PG8_BAR; PG8_WAIT_L(0); PG8_MMA(1, 0, At, B0); PG8_BAR; PG8_SCHED;
            PG8_STAGE(PG8_SB(1, 1), b3 + hstep, voffB);
            PG8_WAIT_V(6); PG8_BAR; PG8_MMA(1, 1, At, B1); PG8_BAR;
            }
        }
        if constexpr (ALIGN_EPI) { if (wr == 0) PG8_BAR; }
        if constexpr (!Epi::AFTER_DRAIN) { E(acc, cur, wr, wc, fr, fq); S.done(cur); }
        if (!has_next) break;
#pragma unroll
        for (int a = 0; a < 2; ++a)
#pragma unroll
            for (int b = 0; b < 2; ++b)
#pragma unroll
                for (int m = 0; m < 4; ++m)
#pragma unroll
                    for (int n = 0; n < 2; ++n) acc[a][b][m][n] = (f32x4){0.f, 0.f, 0.f, 0.f};
        cur = nxt; cA = nA; cB = nB; ++ui;
        if constexpr (ALIGN_EPI) { if (wr == 1) PG8_BAR; }
    }
    PG8_WAIT_V(0);
    if constexpr (!ALIGN_EPI) { if (wr == 0) PG8_BAR; }
    PG8_BAR;
    if constexpr (Epi::AFTER_DRAIN) { E.fused(acc, cur, wr, wc, fr, fq, lds, wid, lane); S.done(cur); }
#undef PG8_SA
#undef PG8_SB
#undef PG8_STAGE
#undef PG8_LDA
#undef PG8_LDB
#undef PG8_MMA
#undef PG8_WAIT_V
#undef PG8_WAIT_L
#undef PG8_BAR
#undef PG8_SCHED
}
}
#include <hip/hip_bf16.h>
#include <cmath>
namespace attn_body {
using bf16=__hip_bfloat16;
using bf16x8=__attribute__((ext_vector_type(8)))short;
using s16x4=__attribute__((ext_vector_type(4)))short;
using f32x16=__attribute__((ext_vector_type(16)))float;
using u32x4=__attribute__((ext_vector_type(4)))unsigned;
constexpr int D=64,DM=1024;
constexpr int NW=8,QBLK=32,QB=QBLK*NW,KVBLK=64;
constexpr int ATTN_PITCH=DM, ATTN_UNIT_ROWS=QB;
__device__ __forceinline__ int crow(int r,int hi){return (r&3)+8*(r>>2)+4*hi;}
#define SBAR() __builtin_amdgcn_sched_barrier(0)
__device__ __forceinline__ void cmask(f32x16&p0,f32x16&p1,int jb,int qchunk){
  const float NEG=-INFINITY;
  if(jb>qchunk){
  #pragma unroll
  for(int r=0;r<16;++r){p0[r]=NEG;p1[r]=NEG;} }
}
constexpr int NSLOT=3, SLOTB=8192;
constexpr int LDS_K=0, LDS_V=NSLOT*SLOTB, LDS_WS=2*NSLOT*SLOTB, LDS_OST=LDS_WS+NW*64*4, LDS_BYTES=LDS_OST+NW*8192;
constexpr float C2=0.125f*1.4426950408889634f;
__device__ __forceinline__ void glds16(const void*gsrc,unsigned lds_dst){unsigned keep;
  asm volatile("s_mov_b32 %0, m0\n\ts_mov_b32 m0, %2\n\ts_nop 0\n\tglobal_load_lds_dwordx4 %1, off\n\ts_mov_b32 m0, %0":"=&s"(keep):"v"(gsrc),"s"(lds_dst):"memory");}
__device__ __forceinline__ float max3f(float a,float b,float c){float r;asm("v_max3_f32 %0, %1, %2, %3":"=v"(r):"v"(a),"v"(b),"v"(c));return r;}
__device__ __forceinline__ float max2f(float a,float b){float r;asm("v_max_f32_e32 %0, %1, %2":"=v"(r):"v"(a),"v"(b));return r;}
__device__ __forceinline__ float fadd_s(float a,float b){float r;asm("v_add_f32_e32 %0, %1, %2":"=v"(r):"v"(a),"v"(b));return r;}
__device__ __forceinline__ float fsub_s(float a,float b){float r;asm("v_sub_f32_e32 %0, %1, %2":"=v"(r):"v"(a),"v"(b));return r;}
typedef float f32x2_t __attribute__((ext_vector_type(2))); typedef __bf16 bf16x2_t __attribute__((ext_vector_type(2)));
__device__ __forceinline__ unsigned cvtpk_s(float lo,float hi){f32x2_t v={lo,hi};bf16x2_t b=__builtin_convertvector(v,bf16x2_t);return __builtin_bit_cast(unsigned,b);}
#define WAIT_BAR(N) asm volatile("s_waitcnt vmcnt(" #N ") lgkmcnt(0)\n\ts_barrier":::"memory")

__device__ __forceinline__ void qkt(f32x16&p0,f32x16&p1,const char*Kslot,const bf16x8*qr,const f32x16&negm,int r32,int hi){
  const char*kb=Kslot+hi*1024+r32*16;
  #pragma unroll
  for(int d0=0;d0<4;++d0){
    const bf16x8 b0=*reinterpret_cast<const bf16x8*>(kb+d0*2048);
    const bf16x8 b1=*reinterpret_cast<const bf16x8*>(kb+d0*2048+512);
    if(d0==0){p0=__builtin_amdgcn_mfma_f32_32x32x16_bf16(b0,qr[0],negm,0,0,0);p1=__builtin_amdgcn_mfma_f32_32x32x16_bf16(b1,qr[0],negm,0,0,0);}
    else{p0=__builtin_amdgcn_mfma_f32_32x32x16_bf16(b0,qr[d0],p0,0,0,0);p1=__builtin_amdgcn_mfma_f32_32x32x16_bf16(b1,qr[d0],p1,0,0,0);}}
}
typedef __attribute__((address_space(3))) const char* lds_cptr;
typedef short v4i16_t __attribute__((ext_vector_type(4)));
__device__ __forceinline__ void kload8(bf16x8*kf,lds_cptr kp){
  kf[0]=*(const __attribute__((address_space(3))) bf16x8*)(kp);      kf[1]=*(const __attribute__((address_space(3))) bf16x8*)(kp+512);
  kf[2]=*(const __attribute__((address_space(3))) bf16x8*)(kp+2048); kf[3]=*(const __attribute__((address_space(3))) bf16x8*)(kp+2560);
  kf[4]=*(const __attribute__((address_space(3))) bf16x8*)(kp+4096); kf[5]=*(const __attribute__((address_space(3))) bf16x8*)(kp+4608);
  kf[6]=*(const __attribute__((address_space(3))) bf16x8*)(kp+6144); kf[7]=*(const __attribute__((address_space(3))) bf16x8*)(kp+6656);
}
__device__ __forceinline__ void kload2(bf16x8*kf,lds_cptr kp,int j){ kf[2*j]=*(const __attribute__((address_space(3))) bf16x8*)(kp+j*2048); kf[2*j+1]=*(const __attribute__((address_space(3))) bf16x8*)(kp+j*2048+512); }
__device__ __forceinline__ s16x4 vtr(lds_cptr p){ return __builtin_bit_cast(s16x4,__builtin_amdgcn_ds_read_tr16_b64_v4i16((__attribute__((address_space(3))) v4i16_t*)p)); }
__device__ __forceinline__ float rowmax(const f32x16&p0,const f32x16&p1){
  float a=max3f(p0[0],p0[1],p1[0]),b=max3f(p0[2],p0[3],p1[1]);a=max3f(a,p1[2],p1[3]);
  #pragma unroll
  for(int r=4;r<16;r+=4){a=max3f(a,p0[r],p0[r+1]);b=max3f(b,p0[r+2],p0[r+3]);a=max3f(a,p1[r],p1[r+1]);b=max3f(b,p1[r+2],p1[r+3]);}
  const float m=max2f(a,b);
  auto rr=__builtin_amdgcn_permlane32_swap(__float_as_uint(m),__float_as_uint(m),false,false);
  return max2f(__uint_as_float(rr[0]),__uint_as_float(rr[1]));
}
__device__ __forceinline__ void pv(f32x16*o,int vb,bf16x8 pa0,bf16x8 pa1,bf16x8 pa2,bf16x8 pa3){
  #pragma unroll
  for(int d0=0;d0<2;++d0){s16x4 lo[4],hi[4];
    #pragma unroll
    for(int ks=0;ks<4;++ks){
      asm volatile("ds_read_b64_tr_b16 %0,%1 offset:%c2":"=&v"(lo[ks]):"v"(vb),"i"(d0*4096+ks*1024):"memory");
      asm volatile("ds_read_b64_tr_b16 %0,%1 offset:%c2":"=&v"(hi[ks]):"v"(vb),"i"(d0*4096+ks*1024+512):"memory");}
    asm volatile("s_waitcnt lgkmcnt(0)":::"memory");SBAR();
    #define PK(k) (bf16x8){lo[k][0],lo[k][1],lo[k][2],lo[k][3],hi[k][0],hi[k][1],hi[k][2],hi[k][3]}
    o[d0]=__builtin_amdgcn_mfma_f32_32x32x16_bf16(pa0,PK(0),o[d0],0,0,0);
    o[d0]=__builtin_amdgcn_mfma_f32_32x32x16_bf16(pa1,PK(1),o[d0],0,0,0);
    o[d0]=__builtin_amdgcn_mfma_f32_32x32x16_bf16(pa2,PK(2),o[d0],0,0,0);
    o[d0]=__builtin_amdgcn_mfma_f32_32x32x16_bf16(pa3,PK(3),o[d0],0,0,0);
    #undef PK
  }
}

#ifndef ATTN_STORE16
#define ATTN_STORE16(p,v) (*(u32x4*)(p)=(v))
#endif
template<int THRL> __device__ __forceinline__ void attn_unit(int qb,const bf16*Q,const bf16*__restrict__ K,const bf16*__restrict__ V,float*O,char*shm){
  int tid_o=threadIdx.x; asm volatile("":"+v"(tid_o));
  const int tid=tid_o,lane=tid&63,r32=lane&31,hi=lane>>5; const int wid=__builtin_amdgcn_readfirstlane(tid>>6);
  const int q0=qb*QB;
  const bf16*Qw=Q+(long)(q0+wid*QBLK)*DM;
  const bf16*Kh=K,*Vh=V;
  const unsigned lds0=(unsigned)(uintptr_t)shm;
  float*wsf=(float*)(shm+LDS_WS)+wid*64;
  const bf16*ksrc=Kh+(long)lane*DM+wid*8;
  const bf16*vsrc=Vh+(long)(16*(wid&3)+(lane>>2))*DM+(wid>>2)*32+(lane&3)*8;
  const unsigned kdst=lds0+LDS_K+wid*1024, vdst=lds0+LDS_V+wid*1024;
  #define DMA_K(t,slot) glds16(ksrc+(long)(t)*KVBLK*DM,(unsigned)__builtin_amdgcn_readfirstlane(kdst+(slot)))
  #define DMA_V(t,slot) glds16(vsrc+(long)(t)*KVBLK*DM,(unsigned)__builtin_amdgcn_readfirstlane(vdst+(slot)))
  const int vb0=(int)(lds0+LDS_V)+((lane>>4)&1)*32+(lane&3)*8+(4*hi+((lane&15)>>2))*64;
  const char*Kbase=shm+LDS_K; bf16x8 kf[8];
  const lds_cptr shm3=(lds_cptr)shm; const lds_cptr kp0=shm3+LDS_K+hi*1024+r32*16; const lds_cptr vp0=shm3+LDS_V+((lane>>4)&1)*32+(lane&3)*8+(4*hi+((lane&15)>>2))*64;
  const int NT=(q0+QB)/KVBLK;
  DMA_K(0,0);DMA_V(0,0);DMA_K(1,SLOTB);
  bf16x8 qr[4];
  #pragma unroll
  for(int d0=0;d0<4;++d0)qr[d0]=*reinterpret_cast<const bf16x8*>(&Qw[(long)r32*DM+d0*16+hi*8]);
  float mhat=0.f,l_reg=0.f;f32x16 o[2];o[0]=f32x16{};o[1]=f32x16{};f32x16 negm=f32x16{};asm volatile("":"+v"(negm));

  #define CMASK(P0,P1,t) do{int jb_=(t)-(NT-4); if(jb_>=0)cmask(P0,P1,jb_,wid>>1);}while(0)
  bool resc=false;
  #define START(P0,P1) do{ const float rm=rowmax(P0,P1); resc=false; \
    { const float dl=rm; mhat=fadd_s(mhat,dl); \
      _Pragma("unroll") for(int r=0;r<16;++r){P0[r]=fsub_s(P0[r],dl);P1[r]=fsub_s(P1[r],dl);} \
      _Pragma("unroll") for(int r=0;r<16;++r)negm[r]=-mhat; asm volatile("":"+v"(negm)); } \
    _Pragma("unroll") for(int r=0;r<16;++r)P0[r]=__builtin_amdgcn_exp2f(P0[r]); }while(0)
  #define RESC() do{ if(resc){ asm volatile("s_waitcnt lgkmcnt(0)":::"memory"); \
      _Pragma("unroll") for(int d_=0;d_<2;++d_) _Pragma("unroll") for(int r=0;r<16;++r)o[d_][r]*=wsf[crow(r,hi)]; } }while(0)
  f32x16 pA0,pA1,pB0,pB1;
  int sl_prev=0,sl_cur=0,sl_next=SLOTB;
  #define ROT() do{sl_prev=sl_cur;sl_cur=sl_next;sl_next=(sl_next==(NSLOT-1)*SLOTB)?0:sl_next+SLOTB;}while(0)
  DMA_K(2,2*SLOTB);
  WAIT_BAR(3);
  qkt(pA0,pA1,Kbase,qr,negm,r32,hi);asm volatile("s_nop 15\n\ts_nop 7":"+v"(pA0),"+v"(pA1));CMASK(pA0,pA1,0);
  START(pA0,pA1);
  _Pragma("unroll") for(int r=0;r<16;++r)pA1[r]=__builtin_amdgcn_exp2f(pA1[r]);
  WAIT_BAR(0);
  DMA_K(3,0);DMA_V(1,SLOTB);
  ROT();
  kload8(kf,kp0+sl_cur);
  WAIT_BAR(2);
  s16x4 vlo[8],vhi[8]; u32x4 pw0,pw1,pw2,pw3;
  #define PKW(P,B) cvtpk_s(P[B],P[B+1])
  #define PAF(k) __builtin_bit_cast(bf16x8,pw##k)
  #define VFR(i) (bf16x8){vlo[i][0],vlo[i][1],vlo[i][2],vlo[i][3],vhi[i][0],vhi[i][1],vhi[i][2],vhi[i][3]}
  #define PIN(x) asm volatile("":"+v"(x))
  #define MX3(a,b,c) __builtin_fmaxf(__builtin_fmaxf((a),(b)),(c))
  #define GAPA(MF,A0,A1,A2,A3,W0,W1,PW) do{ MF; sacc+=A0; sacc+=A1; sacc+=A2; sacc+=A3; PIN(sacc); W0; W1; PIN(PW); SBAR(); }while(0)
  #define EX(v) __builtin_amdgcn_exp2f(v)
  #define GAPB(MF,X,B) do{ MF; X[B]=EX(X[B]); X[B+1]=EX(X[B+1]); X[B+2]=EX(X[B+2]); X[B+3]=EX(X[B+3]); PIN(X); SBAR(); }while(0)
  #define VRD(i) do{ vlo[i]=vtr(vp_+(((i)>>2)*4096+((i)&3)*1024)); vhi[i]=vtr(vp_+(((i)>>2)*4096+((i)&3)*1024+512)); }while(0)
  #define KRD(G,j) do{ if(G){ kload2(kf,kp0+sl_next,j); SBAR(); } }while(0)
  #define STEP(C0,C1,P0,P1,t,GK,GV,GL) do{ SBAR(); \
    const lds_cptr vp_=vp0+sl_prev; \
    VRD(0); SBAR(); float sacc=(P0[0]+P0[1]); \
    GAPA(C0=__builtin_amdgcn_mfma_f32_32x32x16_bf16(kf[0],qr[0],negm,0,0,0), P0[2],P0[3],P0[4],P0[5],     pw0[0]=PKW(P0,0), pw0[1]=PKW(P0,2), pw0); \
    VRD(4); SBAR(); GAPA(C1=__builtin_amdgcn_mfma_f32_32x32x16_bf16(kf[1],qr[0],negm,0,0,0), P0[6],P0[7],P0[8],P0[9],     pw0[2]=PKW(P0,4), pw0[3]=PKW(P0,6), pw0); \
    VRD(1); SBAR(); GAPA(C0=__builtin_amdgcn_mfma_f32_32x32x16_bf16(kf[2],qr[1],C0,0,0,0),   P0[10],P0[11],P0[12],P0[13], pw1[0]=PKW(P0,8), pw1[1]=PKW(P0,10), pw1); \
    VRD(5); SBAR(); GAPA(C1=__builtin_amdgcn_mfma_f32_32x32x16_bf16(kf[3],qr[1],C1,0,0,0),   P0[14],P0[15],P1[0],P1[1],   pw1[2]=PKW(P0,12),pw1[3]=PKW(P0,14), pw1); \
    VRD(2); SBAR(); GAPA(C0=__builtin_amdgcn_mfma_f32_32x32x16_bf16(kf[4],qr[2],C0,0,0,0),   P1[2],P1[3],P1[4],P1[5],     pw2[0]=PKW(P1,0), pw2[1]=PKW(P1,2), pw2); \
    VRD(6); SBAR(); GAPA(C1=__builtin_amdgcn_mfma_f32_32x32x16_bf16(kf[5],qr[2],C1,0,0,0),   P1[6],P1[7],P1[8],P1[9],     pw2[2]=PKW(P1,4), pw2[3]=PKW(P1,6), pw2); \
    VRD(3); SBAR(); GAPA(C0=__builtin_amdgcn_mfma_f32_32x32x16_bf16(kf[6],qr[3],C0,0,0,0),   P1[10],P1[11],P1[12],P1[13], pw3[0]=PKW(P1,8), pw3[1]=PKW(P1,10), pw3); \
    VRD(7); SBAR(); GAPA(C1=__builtin_amdgcn_mfma_f32_32x32x16_bf16(kf[7],qr[3],C1,0,0,0),   P1[14],P1[15],0.f,0.f,       pw3[2]=PKW(P1,12),pw3[3]=PKW(P1,14), pw3); \
    l_reg+=sacc; \
    if(GK){DMA_K((t)+3,sl_cur);} if(GV){DMA_V((t)+1,sl_next);} \
    CMASK(C0,C1,t); \
    { float a=MX3(C0[0],C0[1],C1[0]),b=MX3(C0[2],C0[3],C1[1]); a=MX3(a,C1[2],C1[3]); \
      _Pragma("unroll") for(int r=4;r<16;r+=4){a=MX3(a,C0[r],C0[r+1]);b=MX3(b,C0[r+2],C0[r+3]);a=MX3(a,C1[r],C1[r+1]);b=MX3(b,C1[r+2],C1[r+3]);} \
      float rm=__builtin_fmaxf(a,b); { auto rr=__builtin_amdgcn_permlane32_swap(__float_as_uint(rm),__float_as_uint(rm),false,false); rm=__builtin_fmaxf(__uint_as_float(rr[0]),__uint_as_float(rr[1])); } \
      resc=false; \
      if(__builtin_expect(__any(rm>(float)THRL),0)){ const float dl=__builtin_fmaxf(rm,0.f); mhat+=dl; \
        _Pragma("unroll") for(int r=0;r<16;++r){C0[r]-=dl;C1[r]-=dl;} \
        _Pragma("unroll") for(int r=0;r<16;++r)negm[r]=-mhat; asm volatile("":"+v"(negm)); \
        const float f=__builtin_amdgcn_exp2f(-dl); l_reg*=f; if(hi==0)wsf[r32]=f; resc=true; } } \
    SBAR(); \
    GAPB(o[0]=__builtin_amdgcn_mfma_f32_32x32x16_bf16(PAF(0),VFR(0),o[0],0,0,0), C0,0); \
    GAPB(o[1]=__builtin_amdgcn_mfma_f32_32x32x16_bf16(PAF(0),VFR(4),o[1],0,0,0), C0,4); \
    KRD(GL,0); GAPB(o[0]=__builtin_amdgcn_mfma_f32_32x32x16_bf16(PAF(1),VFR(1),o[0],0,0,0), C0,8); \
    KRD(GL,1); GAPB(o[1]=__builtin_amdgcn_mfma_f32_32x32x16_bf16(PAF(1),VFR(5),o[1],0,0,0), C0,12); \
    KRD(GL,2); GAPB(o[0]=__builtin_amdgcn_mfma_f32_32x32x16_bf16(PAF(2),VFR(2),o[0],0,0,0), C1,0); \
    KRD(GL,3); GAPB(o[1]=__builtin_amdgcn_mfma_f32_32x32x16_bf16(PAF(2),VFR(6),o[1],0,0,0), C1,4); \
    GAPB(o[0]=__builtin_amdgcn_mfma_f32_32x32x16_bf16(PAF(3),VFR(3),o[0],0,0,0), C1,8); \
    GAPB(o[1]=__builtin_amdgcn_mfma_f32_32x32x16_bf16(PAF(3),VFR(7),o[1],0,0,0), C1,12); \
    }while(0)
  int t=1;
  #undef CMASK
  #define CMASK(P0,P1,t) do{}while(0)
  for(;t+5<NT;t+=2){
    STEP(pB0,pB1,pA0,pA1,t,true,true,true);     WAIT_BAR(2); RESC(); ROT();
    STEP(pA0,pA1,pB0,pB1,t+1,true,true,true);   WAIT_BAR(2); RESC(); ROT();
  }
  #undef CMASK
  #define CMASK(P0,P1,t) do{int jb_=(t)-(NT-4); if(jb_>=0)cmask(P0,P1,jb_,wid>>1);}while(0)
  #define ENDW(tt) do{ if((tt)+3<NT){WAIT_BAR(2);} else if((tt)+2<NT){WAIT_BAR(1);} else {WAIT_BAR(0);} }while(0)
  for(;t+1<NT;t+=2){
    STEP(pB0,pB1,pA0,pA1,t,(t+3<NT),(t+1<NT),(t+1<NT));       ENDW(t);   RESC(); ROT();
    STEP(pA0,pA1,pB0,pB1,t+1,(t+4<NT),(t+2<NT),(t+2<NT));     ENDW(t+1); RESC(); ROT();
  }
  STEP(pB0,pB1,pA0,pA1,NT-1,false,false,false); RESC();
  { float sacc=pB0[0]+pB0[1]; _Pragma("unroll") for(int r=2;r<16;++r)sacc+=pB0[r]; _Pragma("unroll") for(int r=0;r<16;++r)sacc+=pB1[r]; l_reg+=sacc;
    pw0=(u32x4){PKW(pB0,0),PKW(pB0,2),PKW(pB0,4),PKW(pB0,6)};pw1=(u32x4){PKW(pB0,8),PKW(pB0,10),PKW(pB0,12),PKW(pB0,14)};pw2=(u32x4){PKW(pB1,0),PKW(pB1,2),PKW(pB1,4),PKW(pB1,6)};pw3=(u32x4){PKW(pB1,8),PKW(pB1,10),PKW(pB1,12),PKW(pB1,14)};
    SBAR(); pv(o,vb0+sl_cur,PAF(0),PAF(1),PAF(2),PAF(3)); }
  #undef PKW
  #undef PAF
  #undef VFR
  #undef PIN
  #undef MX3
  #undef GAPA
  #undef GAPB
  #undef EX
  #undef VRD
  #undef KRD
  #undef STEP
  #undef ENDW
  {auto rr=__builtin_amdgcn_permlane32_swap(__float_as_uint(l_reg),__float_as_uint(l_reg),false,false);l_reg=__uint_as_float(rr[0])+__uint_as_float(rr[1]);}
  if(hi==0)wsf[32+r32]=l_reg;asm volatile("s_waitcnt lgkmcnt(0)":::"memory");
  float rli[16];
  #pragma unroll
  for(int r=0;r<16;++r)rli[r]=__builtin_amdgcn_rcpf(wsf[32+crow(r,hi)]);
  float*Ow=O+(long)(q0+wid*QBLK)*DM;
  { float*stg=(float*)(shm+LDS_OST)+wid*2048;
    #pragma unroll
    for(int r=0;r<16;++r){const int orow=crow(r,hi);
      #pragma unroll
      for(int d0=0;d0<2;++d0)stg[orow*64+d0*32+r32]=o[d0][r]*rli[r];}
    asm volatile("s_waitcnt lgkmcnt(0)":::"memory");
    #pragma unroll
    for(int i=0;i<8;++i){const int row=i*4+(lane>>4),ch=lane&15; const u32x4 v=*(const u32x4*)(stg+row*64+ch*4); *(u32x4*)(Ow+(long)row*DM+ch*4)=v;} }
  asm volatile("s_waitcnt lgkmcnt(0)\n\ts_barrier":::"memory");
  #undef DMA_K
  #undef DMA_V
  #undef CMASK
  #undef START
  #undef RESC
  #undef ROT
}
constexpr int ATTN_LDS_BYTES=LDS_BYTES;
#undef SBAR
#undef WAIT_BAR
}
#define GAS __attribute__((address_space(1)))
#define LAS __attribute__((address_space(3)))
typedef unsigned short bf16;
typedef unsigned v4u __attribute__((ext_vector_type(4)));
typedef float f32x4 __attribute__((ext_vector_type(4)));
typedef short bf16x8 __attribute__((ext_vector_type(8)));
typedef GAS unsigned gu32;
typedef GAS unsigned long long gu64;
#define RLX_AGENT __ATOMIC_RELAXED, __HIP_MEMORY_SCOPE_AGENT
#define LDS_WAIT() asm volatile("s_waitcnt lgkmcnt(0)" ::: "memory")
#define VM_WAIT() asm volatile("s_waitcnt vmcnt(0)" ::: "memory")
__device__ __forceinline__ unsigned long long rt() { return __builtin_amdgcn_s_memrealtime(); }
__device__ __forceinline__ unsigned f2bf(float f) { unsigned u = __builtin_bit_cast(unsigned, f); return (u + 0x7fffu + ((u >> 16) & 1u)) >> 16; }
__device__ __forceinline__ unsigned pk2(float lo, float hi) { return f2bf(lo) | (f2bf(hi) << 16); }

#define XB_TMO      128
#define XB_XCNT(j)  (256  + 64 * (j))
#define XB_XSUB(j)  (1280 + 64 * (j))
#define XB_XGEN(j)  (2304 + 64 * (j))
#define XB_TOP      3328
#define XB_TOPGEN   3392
#define XCD_BAR_WORDS 3456
#define XB_SPIN_CAP (1u << 18)

__device__ __forceinline__ unsigned xb_ld(unsigned* p)              { return __hip_atomic_load(p, __ATOMIC_RELAXED, __HIP_MEMORY_SCOPE_AGENT); }
__device__ __forceinline__ unsigned xb_add(unsigned* p, unsigned v) { return __hip_atomic_fetch_add(p, v, __ATOMIC_RELAXED, __HIP_MEMORY_SCOPE_AGENT); }
__device__ __forceinline__ unsigned xb_xcc_id() { return (unsigned)__builtin_amdgcn_s_getreg((3 << 11) | 20) & 0xFu; }
#define XB_SPIN(cond, bar) do { unsigned _sp = 0; while (cond) { __builtin_amdgcn_s_sleep(1); \
    if ((++_sp & 255u) == 0u) { if (xb_ld(&(bar)[XB_TMO])) break; if (_sp > XB_SPIN_CAP) { atomicAdd(&(bar)[XB_TMO], 1u); break; } } } } while (0)

struct XcdBarrier {
    unsigned* bar; unsigned x;
    volatile LAS unsigned* st;
};

__device__ __forceinline__ XcdBarrier xcd_barrier_post(unsigned* bar, volatile LAS unsigned* st) {
    XcdBarrier b; b.bar = bar; b.x = xb_xcc_id(); b.st = st;
    if (threadIdx.x == 0) (void)xb_add(&bar[XB_XCNT(b.x)], 1u);
    return b;
}
__device__ __forceinline__ void xcd_barrier_complete(unsigned* bar, unsigned x, unsigned& nloc, unsigned& nx) {
    const unsigned G = gridDim.x * gridDim.y * gridDim.z;
    unsigned sum, cnt, mine, sp = 0u;
    for (;;) {
        sum = 0u; cnt = 0u; mine = 0u;
#pragma unroll
        for (unsigned j = 0; j < 16; ++j) { const unsigned c = xb_ld(&bar[XB_XCNT(j)]); sum += c; cnt += (c > 0u) ? 1u : 0u; mine = (j == x) ? c : mine; }
        if (sum == G) break;
        __builtin_amdgcn_s_sleep(1);
        if ((++sp & 255u) == 0u) { if (xb_ld(&bar[XB_TMO])) break; if (sp > XB_SPIN_CAP) { atomicAdd(&bar[XB_TMO], 1u); break; } }
    }
    nloc = mine > 0u ? mine : 1u; nx = cnt > 0u ? cnt : 1u;
}

__device__ __forceinline__ void xcd_barrier(const XcdBarrier& b) {
    asm volatile("s_waitcnt vmcnt(0)" ::: "memory");
    __syncthreads();
    if (threadIdx.x == 0) {
        unsigned* bar = b.bar;
        __builtin_amdgcn_s_waitcnt(0);
        unsigned nloc = b.st[0], nx = b.st[1];
        if (nloc == 0u) { xcd_barrier_complete(bar, b.x, nloc, nx); b.st[0] = nloc; b.st[1] = nx; }
        const unsigned old = xb_add(&bar[XB_XSUB(b.x)], 1u);
        const unsigned gen = old / nloc;
        if (old + 1u == (gen + 1u) * nloc) {
            __builtin_amdgcn_fence(__ATOMIC_RELEASE, "agent");
            asm volatile("s_waitcnt vmcnt(0)" ::: "memory");
            const unsigned og = xb_add(&bar[XB_TOP], 1u);
            const unsigned tg = og / nx;
            if (og + 1u == (tg + 1u) * nx) xb_add(&bar[XB_TOPGEN], 1u);
            else XB_SPIN(xb_ld(&bar[XB_TOPGEN]) == tg, bar);
            __builtin_amdgcn_fence(__ATOMIC_ACQUIRE, "agent");
            xb_add(&bar[XB_XGEN(b.x)], 1u);
            asm volatile("s_waitcnt vmcnt(0)" ::: "memory");
        } else {
            XB_SPIN(xb_ld(&bar[XB_XGEN(b.x)]) == gen, bar);
            __builtin_amdgcn_fence(__ATOMIC_ACQUIRE, "agent");
            asm volatile("s_waitcnt vmcnt(0)" ::: "memory");
        }
    }
    __syncthreads();
}
typedef unsigned short bf16_t;
typedef float f32x4 __attribute__((ext_vector_type(4)));
typedef float f32x16 __attribute__((ext_vector_type(16)));
typedef unsigned u32x2 __attribute__((ext_vector_type(2)));
typedef unsigned u32x4v __attribute__((ext_vector_type(4)));
typedef short bf16x8 __attribute__((ext_vector_type(8)));
__device__ __forceinline__ float bflo(unsigned w) { return __uint_as_float(w << 16); }
__device__ __forceinline__ float bfhi(unsigned w) { return __uint_as_float(w & 0xffff0000u); }
__device__ __forceinline__ unsigned pkbf(float lo, float hi) { return pg8::cvt_pk_bf16(lo, hi); }
__device__ __forceinline__ float sigm(float x) { return __builtin_amdgcn_rcpf(1.f + __builtin_amdgcn_exp2f(-1.4426950408889634f * x)); }
__device__ __forceinline__ float wave_sum(float v) {
#pragma unroll
    for (int o = 1; o < 64; o <<= 1) v += __shfl_xor(v, o);
    return v;
}
__device__ __forceinline__ int crow16(int r, int hi) { return (r & 3) + 8 * (r >> 2) + 4 * hi; }

struct EpiIn {
    static constexpr bool PERM = false, AFTER_DRAIN = false;
    bf16_t *PXB, *SPG, *QB, *KB, *VB, *SAG, *SGA, *SGB; float* out; const float* rc; const float* rs; int layer;
    __device__ __forceinline__ void operator()(const pg8::f32x4 (&acc)[2][2][4][2], const pg8::Unit& u, int wr, int wc, int fr, int fq) const {
        const int pn = u.pn, row0 = u.pm * 256 + wr * 64 + fr;
        const bool samp = u.pm >= MP / 256;
        if (pn >= 4 && pn < 12) {
            const bool isk = pn >= 8;
            const int cbase = (pn - (isk ? 8 : 4)) * 256 + (wc >> 1) * 64 + (wc & 1) * 16 + 4 * fq;
            const int i0 = (wc & 1) * 16 + 4 * fq;
            bf16_t* dstb = isk ? KB : QB; const float sc = isk ? 1.f : C2;
#pragma unroll
            for (int ai = 0; ai < 2; ++ai)
#pragma unroll
                for (int m = 0; m < 4; ++m) {
                    const int row = row0 + ai * 128 + m * 16;
                    const int pos = samp ? PAST + ((row - MP) & 15) : (row & (SEQ - 1));
                    const f32x4 c = *(const f32x4*)(rc + pos * 32 + i0), s = *(const f32x4*)(rs + pos * 32 + i0);
                    float* ko = samp ? out + O_KS + ((size_t)layer * MS + (row - MP)) * 1024 : out + O_KP + ((size_t)layer * MP + row) * 1024;
#pragma unroll
                    for (int bj = 0; bj < 2; ++bj) {
                        const f32x4 x1 = acc[ai][bj][m][0], x2 = acc[ai][bj][m][1];
                        const f32x4 r1 = x1 * c - x2 * s, r2 = x2 * c + x1 * s;
                        const int col = cbase + bj * 128;
                        if (isk) { *(f32x4*)(ko + col) = r1; *(f32x4*)(ko + col + 32) = r2; }
                        u32x2 w1, w2; w1.x = pkbf(r1[0] * sc, r1[1] * sc); w1.y = pkbf(r1[2] * sc, r1[3] * sc); w2.x = pkbf(r2[0] * sc, r2[1] * sc); w2.y = pkbf(r2[2] * sc, r2[3] * sc);
                        *(u32x2*)(dstb + (size_t)row * 1024 + col) = w1; *(u32x2*)(dstb + (size_t)row * 1024 + col + 32) = w2;
                    }
                }
        } else {
            int mode, ld, cb; bf16_t* dst;
            if (pn < 2) { dst = PXB; ld = 512; cb = pn * 256; mode = 0; }
            else if (pn < 4) { dst = SPG; ld = 512; cb = (pn - 2) * 256; mode = 1; }
            else if (pn < 16) { dst = VB; ld = 1024; cb = (pn - 12) * 256; mode = 0; }
            else if (pn < 20) { dst = SAG; ld = 1024; cb = (pn - 16) * 256; mode = 1; }
            else if (pn < 24) { dst = SGA; ld = 1024; cb = (pn - 20) * 256; mode = 2; }
            else { dst = SGB; ld = 1024; cb = (pn - 24) * 256; mode = 2; }
            cb += 32 * wc + 8 * fq;
            const bool isv = pn >= 12 && pn < 16, ispx = pn < 2;
#pragma unroll
            for (int ai = 0; ai < 2; ++ai)
#pragma unroll
                for (int m = 0; m < 4; ++m) {
                    const int row = row0 + ai * 128 + m * 16;
                    float* fo = nullptr;
                    if (isv) fo = samp ? out + O_VS + ((size_t)layer * MS + (row - MP)) * 1024 : out + O_VP + ((size_t)layer * MP + row) * 1024;
                    else if (ispx) {
                        if (!samp) { const int t = row & (SEQ - 1); if (t >= SEQ - 15) fo = out + O_PP + (((size_t)layer * BATCH + (row >> 12)) * 15 + (t - (SEQ - 15))) * 512; }
                        else { const int rs_ = row - MP, j = rs_ & 15; if (j >= 1) fo = out + O_PS + (((size_t)layer * DEC_BATCH + (rs_ >> 4)) * 15 + (j - 1)) * 512; }
                    }
#pragma unroll
                    for (int bj = 0; bj < 2; ++bj) {
                        f32x4 v0 = acc[ai][bj][m][0], v1 = acc[ai][bj][m][1];
                        const int col = cb + bj * 128;
                        if (fo) { *(f32x4*)(fo + col) = v0; *(f32x4*)(fo + col + 4) = v1; }
                        if (mode == 1) {
#pragma unroll
                            for (int k = 0; k < 4; ++k) { v0[k] = v0[k] * sigm(v0[k]); v1[k] = v1[k] * sigm(v1[k]); }
                        } else if (mode == 2) {
#pragma unroll
                            for (int k = 0; k < 4; ++k) { v0[k] = sigm(v0[k]); v1[k] = sigm(v1[k]); }
                        }
                        u32x4v w; w.x = pkbf(v0[0], v0[1]); w.y = pkbf(v0[2], v0[3]); w.z = pkbf(v1[0], v1[1]); w.w = pkbf(v1[2], v1[3]);
                        *(u32x4v*)(dst + (size_t)row * ld + col) = w;
                    }
                }
        }
    }
};
struct EpiMergeA {
    static constexpr bool PERM = false, AFTER_DRAIN = false;
    const bf16_t* SGA; float* TMPA;
    __device__ __forceinline__ void operator()(const pg8::f32x4 (&acc)[2][2][4][2], const pg8::Unit& u, int wr, int wc, int fr, int fq) const {
        const int row0 = u.pm * 256 + wr * 64 + fr, col0 = u.pn * 256 + wc * 32 + 4 * fq;
#pragma unroll
        for (int ai = 0; ai < 2; ++ai)
#pragma unroll
            for (int m = 0; m < 4; ++m) { const size_t ro = (size_t)(row0 + ai * 128 + m * 16) * 1024 + col0;
#pragma unroll
                for (int bj = 0; bj < 2; ++bj)
#pragma unroll
                    for (int n = 0; n < 2; ++n) { const size_t o = ro + bj * 128 + n * 16; const u32x2 g = *(const u32x2*)(SGA + o);
                        const f32x4 a = acc[ai][bj][m][n]; f32x4 r; r[0] = a[0] * bflo(g.x); r[1] = a[1] * bfhi(g.x); r[2] = a[2] * bflo(g.y); r[3] = a[3] * bfhi(g.y);
                        *(f32x4*)(TMPA + o) = r; } }
    }
};
struct EpiMergeB {
    static constexpr bool PERM = false, AFTER_DRAIN = false;
    const bf16_t* SGB; const float* TMPA; bf16_t* MG;
    __device__ __forceinline__ void operator()(const pg8::f32x4 (&acc)[2][2][4][2], const pg8::Unit& u, int wr, int wc, int fr, int fq) const {
        const int row0 = u.pm * 256 + wr * 64 + fr, col0 = u.pn * 256 + wc * 32 + 4 * fq;
#pragma unroll
        for (int ai = 0; ai < 2; ++ai)
#pragma unroll
            for (int m = 0; m < 4; ++m) { const size_t ro = (size_t)(row0 + ai * 128 + m * 16) * 1024 + col0;
#pragma unroll
                for (int bj = 0; bj < 2; ++bj)
#pragma unroll
                    for (int n = 0; n < 2; ++n) { const size_t o = ro + bj * 128 + n * 16; const u32x2 g = *(const u32x2*)(SGB + o); const f32x4 t = *(const f32x4*)(TMPA + o);
                        const f32x4 a = acc[ai][bj][m][n]; f32x4 r; r[0] = t[0] + a[0] * bflo(g.x); r[1] = t[1] + a[1] * bfhi(g.x); r[2] = t[2] + a[2] * bflo(g.y); r[3] = t[3] + a[3] * bfhi(g.y);
                        u32x2 w; w.x = pkbf(r[0], r[1]); w.y = pkbf(r[2], r[3]); *(u32x2*)(MG + o) = w; } }
    }
};
struct EpiOut {
    static constexpr bool PERM = false, AFTER_DRAIN = false;
    float* X;
    __device__ __forceinline__ void operator()(const pg8::f32x4 (&acc)[2][2][4][2], const pg8::Unit& u, int wr, int wc, int fr, int fq) const {
        const int row0 = u.pm * 256 + wr * 64 + fr, col0 = u.pn * 256 + wc * 32 + 4 * fq;
#pragma unroll
        for (int ai = 0; ai < 2; ++ai)
#pragma unroll
            for (int m = 0; m < 4; ++m) { const size_t ro = (size_t)(row0 + ai * 128 + m * 16) * 1024 + col0;
#pragma unroll
                for (int bj = 0; bj < 2; ++bj)
#pragma unroll
                    for (int n = 0; n < 2; ++n) { const size_t o = ro + bj * 128 + n * 16; const f32x4 x = *(const f32x4*)(X + o); *(f32x4*)(X + o) = x * ALPHA + acc[ai][bj][m][n]; } }
    }
};

__device__ __forceinline__ int inv_perm_S(int a) { const int bj = a >> 7, wc = (a >> 5) & 3, fq = (a >> 3) & 3, n = (a >> 2) & 1, j = a & 3; return 128 * bj + 32 * wc + 16 * n + 4 * fq + j; }
__device__ __forceinline__ int inv_perm_R(int a) { const int bj = a >> 7, wch = (a >> 6) & 1, n = (a >> 5) & 1, wcl = (a >> 4) & 1, fq = (a >> 2) & 3, j = a & 3; return 128 * bj + 32 * (2 * wch + wcl) + 16 * n + 4 * fq + j; }
template <int PM>
__device__ __forceinline__ void p0_transpose_item(const float* W, int K, int N, bf16_t* WT, LAS float* scr, int item, int lane) {
    const int nblk = N / 32, kb = item / nblk, nb = item % nblk, k0 = 64 * kb, n0 = 32 * nb;
#pragma unroll 8
    for (int i = 0; i < 32; ++i) { const int kk = 2 * i + (lane >> 5); scr[kk * 33 + (lane & 31)] = W[(size_t)(k0 + kk) * N + n0 + (lane & 31)]; }
    LDS_WAIT(); asm volatile("" ::: "memory");
    const int c = lane & 7;
#pragma unroll
    for (int j = 0; j < 4; ++j) { const int n = (lane >> 3) + 8 * j; const LAS float* s = scr + (8 * c) * 33 + n;
        v4u o; o.x = pkbf(s[0 * 33], s[1 * 33]); o.y = pkbf(s[2 * 33], s[3 * 33]); o.z = pkbf(s[4 * 33], s[5 * 33]); o.w = pkbf(s[6 * 33], s[7 * 33]);
        int nr = n0 + n;
        if (PM == 1) { const int tile = nr >> 8, a = nr & 255; nr = (nr & ~255) + ((tile >= 4 && tile < 12) ? inv_perm_R(a) : inv_perm_S(a)); }
        *(GAS v4u*)(WT + (size_t)nr * K + k0 + 8 * c) = o; }
    LDS_WAIT(); asm volatile("" ::: "memory");
}
__device__ __forceinline__ void ln_row(const float* xrow, const float* g, const float* b, float* of, bf16_t* ob, int lane) {
    asm volatile("" : "+v"(lane));
    const GAS f32x4* xr = (const GAS f32x4*)xrow + lane;
    f32x4 v[4]; float s = 0.f;
#pragma unroll
    for (int j = 0; j < 4; ++j) { v[j] = xr[64 * j]; s += (v[j].x + v[j].y) + (v[j].z + v[j].w); }
    const float mean = wave_sum(s) * (1.f / 1024.f); float s2 = 0.f;
#pragma unroll
    for (int j = 0; j < 4; ++j) { v[j] = v[j] - mean; s2 += (v[j].x * v[j].x + v[j].y * v[j].y) + (v[j].z * v[j].z + v[j].w * v[j].w); }
    const float rstd = 1.f / sqrtf(wave_sum(s2) * (1.f / 1024.f) + LN_EPS);
    GAS f32x4* o4 = (GAS f32x4*)of + lane; GAS u32x2* o8 = (GAS u32x2*)ob + lane;
#pragma unroll
    for (int j = 0; j < 4; ++j) { const f32x4 gg = ((const GAS f32x4*)g + lane)[64 * j], bb = ((const GAS f32x4*)b + lane)[64 * j];
        const f32x4 y = v[j] * rstd * gg + bb; o4[64 * j] = y; u32x2 w; w.x = pkbf(y.x, y.y); w.y = pkbf(y.z, y.w); o8[64 * j] = w; }
}

struct Params { const float* in[17]; float* out; unsigned char* ws; int l_lo, l_hi, do_pro, bar_region; };
enum { I_XP = 0, I_XS, I_CK, I_CV, I_SP, I_LIG, I_LIB, I_WIN, I_WPOOL, I_PSC, I_LQK, I_SUBLN, I_WA, I_WB, I_WO, I_LNG, I_LNB };

__device__ __forceinline__ void pool_item(int item, int layer, const Params& P, int lane) {
    asm volatile("" : "+v"(lane));
    const int blk = item % (M / 32), g = item / (M / 32), w = 2 << g;
    const int r = lane & 31, hi = lane >> 5, row = blk * 32 + r;
    const bool samp = blk >= MP / 32;
    const bf16_t* PXB = (const bf16_t*)(P.ws + WS_PXB); const bf16_t* SPG = (const bf16_t*)(P.ws + WS_SPG); bf16_t* YA = (bf16_t*)(P.ws + WS_YA);
    const bf16_t* WpT = (const bf16_t*)(P.ws + WS_WP) + (size_t)(layer * 4 + g) * 128 * 128;
    int navail, cnt;
    if (!samp) { navail = (row & (SEQ - 1)) + 1; cnt = navail < w ? navail : w; } else { navail = ((row - MP) & 15) + 1; cnt = w; }
    const bf16_t* px = PXB + (size_t)row * 512 + g * 128 + 8 * hi;
    const float rcnt = 1.f / (float)cnt;
    bf16x8 bfr[8];
    if (!samp) {
#pragma unroll
        for (int s = 0; s < 8; ++s) {
            const u32x4v tk = *(const u32x4v*)(px + 16 * s);
            float t0[8] = {bflo(tk.x), bfhi(tk.x), bflo(tk.y), bfhi(tk.y), bflo(tk.z), bfhi(tk.z), bflo(tk.w), bfhi(tk.w)};
            float a[8];
#pragma unroll
            for (int k = 0; k < 8; ++k) a[k] = t0[k];
            for (int d0 = 1; d0 < w; d0 += 4) {
                u32x4v v[4];
#pragma unroll
                for (int e = 0; e < 4; ++e) { const int d = d0 + e; const int dc = d < navail ? d : 0; v[e] = *(const u32x4v*)(px - (size_t)dc * 512 + 16 * s); }
#pragma unroll
                for (int e = 0; e < 4; ++e) { const int d = d0 + e; const bool ok = d < navail && d < w;
                    if (ok) { a[0] += bflo(v[e].x); a[1] += bfhi(v[e].x); a[2] += bflo(v[e].y); a[3] += bfhi(v[e].y); a[4] += bflo(v[e].z); a[5] += bfhi(v[e].z); a[6] += bflo(v[e].w); a[7] += bfhi(v[e].w); } }
            }
            u32x4v pk; pk.x = pkbf(a[0] * rcnt - t0[0], a[1] * rcnt - t0[1]); pk.y = pkbf(a[2] * rcnt - t0[2], a[3] * rcnt - t0[3]);
            pk.z = pkbf(a[4] * rcnt - t0[4], a[5] * rcnt - t0[5]); pk.w = pkbf(a[6] * rcnt - t0[6], a[7] * rcnt - t0[7]);
            bfr[s] = __builtin_bit_cast(bf16x8, pk);
        }
    } else {
        const float* hist = P.in[I_SP] + (((size_t)layer * DEC_BATCH + ((row - MP) >> 4)) * 15) * 512 + g * 128 + 8 * hi;
#pragma unroll
        for (int s = 0; s < 8; ++s) {
            const u32x4v tk = *(const u32x4v*)(px + 16 * s);
            float a[8] = {bflo(tk.x), bfhi(tk.x), bflo(tk.y), bfhi(tk.y), bflo(tk.z), bfhi(tk.z), bflo(tk.w), bfhi(tk.w)};
            float t0[8];
#pragma unroll
            for (int k = 0; k < 8; ++k) t0[k] = a[k];
            for (int d = 1; d < w; ++d) {
                if (d < navail) { const u32x4v v = *(const u32x4v*)(px - (size_t)d * 512 + 16 * s);
                    a[0] += bflo(v.x); a[1] += bfhi(v.x); a[2] += bflo(v.y); a[3] += bfhi(v.y); a[4] += bflo(v.z); a[5] += bfhi(v.z); a[6] += bflo(v.w); a[7] += bfhi(v.w); }
                else { const float* hp = hist + (size_t)(15 + navail - 1 - d) * 512 + 16 * s; const f32x4 h0 = *(const f32x4*)hp, h1 = *(const f32x4*)(hp + 4);
                    a[0] += h0[0]; a[1] += h0[1]; a[2] += h0[2]; a[3] += h0[3]; a[4] += h1[0]; a[5] += h1[1]; a[6] += h1[2]; a[7] += h1[3]; }
            }
            u32x4v pk; pk.x = pkbf(a[0] * rcnt - t0[0], a[1] * rcnt - t0[1]); pk.y = pkbf(a[2] * rcnt - t0[2], a[3] * rcnt - t0[3]);
            pk.z = pkbf(a[4] * rcnt - t0[4], a[5] * rcnt - t0[5]); pk.w = pkbf(a[6] * rcnt - t0[6], a[7] * rcnt - t0[7]);
            bfr[s] = __builtin_bit_cast(bf16x8, pk);
        }
    }
    const float* psc = P.in[I_PSC] + (size_t)layer * 512 + g * 128;
#pragma unroll
    for (int db = 0; db < 4; ++db) {
        bf16x8 af[8];
#pragma unroll
        for (int s = 0; s < 8; ++s) af[s] = *(const bf16x8*)(WpT + (size_t)(32 * db + r) * 128 + 16 * s + 8 * hi);
        f32x4 sc[4]; u32x2 gt[4];
#pragma unroll
        for (int q = 0; q < 4; ++q) { const int d0 = 32 * db + 8 * q + 4 * hi; sc[q] = *(const f32x4*)(psc + d0); gt[q] = *(const u32x2*)(SPG + (size_t)row * 512 + g * 128 + d0); }
        f32x16 acc = {};
#pragma unroll
        for (int s = 0; s < 8; ++s) acc = __builtin_amdgcn_mfma_f32_32x32x16_bf16(af[s], bfr[s], acc, 0, 0, 0);
#pragma unroll
        for (int q = 0; q < 4; ++q) { const int d0 = 32 * db + 8 * q + 4 * hi;
            u32x2 o; o.x = pkbf(acc[4 * q] * sc[q][0] * bflo(gt[q].x), acc[4 * q + 1] * sc[q][1] * bfhi(gt[q].x)); o.y = pkbf(acc[4 * q + 2] * sc[q][2] * bflo(gt[q].y), acc[4 * q + 3] * sc[q][3] * bfhi(gt[q].y));
            *(u32x2*)(YA + (size_t)row * 512 + g * 128 + d0) = o; }
    }
}

__device__ __forceinline__ void combine_rows(size_t rowbase, int h, int layer, const Params& P, int tid) {
    const float* O1 = (const float*)(P.ws + WS_O1); const float* O2 = (const float*)(P.ws + WS_O2);
    const bf16_t* SAG = (const bf16_t*)(P.ws + WS_SAG); bf16_t* YB = (bf16_t*)(P.ws + WS_YB);
    const float* LAM = (const float*)(P.ws + WS_LAM); const float lam = LAM[layer], li = LAM[4 + layer];
    asm volatile("" : "+v"(tid));
    const int rsub = tid >> 4, c8 = (tid & 15) * 8;
    const float* sl = P.in[I_SUBLN] + (size_t)layer * 128 + c8;
    const f32x4 s0 = *(const f32x4*)sl, s1 = *(const f32x4*)(sl + 4);
#pragma unroll 2
    for (int p = 0; p < 8; ++p) {
        const size_t base = (rowbase + p * 32 + rsub) * 1024 + h * 128 + c8;
        const f32x4 a0 = *(const f32x4*)(O1 + base) - lam * *(const f32x4*)(O2 + base), a1 = *(const f32x4*)(O1 + base + 4) - lam * *(const f32x4*)(O2 + base + 4);
        float ss = (a0[0] * a0[0] + a0[1] * a0[1]) + (a0[2] * a0[2] + a0[3] * a0[3]) + (a1[0] * a1[0] + a1[1] * a1[1]) + (a1[2] * a1[2] + a1[3] * a1[3]);
        ss += __shfl_xor(ss, 1); ss += __shfl_xor(ss, 2); ss += __shfl_xor(ss, 4); ss += __shfl_xor(ss, 8);
        const float rr = (1.f - li) / sqrtf(ss * (1.f / 128.f) + RMS_EPS);
        const u32x4v gt = *(const u32x4v*)(SAG + base);
        u32x4v o; o.x = pkbf(a0[0] * rr * s0[0] * bflo(gt.x), a0[1] * rr * s0[1] * bfhi(gt.x)); o.y = pkbf(a0[2] * rr * s0[2] * bflo(gt.y), a0[3] * rr * s0[3] * bfhi(gt.y));
        o.z = pkbf(a1[0] * rr * s1[0] * bflo(gt.z), a1[1] * rr * s1[1] * bfhi(gt.z)); o.w = pkbf(a1[2] * rr * s1[2] * bflo(gt.w), a1[3] * rr * s1[3] * bfhi(gt.w));
        *(u32x4v*)(YB + base) = o;
    }
}

__device__ __forceinline__ void sample_unit(int b, int h, int layer, const Params& P, LAS unsigned char* L, int tid, int lane, int wave) {
    asm volatile("" : "+v"(lane)); asm volatile("" : "+v"(tid));
    const int r = lane & 31, hi = lane >> 5;
    const bf16_t* QB = (const bf16_t*)(P.ws + WS_QB);
    const bf16_t* qrow = QB + (size_t)(MP + b * 16 + (r & 15)) * 1024 + h * 128 + 8 * hi;
    bf16x8 qf[8];
#pragma unroll
    for (int s = 0; s < 8; ++s) { const bool nz = (s < 4) ? (r < 16) : (r >= 16); bf16x8 z = {}; qf[s] = nz ? *(const bf16x8*)(qrow + 16 * s) : z; }
    f32x16 ot[4]; ot[0] = f32x16{}; ot[1] = f32x16{}; ot[2] = f32x16{}; ot[3] = f32x16{};
    float mrun = -INFINITY, lrun = 0.f;
    const float* ck = P.in[I_CK] + ((size_t)(layer * DEC_BATCH + b) * PAST) * 1024 + h * 128;
    const float* cv = P.in[I_CV] + ((size_t)(layer * DEC_BATCH + b) * PAST) * 1024 + h * 128;
    const float* nk = P.out + O_KS + ((size_t)layer * MS + b * 16) * 1024 + h * 128;
    const float* nv = P.out + O_VS + ((size_t)layer * MS + b * 16) * 1024 + h * 128;
    const int ntile = (wave == 0) ? 5 : 4;
    for (int ti = 0; ti < ntile; ++ti) {
        const bool newt = ti == 4;
        const float* kb = newt ? nk : ck + (size_t)(32 * (wave + 8 * ti)) * 1024;
        const float* vb = newt ? nv : cv + (size_t)(32 * (wave + 8 * ti)) * 1024;
        const int rmask = newt ? 15 : 31;
        const float* kr = kb + (size_t)(r & rmask) * 1024 + 8 * hi;
        f32x4 kraw[16];
#pragma unroll
        for (int s = 0; s < 8; ++s) { kraw[2 * s] = *(const f32x4*)(kr + 16 * s); kraw[2 * s + 1] = *(const f32x4*)(kr + 16 * s + 4); }
        float vraw[32];
#pragma unroll
        for (int c = 0; c < 4; ++c)
#pragma unroll
            for (int j = 0; j < 8; ++j) { const int key = (8 * (j >> 2) + 4 * hi + (j & 3)) & rmask; vraw[c * 8 + j] = vb[(size_t)key * 1024 + 32 * c + r]; }
        __builtin_amdgcn_sched_barrier(0);
        f32x16 st = {};
#pragma unroll
        for (int s = 0; s < 8; ++s) { const f32x4 k0 = kraw[2 * s], k1 = kraw[2 * s + 1];
            u32x4v pk; pk.x = pkbf(k0[0], k0[1]); pk.y = pkbf(k0[2], k0[3]); pk.z = pkbf(k1[0], k1[1]); pk.w = pkbf(k1[2], k1[3]);
            st = __builtin_amdgcn_mfma_f32_32x32x16_bf16(__builtin_bit_cast(bf16x8, pk), qf[s], st, 0, 0, 0); }
        float vraw2[32];
#pragma unroll
        for (int c = 0; c < 4; ++c)
#pragma unroll
            for (int j = 0; j < 8; ++j) { const int key = (16 + 8 * (j >> 2) + 4 * hi + (j & 3)) & rmask; vraw2[c * 8 + j] = vb[(size_t)key * 1024 + 32 * c + r]; }
        __builtin_amdgcn_sched_barrier(0);
        if (newt) {
#pragma unroll
            for (int q = 8; q < 16; ++q) st[q] = -INFINITY;
        }
        float tm = st[0];
#pragma unroll
        for (int q = 1; q < 16; ++q) tm = fmaxf(tm, st[q]);
        tm = fmaxf(tm, __shfl_xor(tm, 32));
        const float mnew = fmaxf(mrun, tm), f = __builtin_amdgcn_exp2f(mrun - mnew);
        mrun = mnew; lrun *= f;
#pragma unroll
        for (int c = 0; c < 4; ++c) ot[c] = ot[c] * f;
        float ps = 0.f;
#pragma unroll
        for (int q = 0; q < 16; ++q) { st[q] = __builtin_amdgcn_exp2f(st[q] - mnew); ps += st[q]; }
        lrun += ps;
        bf16x8 pf[2];
#pragma unroll
        for (int sp = 0; sp < 2; ++sp) { u32x4v pk; pk.x = pkbf(st[8 * sp], st[8 * sp + 1]); pk.y = pkbf(st[8 * sp + 2], st[8 * sp + 3]); pk.z = pkbf(st[8 * sp + 4], st[8 * sp + 5]); pk.w = pkbf(st[8 * sp + 6], st[8 * sp + 7]);
            pf[sp] = __builtin_bit_cast(bf16x8, pk); }
#pragma unroll
        for (int c = 0; c < 4; ++c) { u32x4v pk; pk.x = pkbf(vraw[c * 8], vraw[c * 8 + 1]); pk.y = pkbf(vraw[c * 8 + 2], vraw[c * 8 + 3]); pk.z = pkbf(vraw[c * 8 + 4], vraw[c * 8 + 5]); pk.w = pkbf(vraw[c * 8 + 6], vraw[c * 8 + 7]);
            ot[c] = __builtin_amdgcn_mfma_f32_32x32x16_bf16(__builtin_bit_cast(bf16x8, pk), pf[0], ot[c], 0, 0, 0); }
#pragma unroll
        for (int c = 0; c < 4; ++c) { u32x4v pk; pk.x = pkbf(vraw2[c * 8], vraw2[c * 8 + 1]); pk.y = pkbf(vraw2[c * 8 + 2], vraw2[c * 8 + 3]); pk.z = pkbf(vraw2[c * 8 + 4], vraw2[c * 8 + 5]); pk.w = pkbf(vraw2[c * 8 + 6], vraw2[c * 8 + 7]);
            ot[c] = __builtin_amdgcn_mfma_f32_32x32x16_bf16(__builtin_bit_cast(bf16x8, pk), pf[1], ot[c], 0, 0, 0); }
    }
    lrun += __shfl_xor(lrun, 32);
    LAS float* SM_M = (LAS float*)(L + RING_OFF);
    LAS float* SM_R = (LAS float*)(L + RING_OFF + 1024);
    LAS float* SM_O = (LAS float*)(L + RING_OFF + 1024 + 4 * 64 * 65 * 4);
    if (hi == 0) SM_M[wave * 32 + r] = mrun;
    __syncthreads();
    float mfin = SM_M[r];
#pragma unroll
    for (int w2 = 1; w2 < 8; ++w2) mfin = fmaxf(mfin, SM_M[w2 * 32 + r]);
    { const float sc = __builtin_amdgcn_exp2f(mrun - mfin); lrun *= sc;
#pragma unroll
      for (int c = 0; c < 4; ++c) ot[c] = ot[c] * sc; }
#pragma unroll
    for (int step = 4; step >= 1; step >>= 1) {
        if (wave >= step && wave < 2 * step) { LAS float* dst = SM_R + ((wave - step) * 64 + lane) * 65; dst[64] = lrun;
#pragma unroll
            for (int c = 0; c < 4; ++c)
#pragma unroll
                for (int q = 0; q < 16; ++q) dst[c * 16 + q] = ot[c][q]; }
        __syncthreads();
        if (wave < step) { const LAS float* src = SM_R + (wave * 64 + lane) * 65; lrun += src[64];
#pragma unroll
            for (int c = 0; c < 4; ++c)
#pragma unroll
                for (int q = 0; q < 16; ++q) ot[c][q] += src[c * 16 + q]; }
        __syncthreads();
    }
    if (wave == 0) { const float il = 1.f / lrun;
#pragma unroll
        for (int c = 0; c < 4; ++c)
#pragma unroll
            for (int q = 0; q < 16; ++q) SM_O[r * 129 + 32 * c + crow16(q, hi)] = ot[c][q] * il; }
    __syncthreads();
    {
        const float* LAM = (const float*)(P.ws + WS_LAM); const float lam = LAM[layer], li = LAM[4 + layer];
        const int q = tid >> 5, vd0 = (tid & 31) * 4;
        float a[4]; float ss = 0.f;
#pragma unroll
        for (int k = 0; k < 4; ++k) { a[k] = SM_O[q * 129 + vd0 + k] - lam * SM_O[(q + 16) * 129 + vd0 + k]; ss += a[k] * a[k]; }
        ss += __shfl_xor(ss, 1); ss += __shfl_xor(ss, 2); ss += __shfl_xor(ss, 4); ss += __shfl_xor(ss, 8); ss += __shfl_xor(ss, 16);
        const float rr = (1.f - li) / sqrtf(ss * (1.f / 128.f) + RMS_EPS);
        const size_t base = (size_t)(MP + b * 16 + q) * 1024 + h * 128 + vd0;
        const f32x4 sl = *(const f32x4*)(P.in[I_SUBLN] + (size_t)layer * 128 + vd0);
        const u32x2 gt = *(const u32x2*)((const bf16_t*)(P.ws + WS_SAG) + base);
        u32x2 o; o.x = pkbf(a[0] * rr * sl[0] * bflo(gt.x), a[1] * rr * sl[1] * bfhi(gt.x)); o.y = pkbf(a[2] * rr * sl[2] * bflo(gt.y), a[3] * rr * sl[3] * bfhi(gt.y));
        *(u32x2*)((bf16_t*)(P.ws + WS_YB) + base) = o;
    }
    __syncthreads();
}

__global__ void __launch_bounds__(NWAVES * 64, 2) mk_fwd(Params P) {
    extern __shared__ __attribute__((aligned(16))) unsigned char lds[];
    LAS unsigned char* L = (LAS unsigned char*)lds;
    const int tid = threadIdx.x, lane = tid & 63, wave = __builtin_amdgcn_readfirstlane(tid >> 6);
    const int G = gridDim.x, bx = blockIdx.x, vcu = (G % 8 == 0) ? (bx % 8) * (G / 8) + bx / 8 : bx;
    const int gw = vcu * NWAVES + wave, NGW = G * NWAVES;
    for (int u = tid; u < (LDS_BYTES - LDSCTL_OFF) / 4; u += NWAVES * 64) ((LAS unsigned*)(L + LDSCTL_OFF))[u] = 0u;
    __syncthreads();
    unsigned char* ws = P.ws;
    XcdBarrier bar = xcd_barrier_post((unsigned*)(ws + WS_CTL) + CW_BAR + P.bar_region * XCD_BAR_WORDS, (volatile LAS unsigned*)(L + MISC_OFF) + 8);
    bf16_t* WinT = (bf16_t*)(ws + WS_WIN); bf16_t* WaT = (bf16_t*)(ws + WS_WA); bf16_t* WbT = (bf16_t*)(ws + WS_WB); bf16_t* WoT = (bf16_t*)(ws + WS_WO); bf16_t* WpT = (bf16_t*)(ws + WS_WP);
    float* X = (float*)(ws + WS_X); bf16_t* XB = (bf16_t*)(ws + WS_XB);
    float* ropec = (float*)(ws + WS_ROPEC); float* ropes = (float*)(ws + WS_ROPES);

#ifndef NO_P0
    if (P.do_pro) for (int rp_ = 0; rp_ < REP_P0; ++rp_) {
        LAS float* scr = (LAS float*)(L + RING_OFF + wave * 16384);
        constexpr int I_IN = 16 * (D_IN / 32), I_A = 8 * 32, I_B = 16 * 32, I_P = 2 * 4;
        constexpr int N_IN = DEPTH * I_IN, N_A = DEPTH * I_A, N_B = DEPTH * I_B, N_P = DEPTH * 4 * I_P;
        constexpr int NITEMS = N_IN + N_A + 2 * N_B + N_P;
        for (int it = gw; it < NITEMS; it += NGW) {
            int rr = it;
            if (rr < N_IN) { const int l = rr / I_IN; p0_transpose_item<1>(P.in[I_WIN] + (size_t)l * 1024 * D_IN, 1024, D_IN, WinT + (size_t)l * D_IN * 1024, scr, rr % I_IN, lane); continue; } rr -= N_IN;
            if (rr < N_A) { const int l = rr / I_A; p0_transpose_item<0>(P.in[I_WA] + (size_t)l * 512 * 1024, 512, 1024, WaT + (size_t)l * 1024 * 512, scr, rr % I_A, lane); continue; } rr -= N_A;
            if (rr < N_B) { const int l = rr / I_B; p0_transpose_item<0>(P.in[I_WB] + (size_t)l * 1024 * 1024, 1024, 1024, WbT + (size_t)l * 1024 * 1024, scr, rr % I_B, lane); continue; } rr -= N_B;
            if (rr < N_B) { const int l = rr / I_B; p0_transpose_item<0>(P.in[I_WO] + (size_t)l * 1024 * 1024, 1024, 1024, WoT + (size_t)l * 1024 * 1024, scr, rr % I_B, lane); continue; } rr -= N_B;
            { const int lg = rr / I_P; p0_transpose_item<0>(P.in[I_WPOOL] + (size_t)lg * 128 * 128, 128, 128, WpT + (size_t)lg * 128 * 128, scr, rr % I_P, lane); }
        }
        for (int e = gw * 64 + lane; e < SEQ * 32; e += NGW * 64) {
            const int pos = e >> 5, i = e & 31;
            const double inv = exp(-(double)i * (9.210340371976184 / 32.0)), ang = (double)pos * inv;
            ropec[e] = (float)cos(ang); ropes[e] = (float)sin(ang);
        }
        if (bx == 0 && tid < DEPTH) {
            const float* lq = P.in[I_LQK] + tid * 256; float s1 = 0.f, s2 = 0.f;
            for (int i = 0; i < 64; ++i) { s1 += lq[i] * lq[64 + i]; s2 += lq[128 + i] * lq[192 + i]; }
            const float li = 0.8f - 0.6f * expf(-0.3f * (float)tid);
            float* LAM = (float*)(ws + WS_LAM); LAM[tid] = expf(s1) - expf(s2) + li; LAM[4 + tid] = li;
        }
        for (int m = gw; m < M; m += NGW) {
            const float* xr = (m < MP) ? P.in[I_XP] + (size_t)m * 1024 : P.in[I_XS] + (size_t)(m - MP) * 1024;
            ln_row(xr, P.in[I_LIG], P.in[I_LIB], X + (size_t)m * 1024, XB + (size_t)m * 1024, lane);
        }
        xcd_barrier(bar);
    }
#endif

    for (int l = P.l_lo; l < P.l_hi; ++l) {
#ifndef NO_P1
        for (int rp_ = 0; rp_ < REP_P1; ++rp_) {
            if (rp_) xcd_barrier(bar);
            pg8::Gemm g{XB, WinT + (size_t)l * D_IN * 1024, M, D_IN, 1024}; pg8::StaticOrder S; S.init(M, D_IN, G, bx);
            EpiIn E{(bf16_t*)(ws + WS_PXB), (bf16_t*)(ws + WS_SPG), (bf16_t*)(ws + WS_QB), (bf16_t*)(ws + WS_KB), (bf16_t*)(ws + WS_VB), (bf16_t*)(ws + WS_SAG), (bf16_t*)(ws + WS_SGA), (bf16_t*)(ws + WS_SGB),
                    P.out, ropec, ropes, l};
            pg8::gemm_phase<EpiIn, pg8::StaticOrder, true, true>(L + RING_OFF, g, S, E);
        }
#endif
        xcd_barrier(bar);
#ifndef NO_SAMPLE
        for (int rp_ = 0; rp_ < REP_SAMPLE; ++rp_)
        for (int su = vcu; su < DEC_BATCH * 8; su += G) sample_unit(su >> 3, su & 7, l, P, L, tid, lane, wave);
#endif
#ifndef NO_POOL
        for (int rp_ = 0; rp_ < REP_POOL; ++rp_)
        for (int it = gw; it < (M / 32) * 4; it += NGW) pool_item(it, l, P, lane);
#endif
#ifndef NO_ATTN
        for (int rp_ = 0; rp_ < REP_ATTN; ++rp_)
        for (int su = vcu; su < 256; su += G) {
            const int bh = su >> 2, s4 = su & 3, b = bh >> 3, h = bh & 7;
            const size_t bo = (size_t)b * SEQ * 1024 + h * 128;
            for (int i = 0; i < 4; ++i) {
                const int qb = (i == 0) ? s4 : (i == 1) ? 7 - s4 : (i == 2) ? 8 + s4 : 15 - s4;
                for (int sub = 0; sub < 4; ++sub) {
                    const int mp = sub >> 1, vh = sub & 1;
                    attn_body::attn_unit<8>(qb, (const attn_body::bf16*)(ws + WS_QB) + bo + mp * 64, (const attn_body::bf16*)(ws + WS_KB) + bo + mp * 64,
                                            (const attn_body::bf16*)(ws + WS_VB) + bo + vh * 64, (float*)(ws + (mp ? WS_O2 : WS_O1)) + bo + vh * 64, (char*)lds + RING_OFF);
                }
                asm volatile("s_waitcnt vmcnt(0)" ::: "memory"); __syncthreads();
                combine_rows((size_t)b * SEQ + (size_t)qb * 256, h, l, P, tid);
            }
        }
#endif
        xcd_barrier(bar);
#ifndef NO_P3
        for (int rp_ = 0; rp_ < REP_P3; ++rp_) {
        if (rp_) xcd_barrier(bar);
        {
            pg8::Gemm g{(const bf16_t*)(ws + WS_YA), WaT + (size_t)l * 1024 * 512, M, 1024, 512}; pg8::StaticOrder S; S.init(M, 1024, G, bx);
            EpiMergeA E{(const bf16_t*)(ws + WS_SGA), (float*)(ws + WS_TMPA)};
            pg8::gemm_phase<EpiMergeA, pg8::StaticOrder, true, true>(L + RING_OFF, g, S, E);
        }
        {
            pg8::Gemm g{(const bf16_t*)(ws + WS_YB), WbT + (size_t)l * 1024 * 1024, M, 1024, 1024}; pg8::StaticOrder S; S.init(M, 1024, G, bx);
            EpiMergeB E{(const bf16_t*)(ws + WS_SGB), (const float*)(ws + WS_TMPA), (bf16_t*)(ws + WS_MG)};
            pg8::gemm_phase<EpiMergeB, pg8::StaticOrder, true, true>(L + RING_OFF, g, S, E);
        }
        }
#endif
        xcd_barrier(bar);
#ifndef NO_P4
        {
            pg8::Gemm g{(const bf16_t*)(ws + WS_MG), WoT + (size_t)l * 1024 * 1024, M, 1024, 1024}; pg8::StaticOrder S; S.init(M, 1024, G, bx);
            EpiOut E{X};
            pg8::gemm_phase<EpiOut, pg8::StaticOrder, true, true>(L + RING_OFF, g, S, E);
        }
#endif
        xcd_barrier(bar);
        {
            float* dst = (l == DEPTH - 1) ? P.out + O_Y : X;
            for (int m = gw; m < M; m += NGW) ln_row(X + (size_t)m * 1024, P.in[I_LNG] + (size_t)l * 1024, P.in[I_LNB] + (size_t)l * 1024, dst + (size_t)m * 1024, XB + (size_t)m * 1024, lane);
        }
        if (l + 1 < P.l_hi) xcd_barrier(bar);
    }
}
static int mk_grid_setup() {
    static int grid = 0;
    if (grid == 0) {
        int dev = 0, cus = 0;
        if (hipGetDevice(&dev) != hipSuccess || hipDeviceGetAttribute(&cus, hipDeviceAttributeMultiprocessorCount, dev) != hipSuccess || cus < 8) { fprintf(stderr, "kernel_launch: device query failed\n"); grid = -1; return grid; }
        if (hipFuncSetAttribute((const void*)mk_fwd, hipFuncAttributeMaxDynamicSharedMemorySize, LDS_BYTES) != hipSuccess) { fprintf(stderr, "kernel_launch: hipFuncSetAttribute failed\n"); grid = -1; return grid; }
        int per_cu = 0;
        if (hipOccupancyMaxActiveBlocksPerMultiprocessor(&per_cu, (const void*)mk_fwd, NWAVES * 64, LDS_BYTES) != hipSuccess || per_cu < 1) fprintf(stderr, "kernel_launch: occupancy query reports %d\n", per_cu);
        (void)hipGetLastError();
        grid = cus;
    }
    return grid;
}
static void mk_launch(void* const* d_in, float* out, void* d_ws, int l_lo, int l_hi, int do_pro, int region, hipStream_t stream) {
    const int grid = mk_grid_setup(); if (grid < 0) return;
    Params p{};
    for (int i = 0; i < 17; ++i) p.in[i] = (const float*)d_in[i];
    p.out = out; p.ws = (unsigned char*)d_ws; p.l_lo = l_lo; p.l_hi = l_hi; p.do_pro = do_pro; p.bar_region = region;
    hipLaunchKernelGGL(mk_fwd, dim3(grid), dim3(NWAVES * 64), LDS_BYTES, stream, p);
    const hipError_t le = hipPeekAtLastError();
    if (le != hipSuccess) fprintf(stderr, "kernel_launch: launch failed: %s\n", hipGetErrorName(le));
}

#if !DEBUG_CHECK
extern "C" void kernel_launch(void* const* d_in, const int* in_sizes, int n_in, void* d_out, int out_size, void* d_ws, size_t ws_size, hipStream_t stream) {
    if (n_in != 17 || (size_t)out_size != O_END || ws_size < WS_END || in_sizes[0] != MP * 1024) { fprintf(stderr, "kernel_launch: unexpected sizes n_in %d out %d ws %zu\n", n_in, out_size, ws_size); return; }
    if (hipMemsetAsync((char*)d_ws + WS_CTL, 0, CTL_ZERO_BYTES, stream) != hipSuccess) return;
    mk_launch(d_in, (float*)d_out, d_ws, 0, DEPTH, 1, 0, stream);
}
#else
constexpr int C_PX = 0, C_PG = 512, C_Q = 1024, C_K = 2048, C_V = 3072, C_AG = 4096, C_GA = 5120, C_GB = 6144;
__device__ __forceinline__ float silu_f(float x) { return x / (1.f + __expf(-x)); }
__device__ __forceinline__ float sigmoid_f(float x) { return 1.f / (1.f + __expf(-x)); }
__global__ void __launch_bounds__(256) nv_ln(const float* in, const float* add, float alpha, const float* g, const float* b, float* out, int rows) {
    const int row = blockIdx.x * 4 + (threadIdx.x >> 6), lane = threadIdx.x & 63;
    if (row >= rows) return;
    const float4* xi = (const float4*)(in + (size_t)row * 1024) + lane;
    float4 v[4]; float s = 0.f;
#pragma unroll
    for (int j = 0; j < 4; ++j) {
        v[j] = xi[64 * j];
        if (add) { const float4 a = ((const float4*)(add + (size_t)row * 1024) + lane)[64 * j]; v[j].x = alpha * v[j].x + a.x; v[j].y = alpha * v[j].y + a.y; v[j].z = alpha * v[j].z + a.z; v[j].w = alpha * v[j].w + a.w; }
        s += (v[j].x + v[j].y) + (v[j].z + v[j].w);
    }
    const float mean = wave_sum(s) * (1.f / 1024.f); float s2 = 0.f;
#pragma unroll
    for (int j = 0; j < 4; ++j) { v[j].x -= mean; v[j].y -= mean; v[j].z -= mean; v[j].w -= mean; s2 += (v[j].x * v[j].x + v[j].y * v[j].y) + (v[j].z * v[j].z + v[j].w * v[j].w); }
    const float rstd = 1.f / sqrtf(wave_sum(s2) * (1.f / 1024.f) + LN_EPS);
    float4* o = (float4*)(out + (size_t)row * 1024) + lane;
#pragma unroll
    for (int j = 0; j < 4; ++j) { const float4 gg = ((const float4*)g + lane)[64 * j], bb = ((const float4*)b + lane)[64 * j];
        float4 r; r.x = v[j].x * rstd * gg.x + bb.x; r.y = v[j].y * rstd * gg.y + bb.y; r.z = v[j].z * rstd * gg.z + bb.z; r.w = v[j].w * rstd * gg.w + bb.w; o[64 * j] = r; }
}
__global__ void __launch_bounds__(256) nv_gemm(const float* __restrict__ A, int lda, const float* __restrict__ W, int ldw, float* __restrict__ C, int ldc, int K) {
    __shared__ float As[8][132];
    __shared__ float Ws[8][128];
    const int bm = blockIdx.y * 128, bn = blockIdx.x * 128, tid = threadIdx.x, tx = tid & 15, ty = tid >> 4;
    float acc[8][8];
#pragma unroll
    for (int i = 0; i < 8; ++i)
#pragma unroll
        for (int j = 0; j < 8; ++j) acc[i][j] = 0.f;
    const float* Ap = A + (size_t)(bm + (tid >> 1)) * lda + (tid & 1) * 4;
    const float* Wp = W + (size_t)(tid >> 5) * ldw + bn + (tid & 31) * 4;
    for (int k0 = 0; k0 < K; k0 += 8) {
        const float4 a = *(const float4*)(Ap + k0);
        const float4 w = *(const float4*)(Wp + (size_t)k0 * ldw);
        As[(tid & 1) * 4 + 0][tid >> 1] = a.x; As[(tid & 1) * 4 + 1][tid >> 1] = a.y; As[(tid & 1) * 4 + 2][tid >> 1] = a.z; As[(tid & 1) * 4 + 3][tid >> 1] = a.w;
        *(float4*)&Ws[tid >> 5][(tid & 31) * 4] = w;
        __syncthreads();
#pragma unroll
        for (int kk = 0; kk < 8; ++kk) {
            float av[8], bv[8];
#pragma unroll
            for (int i = 0; i < 8; ++i) av[i] = As[kk][ty * 8 + i];
#pragma unroll
            for (int j = 0; j < 8; ++j) bv[j] = Ws[kk][tx * 8 + j];
#pragma unroll
            for (int i = 0; i < 8; ++i)
#pragma unroll
                for (int j = 0; j < 8; ++j) acc[i][j] += av[i] * bv[j];
        }
        __syncthreads();
    }
#pragma unroll
    for (int i = 0; i < 8; ++i) {
        float* cp = C + (size_t)(bm + ty * 8 + i) * ldc + bn + tx * 8;
        *(float4*)cp = make_float4(acc[i][0], acc[i][1], acc[i][2], acc[i][3]);
        *(float4*)(cp + 4) = make_float4(acc[i][4], acc[i][5], acc[i][6], acc[i][7]);
    }
}
__global__ void nv_lambda(const float* lq, float* lam) {
    const int l = threadIdx.x;
    if (l < DEPTH) {
        float s1 = 0.f, s2 = 0.f;
        for (int i = 0; i < 64; ++i) { s1 += lq[l * 256 + i] * lq[l * 256 + 64 + i]; s2 += lq[l * 256 + 128 + i] * lq[l * 256 + 192 + i]; }
        const float li = 0.8f - 0.6f * expf(-0.3f * (float)l);
        lam[l] = expf(s1) - expf(s2) + li; lam[4 + l] = li;
    }
}
__global__ void __launch_bounds__(256) nv_rope_split(float* H, float* out, int layer) {
    const int row = blockIdx.x;
    const bool samp = row >= MP;
    const int pos = samp ? PAST + ((row - MP) & 15) : (row & (SEQ - 1));
    float* h = H + (size_t)row * D_IN;
    float* ko = samp ? out + O_KS + ((size_t)layer * MS + (row - MP)) * 1024 : out + O_KP + ((size_t)layer * MP + row) * 1024;
    float* vo = samp ? out + O_VS + ((size_t)layer * MS + (row - MP)) * 1024 : out + O_VP + ((size_t)layer * MP + row) * 1024;
    for (int p = threadIdx.x; p < 1024; p += 256) {
        const int pp = p & 511, blk = pp >> 5, i = pp & 31;
        const int c = (p < 512 ? C_Q : C_K) + blk * 64 + i;
        const double inv = exp(-(double)i / 32.0 * 9.210340371976184);
        const double ang = (double)pos * inv;
        const float cs = (float)cos(ang), sn = (float)sin(ang);
        const float x1 = h[c], x2 = h[c + 32];
        const float r1 = x1 * cs - x2 * sn, r2 = x2 * cs + x1 * sn;
        h[c] = r1; h[c + 32] = r2;
        if (p >= 512) { ko[blk * 64 + i] = r1; ko[blk * 64 + i + 32] = r2; }
    }
    for (int c = threadIdx.x; c < 1024; c += 256) vo[c] = h[C_V + c];
    if (!samp) { const int t = row & (SEQ - 1), b = row >> 12;
        if (t >= SEQ - 15) { float* po = out + O_PP + (((size_t)layer * BATCH + b) * 15 + (t - (SEQ - 15))) * 512; for (int c = threadIdx.x; c < 512; c += 256) po[c] = h[C_PX + c]; }
    } else { const int j = (row - MP) & 15, b = (row - MP) >> 4;
        if (j >= 1) { float* po = out + O_PS + (((size_t)layer * DEC_BATCH + b) * 15 + (j - 1)) * 512; for (int c = threadIdx.x; c < 512; c += 256) po[c] = h[C_PX + c]; }
    }
}
__global__ void __launch_bounds__(256) nv_pool(const float* H, const float* state_pool_l, float* pooled) {
    const int row = blockIdx.x;
    const bool samp = row >= MP;
    for (int c = threadIdx.x; c < 512; c += 256) {
        const int g = c >> 7, w = 2 << g;
        float s = 0.f; int cnt;
        if (!samp) { const int t = row & (SEQ - 1); cnt = (t + 1 < w) ? t + 1 : w;
            for (int d = 0; d < cnt; ++d) s += H[(size_t)(row - d) * D_IN + C_PX + c];
        } else { const int j = (row - MP) & 15, b = (row - MP) >> 4; cnt = w;
            for (int d = 0; d < w; ++d) { const int jj = j - d;
                s += (jj >= 0) ? H[(size_t)(row - d) * D_IN + C_PX + c] : state_pool_l[((size_t)b * 15 + (15 + jj)) * 512 + c]; }
        }
        pooled[(size_t)row * 512 + c] = s / (float)cnt - H[(size_t)row * D_IN + C_PX + c];
    }
}
__global__ void __launch_bounds__(256) nv_ya_gate(float* ya, const float* H, const float* pool_scale_l) {
    const int row = blockIdx.x;
    for (int c = threadIdx.x; c < 512; c += 256) ya[(size_t)row * 512 + c] *= pool_scale_l[c] * silu_f(H[(size_t)row * D_IN + C_PG + c]);
}
__global__ void __launch_bounds__(64) nv_attn(const float* __restrict__ H, int rowbase0, int rows_per_batch, int nq,
                                             const float* __restrict__ cK, const float* __restrict__ cV, int n1, int causal, float* O1, float* O2) {
    __shared__ float Ks[16][64];
    __shared__ float Vs[16][128];
    const int qb = blockIdx.x, hm = blockIdx.y, b = blockIdx.z, h = hm >> 1, mp = hm & 1, t = threadIdx.x;
    const int rowb = rowbase0 + b * rows_per_batch;
    const int qrow = rowb + qb * 64 + t;
    const bool act = t < nq;
    float q[64];
#pragma unroll
    for (int d = 0; d < 64; ++d) q[d] = act ? H[(size_t)qrow * D_IN + C_Q + h * 128 + mp * 64 + d] * 0.125f : 0.f;
    float o[128];
#pragma unroll
    for (int d = 0; d < 128; ++d) o[d] = 0.f;
    float mx = -INFINITY, l = 0.f;
    const int n2 = causal ? (qb + 1) * 64 : rows_per_batch;
    const int ntot = n1 + n2;
    for (int k0 = 0; k0 < ntot; k0 += 16) {
        __syncthreads();
#pragma unroll
        for (int i = 0; i < 16; ++i) { const int idx = i * 64 + t, kj = idx >> 6, d = idx & 63, key = k0 + kj;
            float v = 0.f;
            if (key < ntot) v = (key < n1) ? cK[((size_t)b * n1 + key) * 1024 + h * 128 + mp * 64 + d] : H[(size_t)(rowb + key - n1) * D_IN + C_K + h * 128 + mp * 64 + d];
            Ks[kj][d] = v; }
#pragma unroll
        for (int i = 0; i < 32; ++i) { const int idx = i * 64 + t, kj = idx >> 7, d = idx & 127, key = k0 + kj;
            float v = 0.f;
            if (key < ntot) v = (key < n1) ? cV[((size_t)b * n1 + key) * 1024 + h * 128 + d] : H[(size_t)(rowb + key - n1) * D_IN + C_V + h * 128 + d];
            Vs[kj][d] = v; }
        __syncthreads();
        const int kend = (ntot - k0 < 16) ? ntot - k0 : 16;
        for (int kj = 0; kj < kend; ++kj) {
            float s = 0.f;
#pragma unroll
            for (int d = 0; d < 64; ++d) s += q[d] * Ks[kj][d];
            const float mn = fmaxf(mx, s), f = __expf(mx - mn), p = __expf(s - mn);
            l = l * f + p; mx = mn;
#pragma unroll
            for (int d = 0; d < 128; ++d) o[d] = o[d] * f + p * Vs[kj][d];
        }
    }
    if (act) { float* O = (mp ? O2 : O1) + (size_t)qrow * 1024 + h * 128; const float il = 1.f / l;
#pragma unroll
        for (int d = 0; d < 128; d += 4) *(float4*)(O + d) = make_float4(o[d] * il, o[d + 1] * il, o[d + 2] * il, o[d + 3] * il); }
}
__global__ void __launch_bounds__(256) nv_combine(const float* O1, const float* O2, const float* lam, int layer, const float* subln_l, const float* H, float* YB) {
    const int idx = blockIdx.x * 4 + (threadIdx.x >> 6), lane = threadIdx.x & 63;
    const int row = idx >> 3, h = idx & 7;
    const float lm = lam[layer], li = lam[4 + layer];
    const size_t base = (size_t)row * 1024 + h * 128;
    const float a0 = O1[base + lane] - lm * O2[base + lane], a1 = O1[base + 64 + lane] - lm * O2[base + 64 + lane];
    const float ms = wave_sum(a0 * a0 + a1 * a1) * (1.f / 128.f);
    const float r = 1.f / sqrtf(ms + RMS_EPS) * (1.f - li);
    YB[base + lane] = a0 * r * subln_l[lane] * silu_f(H[(size_t)row * D_IN + C_AG + h * 128 + lane]);
    YB[base + 64 + lane] = a1 * r * subln_l[64 + lane] * silu_f(H[(size_t)row * D_IN + C_AG + h * 128 + 64 + lane]);
}
__global__ void __launch_bounds__(256) nv_merge(float* TA, const float* TB, const float* H) {
    const int row = blockIdx.x;
    for (int c = threadIdx.x; c < 1024; c += 256) { const size_t i = (size_t)row * 1024 + c;
        TA[i] = sigmoid_f(H[(size_t)row * D_IN + C_GA + c]) * TA[i] + sigmoid_f(H[(size_t)row * D_IN + C_GB + c]) * TB[i]; }
}
__global__ void __launch_bounds__(256) dbg_cmp(const void* a, int a_bf16, int lda, const float* b, int ldb, int rows, int cols, float ascale, int bact, float* err, int slot) {
    __shared__ float red[2][4];
    float num = 0.f, den = 0.f;
    const size_t n = (size_t)rows * cols;
    for (size_t i = (size_t)blockIdx.x * 256 + threadIdx.x; i < n; i += (size_t)gridDim.x * 256) {
        const size_t r = i / cols, c = i % cols;
        float av = a_bf16 ? __uint_as_float((unsigned)((const unsigned short*)a)[r * lda + c] << 16) : ((const float*)a)[r * lda + c];
        float bv = b[r * ldb + c];
        if (bact == 1) bv = silu_f(bv); else if (bact == 2) bv = sigmoid_f(bv);
        const float d = av * ascale - bv; num += d * d; den += bv * bv;
    }
    num = wave_sum(num); den = wave_sum(den);
    if ((threadIdx.x & 63) == 0) { red[0][threadIdx.x >> 6] = num; red[1][threadIdx.x >> 6] = den; }
    __syncthreads();
    if (threadIdx.x == 0) { atomicAdd(err + 2 * slot, red[0][0] + red[0][1] + red[0][2] + red[0][3]); atomicAdd(err + 2 * slot + 1, red[1][0] + red[1][1] + red[1][2] + red[1][3]); }
}
#ifndef DBG_SLOT
#define DBG_SLOT -1
#endif
__global__ void dbg_final(const float* err, int nslots, float tol, float* pool_sample, int n) {
    __shared__ float sc;
    if (threadIdx.x == 0) {
        float s = 1.f;
        if (DBG_SLOT >= 0) { const float e = err[2 * DBG_SLOT] / fmaxf(err[2 * DBG_SLOT + 1], 1e-30f); s = 1.f + sqrtf(fminf(e, 4.f)); }
        else { for (int i = 0; i < nslots; ++i) { const float e = err[2 * i] / fmaxf(err[2 * i + 1], 1e-30f); if (!(e <= tol)) { s = 1.f + 0.01f * (float)(i + 1); break; } } }
        sc = s;
    }
    __syncthreads();
    for (int i = blockIdx.x * 256 + threadIdx.x; i < n; i += gridDim.x * 256) pool_sample[i] *= sc;
}
#define NSLOT_L 24
extern "C" void kernel_launch(void* const* d_in, const int* in_sizes, int n_in, void* d_out, int out_size, void* d_ws, size_t ws_size, hipStream_t stream) {
    const float* x_prompt = (const float*)d_in[0]; const float* x_sample = (const float*)d_in[1];
    const float* cache_k = (const float*)d_in[2]; const float* cache_v = (const float*)d_in[3]; const float* state_pool = (const float*)d_in[4];
    const float* ln_in_g = (const float*)d_in[5]; const float* ln_in_b = (const float*)d_in[6]; const float* w_in = (const float*)d_in[7];
    const float* w_pool = (const float*)d_in[8]; const float* pool_scale = (const float*)d_in[9]; const float* lambda_qk = (const float*)d_in[10];
    const float* subln_w = (const float*)d_in[11]; const float* w_a = (const float*)d_in[12]; const float* w_b = (const float*)d_in[13];
    const float* w_o = (const float*)d_in[14]; const float* ln_g = (const float*)d_in[15]; const float* ln_b = (const float*)d_in[16];
    float* out = (float*)d_out;
    const size_t R = RB4;
    const size_t NV0 = 1300 * MiB;
    const size_t NV_END = NV0 + 4096 + R + (size_t)M * D_IN * 4 + 7 * R;
    const size_t OUT2 = NV_END;
    const size_t need = OUT2 + O_END * 4;
    if (n_in != 17 || (size_t)out_size != O_END || ws_size < need) { fprintf(stderr, "kernel_launch: unexpected sizes n_in %d out %d ws %zu need %zu\n", n_in, out_size, ws_size, need); return; }
    unsigned char* ws = (unsigned char*)d_ws;
    hipMemsetAsync(ws + WS_CTL, 0, CTL_ZERO_BYTES, stream);
    float* ERR = (float*)(ws + WS_CTL + 512 * 1024);
    float* LAM = (float*)(ws + NV0);
    float* X = (float*)(ws + NV0 + 4096);
    float* H = (float*)(ws + NV0 + 4096 + R);
    unsigned char* p = ws + NV0 + 4096 + R + (size_t)M * D_IN * 4;
    float* POOLED = (float*)p; float* YA = (float*)(p + R / 2);
    float* O1 = (float*)(p + R); float* O2 = (float*)(p + 2 * R); float* YB = (float*)(p + 3 * R);
    float* TA = (float*)(p + 4 * R); float* TB = (float*)(p + 5 * R); float* OUTB = (float*)(p + 6 * R);
    float* out2 = (float*)(ws + OUT2);
    const void* oXB = ws + WS_XB; const void* oPXB = ws + WS_PXB; const void* oSPG = ws + WS_SPG; const void* oQB = ws + WS_QB; const void* oKB = ws + WS_KB; const void* oVB = ws + WS_VB;
    const void* oSAG = ws + WS_SAG; const void* oSGA = ws + WS_SGA; const void* oSGB = ws + WS_SGB; const void* oO1 = ws + WS_O1; const void* oO2 = ws + WS_O2;
    const void* oYA = ws + WS_YA; const void* oYB = ws + WS_YB; const void* oMG = ws + WS_MG; const void* oX = ws + WS_X;
#define CMP(slot, a, abf, lda, b, ldb, rows, cols, asc, bact) dbg_cmp<<<1024, 256, 0, stream>>>(a, abf, lda, b, ldb, rows, cols, asc, bact, ERR, slot)

    nv_lambda<<<1, 64, 0, stream>>>(lambda_qk, LAM);
    nv_ln<<<MP / 4, 256, 0, stream>>>(x_prompt, nullptr, 1.f, ln_in_g, ln_in_b, X, MP);
    nv_ln<<<MS / 4, 256, 0, stream>>>(x_sample, nullptr, 1.f, ln_in_g, ln_in_b, X + (size_t)MP * 1024, MS);
    for (int l = 0; l < DEPTH; ++l) {
        const int s0 = l * NSLOT_L;
        mk_launch(d_in, out2, d_ws, l, l + 1, l == 0, l, stream);
        nv_gemm<<<dim3(D_IN / 128, M / 128), 256, 0, stream>>>(X, 1024, w_in + (size_t)l * 1024 * D_IN, D_IN, H, D_IN, 1024);
        nv_rope_split<<<M, 256, 0, stream>>>(H, out, l);
        nv_pool<<<M, 256, 0, stream>>>(H, state_pool + (size_t)l * DEC_BATCH * 15 * 512, POOLED);
        for (int g = 0; g < 4; ++g)
            nv_gemm<<<dim3(1, M / 128), 256, 0, stream>>>(POOLED + g * 128, 512, w_pool + ((size_t)l * 4 + g) * 128 * 128, 128, YA + g * 128, 512, 128);
        nv_ya_gate<<<M, 256, 0, stream>>>(YA, H, pool_scale + (size_t)l * 512);
        nv_attn<<<dim3(SEQ / 64, 16, BATCH), 64, 0, stream>>>(H, 0, SEQ, 64, nullptr, nullptr, 0, 1, O1, O2);
        nv_attn<<<dim3(1, 16, DEC_BATCH), 64, 0, stream>>>(H, MP, DEC_SEQ, DEC_SEQ, cache_k + (size_t)l * DEC_BATCH * PAST * 1024, cache_v + (size_t)l * DEC_BATCH * PAST * 1024, PAST, 0, O1, O2);
        nv_combine<<<M * 8 / 4, 256, 0, stream>>>(O1, O2, LAM, l, subln_w + (size_t)l * 128, H, YB);
        nv_gemm<<<dim3(1024 / 128, M / 128), 256, 0, stream>>>(YA, 512, w_a + (size_t)l * 512 * 1024, 1024, TA, 1024, 512);
        nv_gemm<<<dim3(1024 / 128, M / 128), 256, 0, stream>>>(YB, 1024, w_b + (size_t)l * 1024 * 1024, 1024, TB, 1024, 1024);
        nv_merge<<<M, 256, 0, stream>>>(TA, TB, H);
        nv_gemm<<<dim3(1024 / 128, M / 128), 256, 0, stream>>>(TA, 1024, w_o + (size_t)l * 1024 * 1024, 1024, OUTB, 1024, 1024);
        nv_ln<<<M / 4, 256, 0, stream>>>(X, OUTB, ALPHA, ln_g + (size_t)l * 1024, ln_b + (size_t)l * 1024, (l == DEPTH - 1) ? out + O_Y : X, M);
        CMP(s0 + 1, oPXB, 1, 512, H + C_PX, D_IN, M, 512, 1.f, 0);
        CMP(s0 + 2, oSPG, 1, 512, H + C_PG, D_IN, M, 512, 1.f, 1);
        CMP(s0 + 3, oVB, 1, 1024, H + C_V, D_IN, M, 1024, 1.f, 0);
        CMP(s0 + 4, oSAG, 1, 1024, H + C_AG, D_IN, M, 1024, 1.f, 1);
        CMP(s0 + 5, oSGA, 1, 1024, H + C_GA, D_IN, M, 1024, 1.f, 2);
        CMP(s0 + 6, oSGB, 1, 1024, H + C_GB, D_IN, M, 1024, 1.f, 2);
        CMP(s0 + 7, oKB, 1, 1024, H + C_K, D_IN, M, 1024, 1.f, 0);
        CMP(s0 + 8, oQB, 1, 1024, H + C_Q, D_IN, M, 1024, 1.f / C2, 0);
        CMP(s0 + 9, out2 + O_KP + (size_t)l * MP * 1024, 0, 1024, out + O_KP + (size_t)l * MP * 1024, 1024, MP, 1024, 1.f, 0);
        CMP(s0 + 10, out2 + O_VP + (size_t)l * MP * 1024, 0, 1024, out + O_VP + (size_t)l * MP * 1024, 1024, MP, 1024, 1.f, 0);
        CMP(s0 + 11, out2 + O_PP + (size_t)l * BATCH * 15 * 512, 0, 512, out + O_PP + (size_t)l * BATCH * 15 * 512, 512, BATCH * 15, 512, 1.f, 0);
        CMP(s0 + 12, out2 + O_KS + (size_t)l * MS * 1024, 0, 1024, out + O_KS + (size_t)l * MS * 1024, 1024, MS, 1024, 1.f, 0);
        CMP(s0 + 13, out2 + O_VS + (size_t)l * MS * 1024, 0, 1024, out + O_VS + (size_t)l * MS * 1024, 1024, MS, 1024, 1.f, 0);
        CMP(s0 + 14, out2 + O_PS + (size_t)l * DEC_BATCH * 15 * 512, 0, 512, out + O_PS + (size_t)l * DEC_BATCH * 15 * 512, 512, DEC_BATCH * 15, 512, 1.f, 0);
        CMP(s0 + 15, oYA, 1, 512, YA, 512, M, 512, 1.f, 0);
        CMP(s0 + 16, oO1, 0, 1024, O1, 1024, MP, 1024, 1.f, 0);
        CMP(s0 + 17, oO2, 0, 1024, O2, 1024, MP, 1024, 1.f, 0);
        CMP(s0 + 18, oYB, 1, 1024, YB, 1024, MP, 1024, 1.f, 0);
        CMP(s0 + 19, (const unsigned short*)oYB + (size_t)MP * 1024, 1, 1024, YB + (size_t)MP * 1024, 1024, MS, 1024, 1.f, 0);
        CMP(s0 + 20, oMG, 1, 1024, TA, 1024, M, 1024, 1.f, 0);
        CMP(s0 + 21, (l == DEPTH - 1) ? (const void*)(out2 + O_Y) : oX, 0, 1024, (l == DEPTH - 1) ? out + O_Y : X, 1024, M, 1024, 1.f, 0);
    }
    dbg_final<<<64, 256, 0, stream>>>(ERR, DEPTH * NSLOT_L, 1e-3f, out + O_PS, DEPTH * DEC_BATCH * 15 * 512);
}
#endif
```

```cpp
#include <hip/hip_runtime.h>
#include <hip/hip_bf16.h>
#include <cstdio>
#include <cstdint>
#include <cmath>

#ifndef DEBUG_CHECK
#define DEBUG_CHECK 0
#endif

constexpr int D_MODEL = 1024, BATCH = 8, SEQ = 4096, DEPTH = 4, DEC_BATCH = 32, DEC_SEQ = 16, PAST = 1024;
constexpr int D_POOL = 512, D_IN = 7168;
constexpr int MP = BATCH * SEQ, MS = DEC_BATCH * DEC_SEQ, M = MP + MS;
constexpr float LN_EPS = 1e-5f, RMS_EPS = 1e-5f;
constexpr float ALPHA = 1.681792830507429f;
constexpr float C2 = 0.125f * 1.4426950408889634f;
constexpr size_t O_Y = 0, O_KP = (size_t)M * 1024, O_VP = O_KP + (size_t)DEPTH * MP * 1024, O_PP = O_VP + (size_t)DEPTH * MP * 1024,
                 O_KS = O_PP + (size_t)DEPTH * BATCH * 15 * 512, O_VS = O_KS + (size_t)DEPTH * MS * 1024, O_PS = O_VS + (size_t)DEPTH * MS * 1024,
                 O_END = O_PS + (size_t)DEPTH * DEC_BATCH * 15 * 512;
constexpr size_t MiB = 1u << 20;
constexpr size_t RB2 = (size_t)M * 1024 * 2, RB4 = (size_t)M * 1024 * 4;
constexpr size_t WS_CTL = 0, CTL_ZERO_BYTES = 1 * MiB;
constexpr size_t WS_LAM = 1 * MiB;
constexpr size_t WS_ROPEC = 2 * MiB, WS_ROPES = WS_ROPEC + 512 * 1024;
constexpr size_t WS_WIN = 4 * MiB, WS_WA = 60 * MiB, WS_WB = 64 * MiB, WS_WO = 72 * MiB, WS_WP = 80 * MiB;
constexpr size_t WS_X = 96 * MiB;
constexpr size_t WS_XB = WS_X + RB4;
constexpr size_t WS_PXB = WS_XB + RB2;
constexpr size_t WS_SPG = WS_PXB + RB2 / 2;
constexpr size_t WS_QB = WS_SPG + RB2 / 2, WS_KB = WS_QB + RB2, WS_VB = WS_KB + RB2;
constexpr size_t WS_SAG = WS_VB + RB2, WS_SGA = WS_SAG + RB2, WS_SGB = WS_SGA + RB2;
constexpr size_t WS_O1 = WS_SGB + RB2, WS_O2 = WS_O1 + RB4;
constexpr size_t WS_YA = WS_O2 + RB4, WS_YB = WS_YA + RB2 / 2;
constexpr size_t WS_TMPA = WS_YB + RB2, WS_MG = WS_TMPA + RB4;
constexpr size_t WS_END = WS_MG + RB2;
static_assert(WS_END <= 1300 * MiB && WS_WP + 512 * 1024 <= WS_X && WS_WIN + (size_t)DEPTH * D_IN * 1024 * 2 <= WS_WA, "d_ws map");
constexpr int CW_BAR = 4096;
constexpr int RING_OFF = 0, RING_BYTES = 131072;
constexpr int LDSCTL_OFF = RING_BYTES, MISC_OFF = LDSCTL_OFF + 320;
constexpr int LDS_BYTES = 147456;
constexpr int NWAVES = 8;
#ifndef REP_P0
#define REP_P0 1
#endif
#ifndef REP_P1
#define REP_P1 1
#endif
#ifndef REP_SAMPLE
#define REP_SAMPLE 1
#endif
#ifndef REP_POOL
#define REP_POOL 1
#endif
#ifndef REP_ATTN
#define REP_ATTN 1
#endif
#ifndef REP_P3
#define REP_P3 1
#endif
namespace pg8 {
#define PG8_LAS __attribute__((address_space(3)))
typedef unsigned short bf16_t;
typedef short bf16x8 __attribute__((ext_vector_type(8)));
typedef float f32x4 __attribute__((ext_vector_type(4)));
typedef unsigned u32x4 __attribute__((ext_vector_type(4)));
constexpr int BM = 256, BK = 64, HALF = 128, HTB = HALF * BK * 2  , STAGE_BYTES = 8 * HTB, NXCD = 8, WGM = 8;

__host__ __device__ __forceinline__ int lds_byte(int r, int c) { const int st = (r >> 4) * 2 + (c >> 5), rr = r & 15, cc = c & 31, ob = rr * 64 + cc * 2; return st * 1024 + (ob ^ (((ob >> 9) & 1) << 5)); }
__host__ __device__ __forceinline__ void stage_rc(int b, int& R, int& C) { const int st = b / 1024, sb = b % 1024, swz = sb ^ (((sb >> 9) & 1) << 5); R = (st >> 1) * 16 + swz / 64; C = (st & 1) * 32 + (swz % 64) / 2; }
__host__ __device__ __forceinline__ int perm32(int rho) { const int n = rho >> 4, i = rho & 15; return 8 * (i >> 2) + 4 * n + (i & 3); }

struct Unit { int pm, pn; };
struct Gemm { const bf16_t* A; const bf16_t* Bt; int M, N, K; };

struct StaticOrder {
    int nM, nN, nwg, G, c;
    __host__ __device__ void init(int M, int N, int G_, int c_) { nM = M / BM; nN = N / BM; nwg = nM * nN; G = G_; c = c_; }
    __host__ __device__ bool next(int i, Unit& u) const {
        const long L = (long)i * G + c; if (L >= nwg) return false;
        int wgid = (int)L; { const int q = nwg / NXCD, r = nwg % NXCD, xcd = wgid % NXCD, off = wgid / NXCD; wgid = (xcd < r ? xcd * (q + 1) : r * (q + 1) + (xcd - r) * q) + off; }
        const int nig = WGM * nN, gid = wgid / nig, fm = gid * WGM, gsz = (nM - fm) < WGM ? (nM - fm) : WGM;
        u.pm = fm + ((wgid % nig) % gsz); u.pn = (wgid % nig) / gsz; return true;
    }
    __device__ __forceinline__ void a_ready(const Unit&) const {}
    __device__ __forceinline__ void done(const Unit&) const {}
};

__device__ __forceinline__ unsigned cvt_pk_bf16(float lo, float hi) { unsigned r; asm volatile("v_cvt_pk_bf16_f32 %0, %1, %2" : "=v"(r) : "v"(lo), "v"(hi)); return r; }
typedef float f32x2 __attribute__((ext_vector_type(2)));
template <class Epi, class Sched, bool ALIGN_EPI = false, bool SP2 = false>
__device__ __forceinline__ void gemm_phase(PG8_LAS unsigned char* lds, const Gemm g, const Sched& S, const Epi& E, const int wave_id) {
    int tid_o; asm volatile("v_mbcnt_lo_u32_b32 %0, -1, 0\n\tv_mbcnt_hi_u32_b32 %0, -1, %0" : "=v"(tid_o)); tid_o += wave_id * 64;
    const int tid = tid_o, wid = __builtin_amdgcn_readfirstlane(tid >> 6), lane = tid & 63, wr = wid >> 2, wc = wid & 3, fr = lane & 15, fq = lane >> 4;
    const int K = g.K, nt = K / BK;
    unsigned voffA[2], voffB[2];
#pragma unroll
    for (int i = 0; i < 2; ++i) { int R, C; stage_rc(tid * 16 + i * 8192, R, C); const int Rb = Epi::PERM ? ((R & ~31) + perm32(R & 31)) : R;
        voffA[i] = (unsigned)(R * K + C) * 2u; voffB[i] = (unsigned)(Rb * K + C) * 2u; }
    const size_t kstep = (size_t)(BK * 2);
    const size_t hstep = (size_t)HALF * K * 2;
    const size_t tstep = 2 * hstep;
    const unsigned ldsw = (unsigned)wid * 1024u;
    const int aoff = lds_byte(wr * 64 + fr, fq * 8), boff = lds_byte(wc * 32 + fr, fq * 8);
#define PG8_SA(b, h) (((b) * 2 + (h)) * HTB)
#define PG8_SB(b, h) ((4 + (b) * 2 + (h)) * HTB)
#define PG8_STAGE(bufoff, gbase, voff) do { _Pragma("unroll") for (int _i = 0; _i < 2; ++_i) \
        __builtin_amdgcn_global_load_lds((const unsigned*)((const char*)(gbase) + (voff)[_i]), (PG8_LAS unsigned*)(lds + (bufoff) + ldsw + _i * 8192), 16, 0, 0); } while (0)
#define PG8_LDA(dst, b, h) do { _Pragma("unroll") for (int m = 0; m < 4; ++m) _Pragma("unroll") for (int k = 0; k < 2; ++k) dst[m][k] = *(const PG8_LAS bf16x8*)(lds + PG8_SA(b, h) + aoff + m * 2048 + k * 1024); } while (0)
#define PG8_LDB(dst, b, h) do { _Pragma("unroll") for (int n = 0; n < 2; ++n) _Pragma("unroll") for (int k = 0; k < 2; ++k) dst[n][k] = *(const PG8_LAS bf16x8*)(lds + PG8_SB(b, h) + boff + n * 2048 + k * 1024); } while (0)
#define PG8_MMA(ai, bj, At, Bt) do { __builtin_amdgcn_s_setprio(1); _Pragma("unroll") for (int m = 0; m < 4; ++m) _Pragma("unroll") for (int n = 0; n < 2; ++n) _Pragma("unroll") for (int k = 0; k < 2; ++k) \
        acc[ai][bj][m][n] = __builtin_amdgcn_mfma_f32_16x16x32_bf16(Bt[n][k], At[m][k], acc[ai][bj][m][n], 0, 0, 0); __builtin_amdgcn_s_setprio(0); } while (0)
#define PG8_WAIT_V(n) asm volatile("s_waitcnt vmcnt(" #n ")" ::: "memory")
#define PG8_WAIT_L(n) asm volatile("s_waitcnt lgkmcnt(" #n ")" ::: "memory")
#define PG8_BAR __builtin_amdgcn_s_barrier()
#define PG8_SCHED __builtin_amdgcn_sched_barrier(0)
    Unit cur, nxt; int ui = 0;
    if (!S.next(0, cur)) return;
    f32x4 acc[2][2][4][2];
#pragma unroll
    for (int a = 0; a < 2; ++a)
#pragma unroll
        for (int b = 0; b < 2; ++b)
#pragma unroll
            for (int m = 0; m < 4; ++m)
#pragma unroll
                for (int n = 0; n < 2; ++n) acc[a][b][m][n] = (f32x4){0.f, 0.f, 0.f, 0.f};
    bf16x8 At[4][2], B0[2][2], B1[2][2];
    const char* cA = (const char*)g.A + (size_t)cur.pm * tstep; const char* cB = (const char*)g.Bt + (size_t)cur.pn * tstep;
    S.a_ready(cur);
    if constexpr (SP2) {
        PG8_STAGE(PG8_SB(0, 0), cB, voffB); PG8_STAGE(PG8_SB(0, 1), cB + hstep, voffB); PG8_STAGE(PG8_SA(0, 0), cA, voffA); PG8_STAGE(PG8_SA(0, 1), cA + hstep, voffA);
        if (wr == 1) PG8_BAR;
        PG8_WAIT_V(2); PG8_BAR;
        PG8_STAGE(PG8_SB(1, 0), cB + kstep, voffB); PG8_STAGE(PG8_SA(1, 0), cA + kstep, voffA); PG8_STAGE(PG8_SB(1, 1), cB + hstep + kstep, voffB);
        PG8_WAIT_V(6); PG8_BAR;
    } else {
        PG8_STAGE(PG8_SB(0, 0), cB, voffB); PG8_STAGE(PG8_SA(0, 0), cA, voffA); PG8_STAGE(PG8_SB(0, 1), cB + hstep, voffB); PG8_STAGE(PG8_SA(0, 1), cA + hstep, voffA);
        if (wr == 1) PG8_BAR;
        PG8_WAIT_V(4); PG8_BAR;
        PG8_STAGE(PG8_SB(1, 0), cB + kstep, voffB); PG8_STAGE(PG8_SA(1, 0), cA + kstep, voffA); PG8_STAGE(PG8_SB(1, 1), cB + hstep + kstep, voffB);
        PG8_WAIT_V(6); PG8_BAR;
    }
    for (;;) {
        const bool has_next = S.next(ui + 1, nxt);
        const char* nA = has_next ? (const char*)g.A + (size_t)nxt.pm * tstep : cA; const char* nB = has_next ? (const char*)g.Bt + (size_t)nxt.pn * tstep : cB;
        for (int t = 0; t < nt; t += 2) {
            const bool last = (t == nt - 2);
            const char* a1 = cA + (size_t)(t + 1) * kstep;
            const char* a2 = last ? nA : cA + (size_t)(t + 2) * kstep; const char* b2 = last ? nB : cB + (size_t)(t + 2) * kstep;
            const char* a3 = a2 + kstep; const char* b3 = b2 + kstep;
            if (last && has_next) S.a_ready(nxt);
            if constexpr (SP2) {
            PG8_LDB(B0, 0, 0); PG8_LDB(B1, 0, 1); PG8_SCHED; PG8_LDA(At, 0, 0); PG8_STAGE(PG8_SA(1, 1), a1 + hstep, voffA);
            PG8_WAIT_V(8); PG8_WAIT_L(0); PG8_BAR; PG8_MMA(0, 0, At, B0); PG8_MMA(0, 1, At, B1); PG8_BAR; PG8_SCHED;
            PG8_LDA(At, 0, 1); PG8_STAGE(PG8_SB(0, 0), b2, voffB); PG8_STAGE(PG8_SB(0, 1), b2 + hstep, voffB); PG8_STAGE(PG8_SA(0, 0), a2, voffA);
            PG8_WAIT_V(8); PG8_WAIT_L(0); PG8_BAR; PG8_MMA(1, 0, At, B0); PG8_MMA(1, 1, At, B1); PG8_BAR; PG8_SCHED;
            PG8_LDB(B0, 1, 0); PG8_LDB(B1, 1, 1); PG8_SCHED; PG8_LDA(At, 1, 0); PG8_STAGE(PG8_SA(0, 1), a2 + hstep, voffA);
            PG8_WAIT_V(8); PG8_WAIT_L(0); PG8_BAR; PG8_MMA(0, 0, At, B0); PG8_MMA(0, 1, At, B1); PG8_BAR; PG8_SCHED;
            PG8_LDA(At, 1, 1); PG8_STAGE(PG8_SB(1, 0), b3, voffB); PG8_STAGE(PG8_SB(1, 1), b3 + hstep, voffB); PG8_STAGE(PG8_SA(1, 0), a3, voffA);
            PG8_WAIT_V(8); PG8_WAIT_L(0); PG8_BAR; PG8_MMA(1, 0, At, B0); PG8_MMA(1, 1, At, B1); PG8_BAR; PG8_SCHED;
            } else {
            PG8_LDB(B0, 0, 0); PG8_SCHED; PG8_LDA(At, 0, 0); PG8_STAGE(PG8_SA(1, 1), a1 + hstep, voffA);
            PG8_WAIT_L(8); PG8_BAR; PG8_WAIT_L(0); PG8_MMA(0, 0, At, B0); PG8_BAR; PG8_SCHED;
            PG8_LDB(B1, 0, 1); PG8_STAGE(PG8_SB(0, 0), b2, voffB);
            PG8_BAR; PG8_WAIT_L(0); PG8_MMA(0, 1, At, B1); PG8_BAR;
            PG8_LDA(At, 0, 1); PG8_STAGE(PG8_SA(0, 0), a2, voffA);
            PG8_BAR; PG8_WAIT_L(0); PG8_MMA(1, 0, At, B0); PG8_BAR; PG8_SCHED;
            PG8_STAGE(PG8_SB(0, 1), b2 + hstep, voffB);
            PG8_WAIT_V(6); PG8_BAR; PG8_MMA(1, 1, At, B1); PG8_BAR;
            PG8_LDB(B0, 1, 0); PG8_SCHED; PG8_LDA(At, 1, 0); PG8_STAGE(PG8_SA(0, 1), a2 + hstep, voffA);
            PG8_WAIT_L(8); PG8_BAR; PG8_WAIT_L(0); PG8_MMA(0, 0, At, B0); PG8_BAR; PG8_SCHED;
            PG8_LDB(B1, 1, 1); PG8_STAGE(PG8_SB(1, 0), b3, voffB);
            PG8_BAR; PG8_WAIT_L(0); PG8_MMA(0, 1, At, B1); PG8_BAR;
            PG8_LDA(At, 1, 1); PG8_STAGE(PG8_SA(1, 0), a3, voffA);
            PG8_BAR; PG8_WAIT_L(0); PG8_MMA(1, 0, At, B0); PG8_BAR; PG8_SCHED;
            PG8_STAGE(PG8_SB(1, 1), b3 + hstep, voffB);
            PG8_WAIT_V(6); PG8_BAR; PG8_MMA(1, 1, At, B1); PG8_BAR;
            }
        }
        if constexpr (ALIGN_EPI) { if (wr == 0) PG8_BAR; }
        if constexpr (!Epi::AFTER_DRAIN) { E(acc, cur, wr, wc, fr, fq); S.done(cur); }
        if (!has_next) break;
#pragma unroll
        for (int a = 0; a < 2; ++a)
#pragma unroll
            for (int b = 0; b < 2; ++b)
#pragma unroll
                for (int m = 0; m < 4; ++m)
#pragma unroll
                    for (int n = 0; n < 2; ++n) acc[a][b][m][n] = (f32x4){0.f, 0.f, 0.f, 0.f};
        cur = nxt; cA = nA; cB = nB; ++ui;
        if constexpr (ALIGN_EPI) { if (wr == 1) PG8_BAR; }
    }
    PG8_WAIT_V(0);
    if constexpr (!ALIGN_EPI) { if (wr == 0) PG8_BAR; }
    PG8_BAR;
    if constexpr (Epi::AFTER_DRAIN) { E.fused(acc, cur, wr, wc, fr, fq, lds, wid, lane); S.done(cur); }
#undef PG8_SA
#undef PG8_SB
#undef PG8_STAGE
#undef PG8_LDA
#undef PG8_LDB
#undef PG8_MMA
#undef PG8_WAIT_V
#undef PG8_WAIT_L
#undef PG8_BAR
#undef PG8_SCHED
}
}
#include <hip/hip_bf16.h>
#include <cmath>
namespace attn_body {
using bf16=__hip_bfloat16;
using bf16x8=__attribute__((ext_vector_type(8)))short;
using s16x4=__attribute__((ext_vector_type(4)))short;
using f32x16=__attribute__((ext_vector_type(16)))float;
using u32x4=__attribute__((ext_vector_type(4)))unsigned;
constexpr int D=64,DM=1024;
constexpr int NW=8,QBLK=32,QB=QBLK*NW,KVBLK=64;
constexpr int ATTN_PITCH=DM, ATTN_UNIT_ROWS=QB;
__device__ __forceinline__ int crow(int r,int hi){return (r&3)+8*(r>>2)+4*hi;}
#define SBAR() __builtin_amdgcn_sched_barrier(0)
__device__ __forceinline__ void cmask(f32x16&p0,f32x16&p1,int jb,int qchunk){
  const float NEG=-INFINITY;
  if(jb>qchunk){
  #pragma unroll
  for(int r=0;r<16;++r){p0[r]=NEG;p1[r]=NEG;} }
}
constexpr int NSLOT=3, SLOTB=8192;
constexpr int LDS_K=0, LDS_V=NSLOT*SLOTB, LDS_WS=2*NSLOT*SLOTB, LDS_OST=LDS_WS+NW*64*4, LDS_BYTES=LDS_OST+NW*8192;
constexpr float C2=0.125f*1.4426950408889634f;
__device__ __forceinline__ void glds16(const void*gsrc,unsigned lds_dst){unsigned keep;
  asm volatile("s_mov_b32 %0, m0\n\ts_mov_b32 m0, %2\n\ts_nop 0\n\tglobal_load_lds_dwordx4 %1, off\n\ts_mov_b32 m0, %0":"=&s"(keep):"v"(gsrc),"s"(lds_dst):"memory");}
__device__ __forceinline__ float max3f(float a,float b,float c){float r;asm("v_max3_f32 %0, %1, %2, %3":"=v"(r):"v"(a),"v"(b),"v"(c));return r;}
__device__ __forceinline__ float max2f(float a,float b){float r;asm("v_max_f32_e32 %0, %1, %2":"=v"(r):"v"(a),"v"(b));return r;}
__device__ __forceinline__ float fadd_s(float a,float b){float r;asm("v_add_f32_e32 %0, %1, %2":"=v"(r):"v"(a),"v"(b));return r;}
__device__ __forceinline__ float fsub_s(float a,float b){float r;asm("v_sub_f32_e32 %0, %1, %2":"=v"(r):"v"(a),"v"(b));return r;}
typedef float f32x2_t __attribute__((ext_vector_type(2))); typedef __bf16 bf16x2_t __attribute__((ext_vector_type(2)));
__device__ __forceinline__ unsigned cvtpk_s(float lo,float hi){f32x2_t v={lo,hi};bf16x2_t b=__builtin_convertvector(v,bf16x2_t);return __builtin_bit_cast(unsigned,b);}
#define WAIT_BAR(N) asm volatile("s_waitcnt vmcnt(" #N ") lgkmcnt(0)\n\ts_barrier":::"memory")

__device__ __forceinline__ void qkt(f32x16&p0,f32x16&p1,const char*Kslot,const bf16x8*qr,const f32x16&negm,int r32,int hi){
  const char*kb=Kslot+hi*1024+r32*16;
  #pragma unroll
  for(int d0=0;d0<4;++d0){
    const bf16x8 b0=*reinterpret_cast<const bf16x8*>(kb+d0*2048);
    const bf16x8 b1=*reinterpret_cast<const bf16x8*>(kb+d0*2048+512);
    if(d0==0){p0=__builtin_amdgcn_mfma_f32_32x32x16_bf16(b0,qr[0],negm,0,0,0);p1=__builtin_amdgcn_mfma_f32_32x32x16_bf16(b1,qr[0],negm,0,0,0);}
    else{p0=__builtin_amdgcn_mfma_f32_32x32x16_bf16(b0,qr[d0],p0,0,0,0);p1=__builtin_amdgcn_mfma_f32_32x32x16_bf16(b1,qr[d0],p1,0,0,0);}}
}
typedef __attribute__((address_space(3))) const char* lds_cptr;
typedef short v4i16_t __attribute__((ext_vector_type(4)));
__device__ __forceinline__ void kload8(bf16x8*kf,lds_cptr kp){
  kf[0]=*(const __attribute__((address_space(3))) bf16x8*)(kp);      kf[1]=*(const __attribute__((address_space(3))) bf16x8*)(kp+512);
  kf[2]=*(const __attribute__((address_space(3))) bf16x8*)(kp+2048); kf[3]=*(const __attribute__((address_space(3))) bf16x8*)(kp+2560);
  kf[4]=*(const __attribute__((address_space(3))) bf16x8*)(kp+4096); kf[5]=*(const __attribute__((address_space(3))) bf16x8*)(kp+4608);
  kf[6]=*(const __attribute__((address_space(3))) bf16x8*)(kp+6144); kf[7]=*(const __attribute__((address_space(3))) bf16x8*)(kp+6656);
}
__device__ __forceinline__ void kload2(bf16x8*kf,lds_cptr kp,int j){ kf[2*j]=*(const __attribute__((address_space(3))) bf16x8*)(kp+j*2048); kf[2*j+1]=*(const __attribute__((address_space(3))) bf16x8*)(kp+j*2048+512); }
__device__ __forceinline__ s16x4 vtr(lds_cptr p){ return __builtin_bit_cast(s16x4,__builtin_amdgcn_ds_read_tr16_b64_v4i16((__attribute__((address_space(3))) v4i16_t*)p)); }
__device__ __forceinline__ float rowmax(const f32x16&p0,const f32x16&p1){
  float a=max3f(p0[0],p0[1],p1[0]),b=max3f(p0[2],p0[3],p1[1]);a=max3f(a,p1[2],p1[3]);
  #pragma unroll
  for(int r=4;r<16;r+=4){a=max3f(a,p0[r],p0[r+1]);b=max3f(b,p0[r+2],p0[r+3]);a=max3f(a,p1[r],p1[r+1]);b=max3f(b,p1[r+2],p1[r+3]);}
  const float m=max2f(a,b);
  auto rr=__builtin_amdgcn_permlane32_swap(__float_as_uint(m),__float_as_uint(m),false,false);
  return max2f(__uint_as_float(rr[0]),__uint_as_float(rr[1]));
}
__device__ __forceinline__ void pv(f32x16*o,int vb,bf16x8 pa0,bf16x8 pa1,bf16x8 pa2,bf16x8 pa3){
  #pragma unroll
  for(int d0=0;d0<2;++d0){s16x4 lo[4],hi[4];
    #pragma unroll
    for(int ks=0;ks<4;++ks){
      asm volatile("ds_read_b64_tr_b16 %0,%1 offset:%c2":"=&v"(lo[ks]):"v"(vb),"i"(d0*4096+ks*1024):"memory");
      asm volatile("ds_read_b64_tr_b16 %0,%1 offset:%c2":"=&v"(hi[ks]):"v"(vb),"i"(d0*4096+ks*1024+512):"memory");}
    asm volatile("s_waitcnt lgkmcnt(0)":::"memory");SBAR();
    #define PK(k) (bf16x8){lo[k][0],lo[k][1],lo[k][2],lo[k][3],hi[k][0],hi[k][1],hi[k][2],hi[k][3]}
    o[d0]=__builtin_amdgcn_mfma_f32_32x32x16_bf16(pa0,PK(0),o[d0],0,0,0);
    o[d0]=__builtin_amdgcn_mfma_f32_32x32x16_bf16(pa1,PK(1),o[d0],0,0,0);
    o[d0]=__builtin_amdgcn_mfma_f32_32x32x16_bf16(pa2,PK(2),o[d0],0,0,0);
    o[d0]=__builtin_amdgcn_mfma_f32_32x32x16_bf16(pa3,PK(3),o[d0],0,0,0);
    #undef PK
  }
}

#ifndef ATTN_STORE16
#define ATTN_STORE16(p,v) (*(u32x4*)(p)=(v))
#endif
template<int THRL> __device__ __forceinline__ void attn_unit(int qb,const bf16*Q,const bf16*__restrict__ K,const bf16*__restrict__ V,float*O,char*shm){
  int tid_o=threadIdx.x; asm volatile("":"+v"(tid_o));
  const int tid=tid_o,lane=tid&63,r32=lane&31,hi=lane>>5; const int wid=__builtin_amdgcn_readfirstlane(tid>>6);
  const int q0=qb*QB;
  const bf16*Qw=Q+(long)(q0+wid*QBLK)*DM;
  const bf16*Kh=K,*Vh=V;
  const unsigned lds0=(unsigned)(uintptr_t)shm;
  float*wsf=(float*)(shm+LDS_WS)+wid*64;
  const bf16*ksrc=Kh+(long)lane*DM+wid*8;
  const bf16*vsrc=Vh+(long)(16*(wid&3)+(lane>>2))*DM+(wid>>2)*32+(lane&3)*8;
  const unsigned kdst=lds0+LDS_K+wid*1024, vdst=lds0+LDS_V+wid*1024;
  #define DMA_K(t,slot) glds16(ksrc+(long)(t)*KVBLK*DM,(unsigned)__builtin_amdgcn_readfirstlane(kdst+(slot)))
  #define DMA_V(t,slot) glds16(vsrc+(long)(t)*KVBLK*DM,(unsigned)__builtin_amdgcn_readfirstlane(vdst+(slot)))
  const int vb0=(int)(lds0+LDS_V)+((lane>>4)&1)*32+(lane&3)*8+(4*hi+((lane&15)>>2))*64;
  const char*Kbase=shm+LDS_K; bf16x8 kf[8];
  const lds_cptr shm3=(lds_cptr)shm; const lds_cptr kp0=shm3+LDS_K+hi*1024+r32*16; const lds_cptr vp0=shm3+LDS_V+((lane>>4)&1)*32+(lane&3)*8+(4*hi+((lane&15)>>2))*64;
  const int NT=(q0+QB)/KVBLK;
  DMA_K(0,0);DMA_V(0,0);DMA_K(1,SLOTB);
  bf16x8 qr[4];
  #pragma unroll
  for(int d0=0;d0<4;++d0)qr[d0]=*reinterpret_cast<const bf16x8*>(&Qw[(long)r32*DM+d0*16+hi*8]);
  float mhat=0.f,l_reg=0.f;f32x16 o[2];o[0]=f32x16{};o[1]=f32x16{};f32x16 negm=f32x16{};asm volatile("":"+v"(negm));

  #define CMASK(P0,P1,t) do{int jb_=(t)-(NT-4); if(jb_>=0)cmask(P0,P1,jb_,wid>>1);}while(0)
  bool resc=false;
  #define START(P0,P1) do{ const float rm=rowmax(P0,P1); resc=false; \
    { const float dl=rm; mhat=fadd_s(mhat,dl); \
      _Pragma("unroll") for(int r=0;r<16;++r){P0[r]=fsub_s(P0[r],dl);P1[r]=fsub_s(P1[r],dl);} \
      _Pragma("unroll") for(int r=0;r<16;++r)negm[r]=-mhat; asm volatile("":"+v"(negm)); } \
    _Pragma("unroll") for(int r=0;r<16;++r)P0[r]=__builtin_amdgcn_exp2f(P0[r]); }while(0)
  #define RESC() do{ if(resc){ asm volatile("s_waitcnt lgkmcnt(0)":::"memory"); \
      _Pragma("unroll") for(int d_=0;d_<2;++d_) _Pragma("unroll") for(int r=0;r<16;++r)o[d_][r]*=wsf[crow(r,hi)]; } }while(0)
  f32x16 pA0,pA1,pB0,pB1;
  int sl_prev=0,sl_cur=0,sl_next=SLOTB;
  #define ROT() do{sl_prev=sl_cur;sl_cur=sl_next;sl_next=(sl_next==(NSLOT-1)*SLOTB)?0:sl_next+SLOTB;}while(0)
  DMA_K(2,2*SLOTB);
  WAIT_BAR(3);
  qkt(pA0,pA1,Kbase,qr,negm,r32,hi);asm volatile("s_nop 15\n\ts_nop 7":"+v"(pA0),"+v"(pA1));CMASK(pA0,pA1,0);
  START(pA0,pA1);
  _Pragma("unroll") for(int r=0;r<16;++r)pA1[r]=__builtin_amdgcn_exp2f(pA1[r]);
  WAIT_BAR(0);
  DMA_K(3,0);DMA_V(1,SLOTB);
  ROT();
  kload8(kf,kp0+sl_cur);
  WAIT_BAR(2);
  s16x4 vlo[8],vhi[8]; u32x4 pw0,pw1,pw2,pw3;
  #define PKW(P,B) cvtpk_s(P[B],P[B+1])
  #define PAF(k) __builtin_bit_cast(bf16x8,pw##k)
  #define VFR(i) (bf16x8){vlo[i][0],vlo[i][1],vlo[i][2],vlo[i][3],vhi[i][0],vhi[i][1],vhi[i][2],vhi[i][3]}
  #define PIN(x) asm volatile("":"+v"(x))
  #define MX3(a,b,c) __builtin_fmaxf(__builtin_fmaxf((a),(b)),(c))
  #define GAPA(MF,A0,A1,A2,A3,W0,W1,PW) do{ MF; sacc+=A0; sacc+=A1; sacc+=A2; sacc+=A3; PIN(sacc); W0; W1; PIN(PW); SBAR(); }while(0)
  #define EX(v) __builtin_amdgcn_exp2f(v)
  #define GAPB(MF,X,B) do{ MF; X[B]=EX(X[B]); X[B+1]=EX(X[B+1]); X[B+2]=EX(X[B+2]); X[B+3]=EX(X[B+3]); PIN(X); SBAR(); }while(0)
  #define VRD(i) do{ vlo[i]=vtr(vp_+(((i)>>2)*4096+((i)&3)*1024)); vhi[i]=vtr(vp_+(((i)>>2)*4096+((i)&3)*1024+512)); }while(0)
  #define KRD(G,j) do{ if(G){ kload2(kf,kp0+sl_next,j); SBAR(); } }while(0)
  #define STEP(C0,C1,P0,P1,t,GK,GV,GL) do{ SBAR(); \
    const lds_cptr vp_=vp0+sl_prev; \
    VRD(0); SBAR(); float sacc=(P0[0]+P0[1]); \
    GAPA(C0=__builtin_amdgcn_mfma_f32_32x32x16_bf16(kf[0],qr[0],negm,0,0,0), P0[2],P0[3],P0[4],P0[5],     pw0[0]=PKW(P0,0), pw0[1]=PKW(P0,2), pw0); \
    VRD(4); SBAR(); GAPA(C1=__builtin_amdgcn_mfma_f32_32x32x16_bf16(kf[1],qr[0],negm,0,0,0), P0[6],P0[7],P0[8],P0[9],     pw0[2]=PKW(P0,4), pw0[3]=PKW(P0,6), pw0); \
    VRD(1); SBAR(); GAPA(C0=__builtin_amdgcn_mfma_f32_32x32x16_bf16(kf[2],qr[1],C0,0,0,0),   P0[10],P0[11],P0[12],P0[13], pw1[0]=PKW(P0,8), pw1[1]=PKW(P0,10), pw1); \
    VRD(5); SBAR(); GAPA(C1=__builtin_amdgcn_mfma_f32_32x32x16_bf16(kf[3],qr[1],C1,0,0,0),   P0[14],P0[15],P1[0],P1[1],   pw1[2]=PKW(P0,12),pw1[3]=PKW(P0,14), pw1); \
    VRD(2); SBAR(); GAPA(C0=__builtin_amdgcn_mfma_f32_32x32x16_bf16(kf[4],qr[2],C0,0,0,0),   P1[2],P1[3],P1[4],P1[5],     pw2[0]=PKW(P1,0), pw2[1]=PKW(P1,2), pw2); \
    VRD(6); SBAR(); GAPA(C1=__builtin_amdgcn_mfma_f32_32x32x16_bf16(kf[5],qr[2],C1,0,0,0),   P1[6],P1[7],P1[8],P1[9],     pw2[2]=PKW(P1,4), pw2[3]=PKW(P1,6), pw2); \
    VRD(3); SBAR(); GAPA(C0=__builtin_amdgcn_mfma_f32_32x32x16_bf16(kf[6],qr[3],C0,0,0,0),   P1[10],P1[11],P1[12],P1[13], pw3[0]=PKW(P1,8), pw3[1]=PKW(P1,10), pw3); \
    VRD(7); SBAR(); GAPA(C1=__builtin_amdgcn_mfma_f32_32x32x16_bf16(kf[7],qr[3],C1,0,0,0),   P1[14],P1[15],0.f,0.f,       pw3[2]=PKW(P1,12),pw3[3]=PKW(P1,14), pw3); \
    l_reg+=sacc; \
    if(GK){DMA_K((t)+3,sl_cur);} if(GV){DMA_V((t)+1,sl_next);} \
    CMASK(C0,C1,t); \
    { float a=MX3(C0[0],C0[1],C1[0]),b=MX3(C0[2],C0[3],C1[1]); a=MX3(a,C1[2],C1[3]); \
      _Pragma("unroll") for(int r=4;r<16;r+=4){a=MX3(a,C0[r],C0[r+1]);b=MX3(b,C0[r+2],C0[r+3]);a=MX3(a,C1[r],C1[r+1]);b=MX3(b,C1[r+2],C1[r+3]);} \
      float rm=__builtin_fmaxf(a,b); { auto rr=__builtin_amdgcn_permlane32_swap(__float_as_uint(rm),__float_as_uint(rm),false,false); rm=__builtin_fmaxf(__uint_as_float(rr[0]),__uint_as_float(rr[1])); } \
      resc=false; \
      if(__builtin_expect(__any(rm>(float)THRL),0)){ const float dl=__builtin_fmaxf(rm,0.f); mhat+=dl; \
        _Pragma("unroll") for(int r=0;r<16;++r){C0[r]-=dl;C1[r]-=dl;} \
        _Pragma("unroll") for(int r=0;r<16;++r)negm[r]=-mhat; asm volatile("":"+v"(negm)); \
        const float f=__builtin_amdgcn_exp2f(-dl); l_reg*=f; if(hi==0)wsf[r32]=f; resc=true; } } \
    SBAR(); \
    GAPB(o[0]=__builtin_amdgcn_mfma_f32_32x32x16_bf16(PAF(0),VFR(0),o[0],0,0,0), C0,0); \
    GAPB(o[1]=__builtin_amdgcn_mfma_f32_32x32x16_bf16(PAF(0),VFR(4),o[1],0,0,0), C0,4); \
    KRD(GL,0); GAPB(o[0]=__builtin_amdgcn_mfma_f32_32x32x16_bf16(PAF(1),VFR(1),o[0],0,0,0), C0,8); \
    KRD(GL,1); GAPB(o[1]=__builtin_amdgcn_mfma_f32_32x32x16_bf16(PAF(1),VFR(5),o[1],0,0,0), C0,12); \
    KRD(GL,2); GAPB(o[0]=__builtin_amdgcn_mfma_f32_32x32x16_bf16(PAF(2),VFR(2),o[0],0,0,0), C1,0); \
    KRD(GL,3); GAPB(o[1]=__builtin_amdgcn_mfma_f32_32x32x16_bf16(PAF(2),VFR(6),o[1],0,0,0), C1,4); \
    GAPB(o[0]=__builtin_amdgcn_mfma_f32_32x32x16_bf16(PAF(3),VFR(3),o[0],0,0,0), C1,8); \
    GAPB(o[1]=__builtin_amdgcn_mfma_f32_32x32x16_bf16(PAF(3),VFR(7),o[1],0,0,0), C1,12); \
    }while(0)
  int t=1;
  #undef CMASK
  #define CMASK(P0,P1,t) do{}while(0)
  for(;t+5<NT;t+=2){
    STEP(pB0,pB1,pA0,pA1,t,true,true,true);     WAIT_BAR(2); RESC(); ROT();
    STEP(pA0,pA1,pB0,pB1,t+1,true,true,true);   WAIT_BAR(2); RESC(); ROT();
  }
  #undef CMASK
  #define CMASK(P0,P1,t) do{int jb_=(t)-(NT-4); if(jb_>=0)cmask(P0,P1,jb_,wid>>1);}while(0)
  #define ENDW(tt) do{ if((tt)+3<NT){WAIT_BAR(2);} else if((tt)+2<NT){WAIT_BAR(1);} else {WAIT_BAR(0);} }while(0)
  for(;t+1<NT;t+=2){
    STEP(pB0,pB1,pA0,pA1,t,(t+3<NT),(t+1<NT),(t+1<NT));       ENDW(t);   RESC(); ROT();
    STEP(pA0,pA1,pB0,pB1,t+1,(t+4<NT),(t+2<NT),(t+2<NT));     ENDW(t+1); RESC(); ROT();
  }
  STEP(pB0,pB1,pA0,pA1,NT-1,false,false,false); RESC();
  { float sacc=pB0[0]+pB0[1]; _Pragma("unroll") for(int r=2;r<16;++r)sacc+=pB0[r]; _Pragma("unroll") for(int r=0;r<16;++r)sacc+=pB1[r]; l_reg+=sacc;
    pw0=(u32x4){PKW(pB0,0),PKW(pB0,2),PKW(pB0,4),PKW(pB0,6)};pw1=(u32x4){PKW(pB0,8),PKW(pB0,10),PKW(pB0,12),PKW(pB0,14)};pw2=(u32x4){PKW(pB1,0),PKW(pB1,2),PKW(pB1,4),PKW(pB1,6)};pw3=(u32x4){PKW(pB1,8),PKW(pB1,10),PKW(pB1,12),PKW(pB1,14)};
    SBAR(); pv(o,vb0+sl_cur,PAF(0),PAF(1),PAF(2),PAF(3)); }
  #undef PKW
  #undef PAF
  #undef VFR
  #undef PIN
  #undef MX3
  #undef GAPA
  #undef GAPB
  #undef EX
  #undef VRD
  #undef KRD
  #undef STEP
  #undef ENDW
  {auto rr=__builtin_amdgcn_permlane32_swap(__float_as_uint(l_reg),__float_as_uint(l_reg),false,false);l_reg=__uint_as_float(rr[0])+__uint_as_float(rr[1]);}
  if(hi==0)wsf[32+r32]=l_reg;asm volatile("s_waitcnt lgkmcnt(0)":::"memory");
  float rli[16];
  #pragma unroll
  for(int r=0;r<16;++r)rli[r]=__builtin_amdgcn_rcpf(wsf[32+crow(r,hi)]);
  float*Ow=O+(long)(q0+wid*QBLK)*DM;
  { float*stg=(float*)(shm+LDS_OST)+wid*2048;
    #pragma unroll
    for(int r=0;r<16;++r){const int orow=crow(r,hi);
      #pragma unroll
      for(int d0=0;d0<2;++d0)stg[orow*64+d0*32+r32]=o[d0][r]*rli[r];}
    asm volatile("s_waitcnt lgkmcnt(0)":::"memory");
    #pragma unroll
    for(int i=0;i<8;++i){const int row=i*4+(lane>>4),ch=lane&15; const u32x4 v=*(const u32x4*)(stg+row*64+ch*4); *(u32x4*)(Ow+(long)row*DM+ch*4)=v;} }
  asm volatile("s_waitcnt lgkmcnt(0)\n\ts_barrier":::"memory");
  #undef DMA_K
  #undef DMA_V
  #undef CMASK
  #undef START
  #undef RESC
  #undef ROT
}

constexpr int W_LDS_K=0, W_LDS_V=3*8192, W_LDS_WS=W_LDS_V+3*16384, W_LDS_OST=W_LDS_WS+NW*64*4, W_LDS_BYTES=W_LDS_OST+NW*4096;
template<int THRL> __device__ __forceinline__ void attn_unit128(int qb,const bf16*Q,const bf16*__restrict__ K,const bf16*__restrict__ V,float*O,char*shm,const int wave_id){
  int tid_o; asm volatile("v_mbcnt_lo_u32_b32 %0, -1, 0\n\tv_mbcnt_hi_u32_b32 %0, -1, %0":"=v"(tid_o)); tid_o+=wave_id*64;
  const int tid=tid_o,lane=tid&63,r32=lane&31,hi=lane>>5; const int wid=__builtin_amdgcn_readfirstlane(tid>>6);
  const int q0=qb*QB;
  const bf16*Qw=Q+(long)(q0+wid*QBLK)*DM;
  const unsigned lds0=(unsigned)(uintptr_t)shm;
  const bf16*ksrc=K+(long)lane*DM+wid*8;
  const bf16*vsrc=V+(long)(16*(wid&3)+(lane>>2))*DM+(wid>>2)*32+(lane&3)*8;
  const unsigned kdst=lds0+W_LDS_K+wid*1024, vdst=lds0+W_LDS_V+wid*1024;
  #define DMA_K(t,slot) glds16(ksrc+(long)(t)*KVBLK*DM,(unsigned)__builtin_amdgcn_readfirstlane(kdst+(slot)))
  #define DMA_V(t,slot) do{ glds16(vsrc+(long)(t)*KVBLK*DM,(unsigned)__builtin_amdgcn_readfirstlane(vdst+2*(slot))); glds16(vsrc+(long)(t)*KVBLK*DM+64,(unsigned)__builtin_amdgcn_readfirstlane(vdst+2*(slot)+8192)); }while(0)
  const char*Kbase=shm+W_LDS_K; bf16x8 kf[8];
  const lds_cptr shm3=(lds_cptr)shm; __attribute__((address_space(3))) float*const wsf=(__attribute__((address_space(3))) float*)(shm3+W_LDS_WS)+wid*64;
  const lds_cptr kp0=shm3+W_LDS_K+hi*1024+r32*16; const lds_cptr vp0=shm3+W_LDS_V+((lane>>4)&1)*32+(lane&3)*8+(4*hi+((lane&15)>>2))*64;
  const int NT=(q0+QB)/KVBLK;
  DMA_K(0,0);DMA_V(0,0);DMA_K(1,SLOTB);
  bf16x8 qr[4];
  #pragma unroll
  for(int d0=0;d0<4;++d0)qr[d0]=*reinterpret_cast<const bf16x8*>(&Qw[(long)r32*DM+d0*16+hi*8]);
  float mhat=0.f,l_reg=0.f;f32x16 o[4];o[0]=f32x16{};o[1]=f32x16{};o[2]=f32x16{};o[3]=f32x16{};f32x16 negm; { float z_=0.f; asm volatile("":"+v"(z_)); _Pragma("unroll") for(int r=0;r<16;++r)negm[r]=z_; }
  #define CMASK(P0,P1,t) do{int jb_=(t)-(NT-4); if(jb_>=0)cmask(P0,P1,jb_,wid>>1);}while(0)
  bool resc=false;
  #define RESC() do{ if(resc){ asm volatile("s_waitcnt lgkmcnt(0)":::"memory"); \
      _Pragma("unroll") for(int d_=0;d_<4;++d_) _Pragma("unroll") for(int r=0;r<16;++r)o[d_][r]*=wsf[crow(r,hi)]; } }while(0)
  f32x16 c0,c1;
  u32x4 pa0,pa1,pa2,pa3,pb0,pb1,pb2,pb3;
  int sl_prev=0,sl_cur=0,sl_next=SLOTB;
  #define ROT() do{sl_prev=sl_cur;sl_cur=sl_next;sl_next=(sl_next==(NSLOT-1)*SLOTB)?0:sl_next+SLOTB;}while(0)
  #define PKW(P,B) cvtpk_s(P[B],P[B+1])
  DMA_K(2,2*SLOTB);
  WAIT_BAR(3);
  qkt(c0,c1,Kbase,qr,negm,r32,hi);asm volatile("s_nop 15\n\ts_nop 7":"+v"(c0),"+v"(c1));CMASK(c0,c1,0);
  { const float rm=rowmax(c0,c1); mhat=fadd_s(mhat,rm);
    _Pragma("unroll") for(int r=0;r<16;++r){c0[r]=fsub_s(c0[r],rm);c1[r]=fsub_s(c1[r],rm);}
    _Pragma("unroll") for(int r=0;r<16;++r)negm[r]=-mhat; asm volatile("":"+v"(negm));
    _Pragma("unroll") for(int r=0;r<16;++r){c0[r]=__builtin_amdgcn_exp2f(c0[r]);c1[r]=__builtin_amdgcn_exp2f(c1[r]);}
    float sacc=c0[0]+c0[1]; _Pragma("unroll") for(int r=2;r<16;++r)sacc+=c0[r]; _Pragma("unroll") for(int r=0;r<16;++r)sacc+=c1[r]; l_reg+=sacc;
    pa0=(u32x4){PKW(c0,0),PKW(c0,2),PKW(c0,4),PKW(c0,6)};pa1=(u32x4){PKW(c0,8),PKW(c0,10),PKW(c0,12),PKW(c0,14)};pa2=(u32x4){PKW(c1,0),PKW(c1,2),PKW(c1,4),PKW(c1,6)};pa3=(u32x4){PKW(c1,8),PKW(c1,10),PKW(c1,12),PKW(c1,14)}; }
  WAIT_BAR(0);
  DMA_K(3,0);DMA_V(1,SLOTB);
  ROT();
  kload8(kf,kp0+sl_cur);
  WAIT_BAR(3);
  s16x4 vlo[8],vhi[8];
  #define PAFX(x) __builtin_bit_cast(bf16x8,x)
  #define VFR(i) (bf16x8){vlo[i][0],vlo[i][1],vlo[i][2],vlo[i][3],vhi[i][0],vhi[i][1],vhi[i][2],vhi[i][3]}
  #define PIN(x) asm volatile("":"+v"(x))
  #define MX3(a,b,c) __builtin_fmaxf(__builtin_fmaxf((a),(b)),(c))
  #define EX(v) __builtin_amdgcn_exp2f(v)
  #define MFM(a,b,c) __builtin_amdgcn_mfma_f32_32x32x16_bf16(a,b,c,0,0,0)
  #define VRDQ(i,qoff) do{ vlo[i]=vtr(vp_+((qoff)+(((i)>>2)*4096+((i)&3)*1024))); vhi[i]=vtr(vp_+((qoff)+(((i)>>2)*4096+((i)&3)*1024+512))); }while(0)
  #define KRD(G,j) do{ if(G){ kload2(kf,kp0+sl_next,j); SBAR(); } }while(0)
  #define GAPA(MF) do{ MF; SBAR(); }while(0)
  #define GAPB(MF,X,B,I) do{ MF; X[B]=EX(X[B]); X[B+1]=EX(X[B+1]); X[B+2]=EX(X[B+2]); X[B+3]=EX(X[B+3]); PIN(X); VRDQ(I,8192); SBAR(); }while(0)
  #define GAPC(MF,A0,A1,A2,A3,W0,W1,PW) do{ MF; sacc+=A0; sacc+=A1; sacc+=A2; sacc+=A3; PIN(sacc); W0; W1; PIN(PW); SBAR(); }while(0)
  #define STEPW(PO0,PO1,PO2,PO3,PN0,PN1,PN2,PN3,t,GK,GV,GL) do{ SBAR(); \
    const lds_cptr vp_=vp0+2*sl_prev; \
    VRDQ(0,0); SBAR(); GAPA(c0=MFM(kf[0],qr[0],negm)); \
    VRDQ(4,0); SBAR(); GAPA(c1=MFM(kf[1],qr[0],negm)); \
    VRDQ(1,0); SBAR(); GAPA(c0=MFM(kf[2],qr[1],c0)); \
    VRDQ(5,0); SBAR(); GAPA(c1=MFM(kf[3],qr[1],c1)); \
    VRDQ(2,0); SBAR(); GAPA(c0=MFM(kf[4],qr[2],c0)); \
    VRDQ(6,0); SBAR(); GAPA(c1=MFM(kf[5],qr[2],c1)); \
    VRDQ(3,0); SBAR(); GAPA(c0=MFM(kf[6],qr[3],c0)); \
    VRDQ(7,0); SBAR(); GAPA(c1=MFM(kf[7],qr[3],c1)); \
    if(GK){DMA_K((t)+3,sl_cur);} if(GV){DMA_V((t)+1,sl_next);} \
    CMASK(c0,c1,t); \
    { float a=MX3(c0[0],c0[1],c1[0]),b=MX3(c0[2],c0[3],c1[1]); a=MX3(a,c1[2],c1[3]); \
      _Pragma("unroll") for(int r=4;r<16;r+=4){a=MX3(a,c0[r],c0[r+1]);b=MX3(b,c0[r+2],c0[r+3]);a=MX3(a,c1[r],c1[r+1]);b=MX3(b,c1[r+2],c1[r+3]);} \
      float rm=__builtin_fmaxf(a,b); { auto rr=__builtin_amdgcn_permlane32_swap(__float_as_uint(rm),__float_as_uint(rm),false,false); rm=__builtin_fmaxf(__uint_as_float(rr[0]),__uint_as_float(rr[1])); } \
      resc=false; \
      if(__builtin_expect(__any(rm>(float)THRL),0)){ const float dl=__builtin_fmaxf(rm,0.f); mhat+=dl; \
        _Pragma("unroll") for(int r=0;r<16;++r){c0[r]-=dl;c1[r]-=dl;} \
        _Pragma("unroll") for(int r=0;r<16;++r)negm[r]=-mhat; asm volatile("":"+v"(negm)); \
        const float f=__builtin_amdgcn_exp2f(-dl); l_reg*=f; if(hi==0)wsf[r32]=f; resc=true; } } \
    SBAR(); \
    GAPB(o[0]=MFM(PAFX(PO0),VFR(0),o[0]), c0,0, 0); \
    GAPB(o[1]=MFM(PAFX(PO0),VFR(4),o[1]), c0,4, 4); \
    KRD(GL,0); GAPB(o[0]=MFM(PAFX(PO1),VFR(1),o[0]), c0,8, 1); \
    KRD(GL,1); GAPB(o[1]=MFM(PAFX(PO1),VFR(5),o[1]), c0,12, 5); \
    KRD(GL,2); GAPB(o[0]=MFM(PAFX(PO2),VFR(2),o[0]), c1,0, 2); \
    KRD(GL,3); GAPB(o[1]=MFM(PAFX(PO2),VFR(6),o[1]), c1,4, 6); \
    GAPB(o[0]=MFM(PAFX(PO3),VFR(3),o[0]), c1,8, 3); \
    GAPB(o[1]=MFM(PAFX(PO3),VFR(7),o[1]), c1,12, 7); \
    float sacc=(c0[0]+c0[1]); \
    GAPC(o[2]=MFM(PAFX(PO0),VFR(0),o[2]), c0[2],c0[3],c0[4],c0[5],     PN0[0]=PKW(c0,0), PN0[1]=PKW(c0,2), PN0); \
    GAPC(o[3]=MFM(PAFX(PO0),VFR(4),o[3]), c0[6],c0[7],c0[8],c0[9],     PN0[2]=PKW(c0,4), PN0[3]=PKW(c0,6), PN0); \
    GAPC(o[2]=MFM(PAFX(PO1),VFR(1),o[2]), c0[10],c0[11],c0[12],c0[13], PN1[0]=PKW(c0,8), PN1[1]=PKW(c0,10), PN1); \
    GAPC(o[3]=MFM(PAFX(PO1),VFR(5),o[3]), c0[14],c0[15],c1[0],c1[1],   PN1[2]=PKW(c0,12),PN1[3]=PKW(c0,14), PN1); \
    GAPC(o[2]=MFM(PAFX(PO2),VFR(2),o[2]), c1[2],c1[3],c1[4],c1[5],     PN2[0]=PKW(c1,0), PN2[1]=PKW(c1,2), PN2); \
    GAPC(o[3]=MFM(PAFX(PO2),VFR(6),o[3]), c1[6],c1[7],c1[8],c1[9],     PN2[2]=PKW(c1,4), PN2[3]=PKW(c1,6), PN2); \
    GAPC(o[2]=MFM(PAFX(PO3),VFR(3),o[2]), c1[10],c1[11],c1[12],c1[13], PN3[0]=PKW(c1,8), PN3[1]=PKW(c1,10), PN3); \
    GAPC(o[3]=MFM(PAFX(PO3),VFR(7),o[3]), c1[14],c1[15],0.f,0.f,       PN3[2]=PKW(c1,12),PN3[3]=PKW(c1,14), PN3); \
    l_reg+=sacc; \
    }while(0)
  int t=1;
  #undef CMASK
  #define CMASK(P0,P1,t) do{}while(0)
  for(;t+5<NT;t+=2){
    STEPW(pa0,pa1,pa2,pa3,pb0,pb1,pb2,pb3,t,true,true,true);     WAIT_BAR(3); RESC(); ROT();
    STEPW(pb0,pb1,pb2,pb3,pa0,pa1,pa2,pa3,t+1,true,true,true);   WAIT_BAR(3); RESC(); ROT();
  }
  #undef CMASK
  #define CMASK(P0,P1,t) do{int jb_=(t)-(NT-4); if(jb_>=0)cmask(P0,P1,jb_,wid>>1);}while(0)
  #define ENDW(tt) do{ if((tt)+3<NT){WAIT_BAR(3);} else if((tt)+2<NT){WAIT_BAR(2);} else {WAIT_BAR(0);} }while(0)
  for(;t+1<NT;t+=2){
    STEPW(pa0,pa1,pa2,pa3,pb0,pb1,pb2,pb3,t,(t+3<NT),(t+1<NT),(t+1<NT));       ENDW(t);   RESC(); ROT();
    STEPW(pb0,pb1,pb2,pb3,pa0,pa1,pa2,pa3,t+1,(t+4<NT),(t+2<NT),(t+2<NT));     ENDW(t+1); RESC(); ROT();
  }
  STEPW(pa0,pa1,pa2,pa3,pb0,pb1,pb2,pb3,NT-1,false,false,false); RESC();
  { SBAR();
    #pragma unroll
    for(int q=0;q<4;++q){ s16x4 lo[4],hh[4]; const int vb=(int)(unsigned)(uintptr_t)vp0+2*sl_cur;
      #pragma unroll
      for(int ks=0;ks<4;++ks){
        asm volatile("ds_read_b64_tr_b16 %0,%1 offset:%c2":"=&v"(lo[ks]):"v"(vb),"i"(q*4096+ks*1024):"memory");
        asm volatile("ds_read_b64_tr_b16 %0,%1 offset:%c2":"=&v"(hh[ks]):"v"(vb),"i"(q*4096+ks*1024+512):"memory");}
      asm volatile("s_waitcnt lgkmcnt(0)":::"memory");SBAR();
      #define PK(k) (bf16x8){lo[k][0],lo[k][1],lo[k][2],lo[k][3],hh[k][0],hh[k][1],hh[k][2],hh[k][3]}
      o[q]=MFM(PAFX(pb0),PK(0),o[q]); o[q]=MFM(PAFX(pb1),PK(1),o[q]); o[q]=MFM(PAFX(pb2),PK(2),o[q]); o[q]=MFM(PAFX(pb3),PK(3),o[q]);
      #undef PK
    } }
  #undef PKW
  #undef PAFX
  #undef VFR
  #undef PIN
  #undef MX3
  #undef EX
  #undef MFM
  #undef VRDQ
  #undef KRD
  #undef GAPA
  #undef GAPB
  #undef GAPC
  #undef STEPW
  #undef ENDW
  {auto rr=__builtin_amdgcn_permlane32_swap(__float_as_uint(l_reg),__float_as_uint(l_reg),false,false);l_reg=__uint_as_float(rr[0])+__uint_as_float(rr[1]);}
  if(hi==0)wsf[32+r32]=l_reg;asm volatile("s_waitcnt lgkmcnt(0)":::"memory");
  float rli[16];
  #pragma unroll
  for(int r=0;r<16;++r)rli[r]=__builtin_amdgcn_rcpf(wsf[32+crow(r,hi)]);
  float*Ow=O+(long)(q0+wid*QBLK)*DM;
  { float*stg=(float*)(shm+W_LDS_OST)+wid*1024;
    #pragma unroll
    for(int q=0;q<4;++q){
      #pragma unroll
      for(int r=0;r<16;++r)stg[crow(r,hi)*32+r32]=o[q][r]*rli[r];
      asm volatile("s_waitcnt lgkmcnt(0)":::"memory");
      #pragma unroll
      for(int i=0;i<4;++i){const int row=i*8+(lane>>3),ch=lane&7; const u32x4 v=*(const u32x4*)(stg+row*32+ch*4); *(u32x4*)(Ow+(long)row*DM+q*32+ch*4)=v;}
      asm volatile("s_waitcnt lgkmcnt(0)":::"memory");
    } }
  asm volatile("s_waitcnt lgkmcnt(0)\n\ts_barrier":::"memory");
  #undef DMA_K
  #undef DMA_V
  #undef CMASK
  #undef RESC
  #undef ROT
}
constexpr int ATTN_LDS_BYTES=W_LDS_BYTES>LDS_BYTES?W_LDS_BYTES:LDS_BYTES;
#undef SBAR
#undef WAIT_BAR
}
#define GAS __attribute__((address_space(1)))
#define LAS __attribute__((address_space(3)))
typedef unsigned short bf16;
typedef unsigned v4u __attribute__((ext_vector_type(4)));
typedef float f32x4 __attribute__((ext_vector_type(4)));
typedef short bf16x8 __attribute__((ext_vector_type(8)));
typedef GAS unsigned gu32;
typedef GAS unsigned long long gu64;
#define RLX_AGENT __ATOMIC_RELAXED, __HIP_MEMORY_SCOPE_AGENT
#define LDS_WAIT() asm volatile("s_waitcnt lgkmcnt(0)" ::: "memory")
#define VM_WAIT() asm volatile("s_waitcnt vmcnt(0)" ::: "memory")
__device__ __forceinline__ unsigned long long rt() { return __builtin_amdgcn_s_memrealtime(); }
__device__ __forceinline__ unsigned f2bf(float f) { unsigned u = __builtin_bit_cast(unsigned, f); return (u + 0x7fffu + ((u >> 16) & 1u)) >> 16; }
__device__ __forceinline__ unsigned pk2(float lo, float hi) { return f2bf(lo) | (f2bf(hi) << 16); }

#define XB_TMO      128
#define XB_XCNT(j)  (256  + 64 * (j))
#define XB_XSUB(j)  (1280 + 64 * (j))
#define XB_XGEN(j)  (2304 + 64 * (j))
#define XB_TOP      3328
#define XB_TOPGEN   3392
#define XCD_BAR_WORDS 3456
#define XB_SPIN_CAP (1u << 18)

__device__ __forceinline__ unsigned xb_ld(unsigned* p)              { return __hip_atomic_load(p, __ATOMIC_RELAXED, __HIP_MEMORY_SCOPE_AGENT); }
__device__ __forceinline__ unsigned xb_add(unsigned* p, unsigned v) { return __hip_atomic_fetch_add(p, v, __ATOMIC_RELAXED, __HIP_MEMORY_SCOPE_AGENT); }
__device__ __forceinline__ unsigned xb_xcc_id() { return (unsigned)__builtin_amdgcn_s_getreg((3 << 11) | 20) & 0xFu; }
#define XB_SPIN(cond, bar) do { unsigned _sp = 0; while (cond) { __builtin_amdgcn_s_sleep(1); \
    if ((++_sp & 255u) == 0u) { if (xb_ld(&(bar)[XB_TMO])) break; if (_sp > XB_SPIN_CAP) { atomicAdd(&(bar)[XB_TMO], 1u); break; } } } } while (0)

struct XcdBarrier {
    unsigned* bar; unsigned x;
    volatile LAS unsigned* st;
};

__device__ __forceinline__ XcdBarrier xcd_barrier_post(unsigned* bar, volatile LAS unsigned* st) {
    XcdBarrier b; b.bar = bar; b.x = xb_xcc_id(); b.st = st;
    if (threadIdx.x == 0) (void)xb_add(&bar[XB_XCNT(b.x)], 1u);
    return b;
}
__device__ __forceinline__ void xcd_barrier_complete(unsigned* bar, unsigned x, unsigned& nloc, unsigned& nx) {
    const unsigned G = gridDim.x * gridDim.y * gridDim.z;
    unsigned sum, cnt, mine, sp = 0u;
    for (;;) {
        sum = 0u; cnt = 0u; mine = 0u;
#pragma unroll
        for (unsigned j = 0; j < 16; ++j) { const unsigned c = xb_ld(&bar[XB_XCNT(j)]); sum += c; cnt += (c > 0u) ? 1u : 0u; mine = (j == x) ? c : mine; }
        if (sum == G) break;
        __builtin_amdgcn_s_sleep(1);
        if ((++sp & 255u) == 0u) { if (xb_ld(&bar[XB_TMO])) break; if (sp > XB_SPIN_CAP) { atomicAdd(&bar[XB_TMO], 1u); break; } }
    }
    nloc = mine > 0u ? mine : 1u; nx = cnt > 0u ? cnt : 1u;
}

__device__ __forceinline__ void xcd_barrier(const XcdBarrier& b) {
    asm volatile("s_waitcnt vmcnt(0)" ::: "memory");
    __syncthreads();
    if (threadIdx.x == 0) {
        unsigned* bar = b.bar;
        __builtin_amdgcn_s_waitcnt(0);
        unsigned nloc = b.st[0], nx = b.st[1];
        if (nloc == 0u) { xcd_barrier_complete(bar, b.x, nloc, nx); b.st[0] = nloc; b.st[1] = nx; }
        const unsigned old = xb_add(&bar[XB_XSUB(b.x)], 1u);
        const unsigned gen = old / nloc;
        if (old + 1u == (gen + 1u) * nloc) {
            __builtin_amdgcn_fence(__ATOMIC_RELEASE, "agent");
            asm volatile("s_waitcnt vmcnt(0)" ::: "memory");
            const unsigned og = xb_add(&bar[XB_TOP], 1u);
            const unsigned tg = og / nx;
            if (og + 1u == (tg + 1u) * nx) xb_add(&bar[XB_TOPGEN], 1u);
            else XB_SPIN(xb_ld(&bar[XB_TOPGEN]) == tg, bar);
            __builtin_amdgcn_fence(__ATOMIC_ACQUIRE, "agent");
            xb_add(&bar[XB_XGEN(b.x)], 1u);
            asm volatile("s_waitcnt vmcnt(0)" ::: "memory");
        } else {
            XB_SPIN(xb_ld(&bar[XB_XGEN(b.x)]) == gen, bar);
            __builtin_amdgcn_fence(__ATOMIC_ACQUIRE, "agent");
            asm volatile("s_waitcnt vmcnt(0)" ::: "memory");
        }
    }
    __syncthreads();
}
typedef unsigned short bf16_t;
typedef float f32x4 __attribute__((ext_vector_type(4)));
typedef float f32x16 __attribute__((ext_vector_type(16)));
typedef unsigned u32x2 __attribute__((ext_vector_type(2)));
typedef unsigned u32x4v __attribute__((ext_vector_type(4)));
typedef short bf16x8 __attribute__((ext_vector_type(8)));
__device__ __forceinline__ float bflo(unsigned w) { return __uint_as_float(w << 16); }
__device__ __forceinline__ float bfhi(unsigned w) { return __uint_as_float(w & 0xffff0000u); }
__device__ __forceinline__ unsigned pkbf(float lo, float hi) { return pg8::cvt_pk_bf16(lo, hi); }
__device__ __forceinline__ float sigm(float x) { return __builtin_amdgcn_rcpf(1.f + __builtin_amdgcn_exp2f(-1.4426950408889634f * x)); }
template <int MSK> __device__ __forceinline__ float xor_swz(float v) { return __int_as_float(__builtin_amdgcn_ds_swizzle(__float_as_int(v), (MSK << 10) | 0x1f)); }
__device__ __forceinline__ float sum_halves(float v) { auto rr = __builtin_amdgcn_permlane32_swap(__float_as_uint(v), __float_as_uint(v), false, false); return __uint_as_float(rr[0]) + __uint_as_float(rr[1]); }
__device__ __forceinline__ float max_halves(float v) { auto rr = __builtin_amdgcn_permlane32_swap(__float_as_uint(v), __float_as_uint(v), false, false); return fmaxf(__uint_as_float(rr[0]), __uint_as_float(rr[1])); }
__device__ __forceinline__ float wave_sum(float v) { v += xor_swz<1>(v); v += xor_swz<2>(v); v += xor_swz<4>(v); v += xor_swz<8>(v); v += xor_swz<16>(v); return sum_halves(v); }
__device__ __forceinline__ int fresh_tid(int wave) { int l_; asm volatile("v_mbcnt_lo_u32_b32 %0, -1, 0\n\tv_mbcnt_hi_u32_b32 %0, -1, %0" : "=v"(l_)); return wave * 64 + l_; }
__device__ __forceinline__ int crow16(int r, int hi) { return (r & 3) + 8 * (r >> 2) + 4 * hi; }

struct EpiIn {
    static constexpr bool PERM = false, AFTER_DRAIN = false;
    bf16_t *PXB, *SPG, *QB, *KB, *VB, *SAG, *SGA, *SGB; float* out; const float* rc; const float* rs; int layer;
    __device__ __forceinline__ void operator()(const pg8::f32x4 (&acc)[2][2][4][2], const pg8::Unit& u, int wr, int wc, int fr, int fq) const {
        const int pn = u.pn, row0 = u.pm * 256 + wr * 64 + fr;
        const bool samp = u.pm >= MP / 256;
        if (pn >= 4 && pn < 12) {
            const bool isk = pn >= 8;
            const int cbase = (pn - (isk ? 8 : 4)) * 256 + (wc >> 1) * 64 + (wc & 1) * 16 + 4 * fq;
            const int i0 = (wc & 1) * 16 + 4 * fq;
            bf16_t* dstb = isk ? KB : QB; const float sc = isk ? 1.f : C2;
#pragma unroll
            for (int ai = 0; ai < 2; ++ai)
#pragma unroll
                for (int m = 0; m < 4; ++m) {
                    const int row = row0 + ai * 128 + m * 16;
                    const int pos = samp ? PAST + ((row - MP) & 15) : (row & (SEQ - 1));
                    const f32x4 c = *(const f32x4*)(rc + pos * 32 + i0), s = *(const f32x4*)(rs + pos * 32 + i0);
                    float* ko = samp ? out + O_KS + ((size_t)layer * MS + (row - MP)) * 1024 : out + O_KP + ((size_t)layer * MP + row) * 1024;
#pragma unroll
                    for (int bj = 0; bj < 2; ++bj) {
                        const f32x4 x1 = acc[ai][bj][m][0], x2 = acc[ai][bj][m][1];
                        const f32x4 r1 = x1 * c - x2 * s, r2 = x2 * c + x1 * s;
                        const int col = cbase + bj * 128;
                        if (isk) { *(f32x4*)(ko + col) = r1; *(f32x4*)(ko + col + 32) = r2; }
                        u32x2 w1, w2; w1.x = pkbf(r1[0] * sc, r1[1] * sc); w1.y = pkbf(r1[2] * sc, r1[3] * sc); w2.x = pkbf(r2[0] * sc, r2[1] * sc); w2.y = pkbf(r2[2] * sc, r2[3] * sc);
                        *(u32x2*)(dstb + (size_t)row * 1024 + col) = w1; *(u32x2*)(dstb + (size_t)row * 1024 + col + 32) = w2;
                    }
                }
        } else {
            int mode, ld, cb; bf16_t* dst;
            if (pn < 2) { dst = PXB; ld = 512; cb = pn * 256; mode = 0; }
            else if (pn < 4) { dst = SPG; ld = 512; cb = (pn - 2) * 256; mode = 1; }
            else if (pn < 16) { dst = VB; ld = 1024; cb = (pn - 12) * 256; mode = 0; }
            else if (pn < 20) { dst = SAG; ld = 1024; cb = (pn - 16) * 256; mode = 1; }
            else if (pn < 24) { dst = SGA; ld = 1024; cb = (pn - 20) * 256; mode = 2; }
            else { dst = SGB; ld = 1024; cb = (pn - 24) * 256; mode = 2; }
            cb += 32 * wc + 8 * fq;
            const bool isv = pn >= 12 && pn < 16, ispx = pn < 2;
#pragma unroll
            for (int ai = 0; ai < 2; ++ai)
#pragma unroll
                for (int m = 0; m < 4; ++m) {
                    const int row = row0 + ai * 128 + m * 16;
                    float* fo = nullptr;
                    if (isv) fo = samp ? out + O_VS + ((size_t)layer * MS + (row - MP)) * 1024 : out + O_VP + ((size_t)layer * MP + row) * 1024;
                    else if (ispx) {
                        if (!samp) { const int t = row & (SEQ - 1); if (t >= SEQ - 15) fo = out + O_PP + (((size_t)layer * BATCH + (row >> 12)) * 15 + (t - (SEQ - 15))) * 512; }
                        else { const int rs_ = row - MP, j = rs_ & 15; if (j >= 1) fo = out + O_PS + (((size_t)layer * DEC_BATCH + (rs_ >> 4)) * 15 + (j - 1)) * 512; }
                    }
#pragma unroll
                    for (int bj = 0; bj < 2; ++bj) {
                        f32x4 v0 = acc[ai][bj][m][0], v1 = acc[ai][bj][m][1];
                        const int col = cb + bj * 128;
                        if (fo) { *(f32x4*)(fo + col) = v0; *(f32x4*)(fo + col + 4) = v1; }
                        if (mode == 1) {
#pragma unroll
                            for (int k = 0; k < 4; ++k) { v0[k] = v0[k] * sigm(v0[k]); v1[k] = v1[k] * sigm(v1[k]); }
                        } else if (mode == 2) {
#pragma unroll
                            for (int k = 0; k < 4; ++k) { v0[k] = sigm(v0[k]); v1[k] = sigm(v1[k]); }
                        }
                        u32x4v w; w.x = pkbf(v0[0], v0[1]); w.y = pkbf(v0[2], v0[3]); w.z = pkbf(v1[0], v1[1]); w.w = pkbf(v1[2], v1[3]);
                        *(u32x4v*)(dst + (size_t)row * ld + col) = w;
                    }
                }
        }
    }
};
struct EpiMergeA {
    static constexpr bool PERM = false, AFTER_DRAIN = false;
    const bf16_t* SGA; float* TMPA;
    __device__ __forceinline__ void operator()(const pg8::f32x4 (&acc)[2][2][4][2], const pg8::Unit& u, int wr, int wc, int fr, int fq) const {
        const int row0 = u.pm * 256 + wr * 64 + fr, col0 = u.pn * 256 + wc * 32 + 4 * fq;
#pragma unroll
        for (int ai = 0; ai < 2; ++ai)
#pragma unroll
            for (int m = 0; m < 4; ++m) { const size_t ro = (size_t)(row0 + ai * 128 + m * 16) * 1024 + col0;
#pragma unroll
                for (int bj = 0; bj < 2; ++bj)
#pragma unroll
                    for (int n = 0; n < 2; ++n) { const size_t o = ro + bj * 128 + n * 16; const u32x2 g = *(const u32x2*)(SGA + o);
                        const f32x4 a = acc[ai][bj][m][n]; f32x4 r; r[0] = a[0] * bflo(g.x); r[1] = a[1] * bfhi(g.x); r[2] = a[2] * bflo(g.y); r[3] = a[3] * bfhi(g.y);
                        *(f32x4*)(TMPA + o) = r; } }
    }
};
struct EpiMergeB {
    static constexpr bool PERM = false, AFTER_DRAIN = false;
    const bf16_t* SGB; const float* TMPA; bf16_t* MG;
    __device__ __forceinline__ void operator()(const pg8::f32x4 (&acc)[2][2][4][2], const pg8::Unit& u, int wr, int wc, int fr, int fq) const {
        const int row0 = u.pm * 256 + wr * 64 + fr, col0 = u.pn * 256 + wc * 32 + 4 * fq;
#pragma unroll
        for (int ai = 0; ai < 2; ++ai)
#pragma unroll
            for (int m = 0; m < 4; ++m) { const size_t ro = (size_t)(row0 + ai * 128 + m * 16) * 1024 + col0;
#pragma unroll
                for (int bj = 0; bj < 2; ++bj)
#pragma unroll
                    for (int n = 0; n < 2; ++n) { const size_t o = ro + bj * 128 + n * 16; const u32x2 g = *(const u32x2*)(SGB + o); const f32x4 t = *(const f32x4*)(TMPA + o);
                        const f32x4 a = acc[ai][bj][m][n]; f32x4 r; r[0] = t[0] + a[0] * bflo(g.x); r[1] = t[1] + a[1] * bfhi(g.x); r[2] = t[2] + a[2] * bflo(g.y); r[3] = t[3] + a[3] * bfhi(g.y);
                        u32x2 w; w.x = pkbf(r[0], r[1]); w.y = pkbf(r[2], r[3]); *(u32x2*)(MG + o) = w; } }
    }
};
struct EpiOut {
    static constexpr bool PERM = false, AFTER_DRAIN = false;
    float* X;
    __device__ __forceinline__ void operator()(const pg8::f32x4 (&acc)[2][2][4][2], const pg8::Unit& u, int wr, int wc, int fr, int fq) const {
        const int row0 = u.pm * 256 + wr * 64 + fr, col0 = u.pn * 256 + wc * 32 + 4 * fq;
#pragma unroll
        for (int ai = 0; ai < 2; ++ai)
#pragma unroll
            for (int m = 0; m < 4; ++m) { const size_t ro = (size_t)(row0 + ai * 128 + m * 16) * 1024 + col0;
#pragma unroll
                for (int bj = 0; bj < 2; ++bj)
#pragma unroll
                    for (int n = 0; n < 2; ++n) { const size_t o = ro + bj * 128 + n * 16; const f32x4 x = *(const f32x4*)(X + o); *(f32x4*)(X + o) = x * ALPHA + acc[ai][bj][m][n]; } }
    }
};

__device__ __forceinline__ int inv_perm_S(int a) { const int bj = a >> 7, wc = (a >> 5) & 3, fq = (a >> 3) & 3, n = (a >> 2) & 1, j = a & 3; return 128 * bj + 32 * wc + 16 * n + 4 * fq + j; }
__device__ __forceinline__ int inv_perm_R(int a) { const int bj = a >> 7, wch = (a >> 6) & 1, n = (a >> 5) & 1, wcl = (a >> 4) & 1, fq = (a >> 2) & 3, j = a & 3; return 128 * bj + 32 * (2 * wch + wcl) + 16 * n + 4 * fq + j; }
template <int PM>
__device__ __forceinline__ void p0_transpose_item(const float* W, int K, int N, bf16_t* WT, LAS float* scr, int item, int lane) {
    const int nblk = N / 32, kb = item / nblk, nb = item % nblk, k0 = 64 * kb, n0 = 32 * nb;
#pragma unroll 8
    for (int i = 0; i < 32; ++i) { const int kk = 2 * i + (lane >> 5); scr[kk * 33 + (lane & 31)] = W[(size_t)(k0 + kk) * N + n0 + (lane & 31)]; }
    LDS_WAIT(); asm volatile("" ::: "memory");
    const int c = lane & 7;
#pragma unroll
    for (int j = 0; j < 4; ++j) { const int n = (lane >> 3) + 8 * j; const LAS float* s = scr + (8 * c) * 33 + n;
        v4u o; o.x = pkbf(s[0 * 33], s[1 * 33]); o.y = pkbf(s[2 * 33], s[3 * 33]); o.z = pkbf(s[4 * 33], s[5 * 33]); o.w = pkbf(s[6 * 33], s[7 * 33]);
        int nr = n0 + n;
        if (PM == 1) { const int tile = nr >> 8, a = nr & 255; nr = (nr & ~255) + ((tile >= 4 && tile < 12) ? inv_perm_R(a) : inv_perm_S(a)); }
        *(GAS v4u*)(WT + (size_t)nr * K + k0 + 8 * c) = o; }
    LDS_WAIT(); asm volatile("" ::: "memory");
}
__device__ __forceinline__ void ln_row(const float* xrow, const float* g, const float* b, float* of, bf16_t* ob) {
    const int lane = fresh_tid(0);
    const GAS f32x4* xr = (const GAS f32x4*)xrow + lane;
    f32x4 v[4]; float s = 0.f;
#pragma unroll
    for (int j = 0; j < 4; ++j) { v[j] = xr[64 * j]; s += (v[j].x + v[j].y) + (v[j].z + v[j].w); }
    const float mean = wave_sum(s) * (1.f / 1024.f); float s2 = 0.f;
#pragma unroll
    for (int j = 0; j < 4; ++j) { v[j] = v[j] - mean; s2 += (v[j].x * v[j].x + v[j].y * v[j].y) + (v[j].z * v[j].z + v[j].w * v[j].w); }
    const float rstd = 1.f / sqrtf(wave_sum(s2) * (1.f / 1024.f) + LN_EPS);
    GAS f32x4* o4 = (GAS f32x4*)of + lane; GAS u32x2* o8 = (GAS u32x2*)ob + lane;
#pragma unroll
    for (int j = 0; j < 4; ++j) { const f32x4 gg = ((const GAS f32x4*)g + lane)[64 * j], bb = ((const GAS f32x4*)b + lane)[64 * j];
        const f32x4 y = v[j] * rstd * gg + bb; o4[64 * j] = y; u32x2 w; w.x = pkbf(y.x, y.y); w.y = pkbf(y.z, y.w); o8[64 * j] = w; }
}

struct Params { const float* in[17]; float* out; unsigned char* ws; int l_lo, l_hi, do_pro, bar_region; };
enum { I_XP = 0, I_XS, I_CK, I_CV, I_SP, I_LIG, I_LIB, I_WIN, I_WPOOL, I_PSC, I_LQK, I_SUBLN, I_WA, I_WB, I_WO, I_LNG, I_LNB };

constexpr int POOL_TILE_PITCH = 272, POOL_TILE_BYTES = 12800, POOL_NITEMS = (MP / 32) * 4 + DEC_BATCH * 4;
__device__ __forceinline__ void pool_item(int item, int layer, const Params& P, LAS unsigned char* tile) {
    const int lane = fresh_tid(0);
    constexpr int NPI = (MP / 32) * 4;
    const bool samp = item >= NPI;
    int g, R0, nrows;
    if (!samp) { g = item / (MP / 32); R0 = (item % (MP / 32)) * 32; nrows = 32; } else { const int si = item - NPI; g = si / DEC_BATCH; R0 = MP + (si % DEC_BATCH) * 16; nrows = 16; }
    const int w = 2 << g, ntr = 15 + nrows;
    const bf16_t* PXB = (const bf16_t*)(P.ws + WS_PXB); const bf16_t* SPG = (const bf16_t*)(P.ws + WS_SPG); bf16_t* YA = (bf16_t*)(P.ws + WS_YA);
    const bf16_t* WpT = (const bf16_t*)(P.ws + WS_WP) + (size_t)(layer * 4 + g) * 128 * 128;
    if (!samp) {
        const int t0 = R0 & (SEQ - 1);
        u32x4v v[12];
#pragma unroll
        for (int i = 0; i < 12; ++i) { const int p = i * 64 + lane, trow = p >> 4, c16 = p & 15; const bool ok = trow < ntr && (t0 + trow - 15) >= 0;
            const int grow = ok ? (R0 - 15 + trow) : R0; v[i] = *(const u32x4v*)(PXB + (size_t)grow * 512 + g * 128 + c16 * 8); if (!ok) v[i] = (u32x4v){0u, 0u, 0u, 0u}; }
#pragma unroll
        for (int i = 0; i < 12; ++i) { const int p = i * 64 + lane, trow = p >> 4, c16 = p & 15; if (trow < ntr) *(LAS u32x4v*)(tile + trow * POOL_TILE_PITCH + c16 * 16) = v[i]; }
    } else {
        const float* hist = P.in[I_SP] + ((size_t)layer * DEC_BATCH + ((R0 - MP) >> 4)) * 15 * 512 + g * 128;
#pragma unroll
        for (int i = 0; i < 8; ++i) { const int p = i * 64 + lane, trow = p >> 4, c16 = p & 15;
            if (trow < ntr) { u32x4v v;
                if (trow >= 15) v = *(const u32x4v*)(PXB + (size_t)(R0 + trow - 15) * 512 + g * 128 + c16 * 8);
                else { const float* hp = hist + (size_t)trow * 512 + c16 * 8; const f32x4 h0 = *(const f32x4*)hp, h1 = *(const f32x4*)(hp + 4);
                    v.x = pkbf(h0[0], h0[1]); v.y = pkbf(h0[2], h0[3]); v.z = pkbf(h1[0], h1[1]); v.w = pkbf(h1[2], h1[3]); }
                *(LAS u32x4v*)(tile + trow * POOL_TILE_PITCH + c16 * 16) = v; } }
    }
    asm volatile("s_waitcnt lgkmcnt(0)" ::: "memory");
    const int r = lane & 31, hi = lane >> 5, rl = r & (nrows - 1), row = R0 + rl;
    bf16x8 afirst[8];
#pragma unroll
    for (int s = 0; s < 8; ++s) afirst[s] = *(const bf16x8*)(WpT + (size_t)r * 128 + 16 * s + 8 * hi);
    int cnt = w; if (!samp) { const int navail = (row & (SEQ - 1)) + 1; cnt = navail < w ? navail : w; }
    const float rcnt = 1.f / (float)cnt;
    bf16x8 bfr[8];
#pragma unroll
    for (int s = 0; s < 8; ++s) {
        const LAS unsigned char* bp = tile + (15 + rl) * POOL_TILE_PITCH + (16 * s + 8 * hi) * 2;
        const u32x4v tk = *(const LAS u32x4v*)bp;
        const float t0[8] = {bflo(tk.x), bfhi(tk.x), bflo(tk.y), bfhi(tk.y), bflo(tk.z), bfhi(tk.z), bflo(tk.w), bfhi(tk.w)};
        float a[8];
#pragma unroll
        for (int k = 0; k < 8; ++k) a[k] = t0[k];
#pragma unroll 4
        for (int d = 1; d < w; ++d) { const u32x4v v = *(const LAS u32x4v*)(bp - d * POOL_TILE_PITCH);
            a[0] += bflo(v.x); a[1] += bfhi(v.x); a[2] += bflo(v.y); a[3] += bfhi(v.y); a[4] += bflo(v.z); a[5] += bfhi(v.z); a[6] += bflo(v.w); a[7] += bfhi(v.w); }
        u32x4v pk; pk.x = pkbf(a[0] * rcnt - t0[0], a[1] * rcnt - t0[1]); pk.y = pkbf(a[2] * rcnt - t0[2], a[3] * rcnt - t0[3]);
        pk.z = pkbf(a[4] * rcnt - t0[4], a[5] * rcnt - t0[5]); pk.w = pkbf(a[6] * rcnt - t0[6], a[7] * rcnt - t0[7]);
        bfr[s] = __builtin_bit_cast(bf16x8, pk);
    }
    const float* psc = P.in[I_PSC] + (size_t)layer * 512 + g * 128;
    bf16x8 af[2][8];
#pragma unroll
    for (int db = 0; db < 4; ++db) {
        if (db == 0) {
#pragma unroll
            for (int s = 0; s < 8; ++s) af[0][s] = afirst[s];
        }
        if (db < 3) {
#pragma unroll
            for (int s = 0; s < 8; ++s) af[(db + 1) & 1][s] = *(const bf16x8*)(WpT + (size_t)(32 * (db + 1) + r) * 128 + 16 * s + 8 * hi);
        }
        f32x4 sc[4]; u32x2 gt[4];
#pragma unroll
        for (int q = 0; q < 4; ++q) { const int d0 = 32 * db + 8 * q + 4 * hi; sc[q] = *(const f32x4*)(psc + d0); gt[q] = *(const u32x2*)(SPG + (size_t)row * 512 + g * 128 + d0); }
        f32x16 acc = {};
#pragma unroll
        for (int s = 0; s < 8; ++s) acc = __builtin_amdgcn_mfma_f32_32x32x16_bf16(af[db & 1][s], bfr[s], acc, 0, 0, 0);
        if (r < nrows) {
#pragma unroll
        for (int q = 0; q < 4; ++q) { const int d0 = 32 * db + 8 * q + 4 * hi;
            u32x2 o; o.x = pkbf(acc[4 * q] * sc[q][0] * bflo(gt[q].x), acc[4 * q + 1] * sc[q][1] * bfhi(gt[q].x)); o.y = pkbf(acc[4 * q + 2] * sc[q][2] * bflo(gt[q].y), acc[4 * q + 3] * sc[q][3] * bfhi(gt[q].y));
            *(u32x2*)(YA + (size_t)row * 512 + g * 128 + d0) = o; }
        }
    }
    asm volatile("s_waitcnt lgkmcnt(0)" ::: "memory");
}

__device__ __forceinline__ void combine_rows(size_t rowbase, int h, int layer, const Params& P, int wave) {
    const int tid = fresh_tid(wave);
    const float* O1 = (const float*)(P.ws + WS_O1); const float* O2 = (const float*)(P.ws + WS_O2);
    const bf16_t* SAG = (const bf16_t*)(P.ws + WS_SAG); bf16_t* YB = (bf16_t*)(P.ws + WS_YB);
    const float* LAM = (const float*)(P.ws + WS_LAM); const float lam = LAM[layer], li = LAM[4 + layer];
    const int rsub = tid >> 4, c8 = (tid & 15) * 8;
    const float* sl = P.in[I_SUBLN] + (size_t)layer * 128 + c8;
    const f32x4 s0 = *(const f32x4*)sl, s1 = *(const f32x4*)(sl + 4);
#pragma unroll 2
    for (int p = 0; p < 8; ++p) {
        const size_t base = (rowbase + p * 32 + rsub) * 1024 + h * 128 + c8;
        const f32x4 a0 = *(const f32x4*)(O1 + base) - lam * *(const f32x4*)(O2 + base), a1 = *(const f32x4*)(O1 + base + 4) - lam * *(const f32x4*)(O2 + base + 4);
        float ss = (a0[0] * a0[0] + a0[1] * a0[1]) + (a0[2] * a0[2] + a0[3] * a0[3]) + (a1[0] * a1[0] + a1[1] * a1[1]) + (a1[2] * a1[2] + a1[3] * a1[3]);
        ss += xor_swz<1>(ss); ss += xor_swz<2>(ss); ss += xor_swz<4>(ss); ss += xor_swz<8>(ss);
        const float rr = (1.f - li) / sqrtf(ss * (1.f / 128.f) + RMS_EPS);
        const u32x4v gt = *(const u32x4v*)(SAG + base);
        u32x4v o; o.x = pkbf(a0[0] * rr * s0[0] * bflo(gt.x), a0[1] * rr * s0[1] * bfhi(gt.x)); o.y = pkbf(a0[2] * rr * s0[2] * bflo(gt.y), a0[3] * rr * s0[3] * bfhi(gt.y));
        o.z = pkbf(a1[0] * rr * s1[0] * bflo(gt.z), a1[1] * rr * s1[1] * bfhi(gt.z)); o.w = pkbf(a1[2] * rr * s1[2] * bflo(gt.w), a1[3] * rr * s1[3] * bfhi(gt.w));
        *(u32x4v*)(YB + base) = o;
    }
}

__device__ __forceinline__ void sample_unit(int b, int h, int layer, const Params& P, LAS unsigned char* L, int wave) {
    const int tid = fresh_tid(wave), lane = tid & 63;
    const int r = lane & 31, hi = lane >> 5;
    const bf16_t* QB = (const bf16_t*)(P.ws + WS_QB);
    const bf16_t* qrow = QB + (size_t)(MP + b * 16 + (r & 15)) * 1024 + h * 128 + 8 * hi;
    bf16x8 qf[8];
#pragma unroll
    for (int s = 0; s < 8; ++s) { const bool nz = (s < 4) ? (r < 16) : (r >= 16); bf16x8 z = {}; qf[s] = nz ? *(const bf16x8*)(qrow + 16 * s) : z; }
    f32x16 ot[4]; ot[0] = f32x16{}; ot[1] = f32x16{}; ot[2] = f32x16{}; ot[3] = f32x16{};
    float mrun = -INFINITY, lrun = 0.f;
    const float* ck = P.in[I_CK] + ((size_t)(layer * DEC_BATCH + b) * PAST) * 1024 + h * 128;
    const float* cv = P.in[I_CV] + ((size_t)(layer * DEC_BATCH + b) * PAST) * 1024 + h * 128;
    const float* nk = P.out + O_KS + ((size_t)layer * MS + b * 16) * 1024 + h * 128;
    const float* nv = P.out + O_VS + ((size_t)layer * MS + b * 16) * 1024 + h * 128;
    const int ntile = (wave == 0) ? 5 : 4;
    for (int ti = 0; ti < ntile; ++ti) {
        const bool newt = ti == 4;
        const float* kb = newt ? nk : ck + (size_t)(32 * (wave + 8 * ti)) * 1024;
        const float* vb = newt ? nv : cv + (size_t)(32 * (wave + 8 * ti)) * 1024;
        const int rmask = newt ? 15 : 31;
        const float* kr = kb + (size_t)(r & rmask) * 1024 + 8 * hi;
        f32x4 kraw[16];
#pragma unroll
        for (int s = 0; s < 8; ++s) { kraw[2 * s] = *(const f32x4*)(kr + 16 * s); kraw[2 * s + 1] = *(const f32x4*)(kr + 16 * s + 4); }
        float vraw[32];
#pragma unroll
        for (int c = 0; c < 4; ++c)
#pragma unroll
            for (int j = 0; j < 8; ++j) { const int key = (8 * (j >> 2) + 4 * hi + (j & 3)) & rmask; vraw[c * 8 + j] = vb[(size_t)key * 1024 + 32 * c + r]; }
        __builtin_amdgcn_sched_barrier(0);
        f32x16 st = {};
#pragma unroll
        for (int s = 0; s < 8; ++s) { const f32x4 k0 = kraw[2 * s], k1 = kraw[2 * s + 1];
            u32x4v pk; pk.x = pkbf(k0[0], k0[1]); pk.y = pkbf(k0[2], k0[3]); pk.z = pkbf(k1[0], k1[1]); pk.w = pkbf(k1[2], k1[3]);
            st = __builtin_amdgcn_mfma_f32_32x32x16_bf16(__builtin_bit_cast(bf16x8, pk), qf[s], st, 0, 0, 0); }
        float vraw2[32];
#pragma unroll
        for (int c = 0; c < 4; ++c)
#pragma unroll
            for (int j = 0; j < 8; ++j) { const int key = (16 + 8 * (j >> 2) + 4 * hi + (j & 3)) & rmask; vraw2[c * 8 + j] = vb[(size_t)key * 1024 + 32 * c + r]; }
        __builtin_amdgcn_sched_barrier(0);
        if (newt) {
#pragma unroll
            for (int q = 8; q < 16; ++q) st[q] = -INFINITY;
        }
        float tm = st[0];
#pragma unroll
        for (int q = 1; q < 16; ++q) tm = fmaxf(tm, st[q]);
        tm = max_halves(tm);
        const float mnew = fmaxf(mrun, tm), f = __builtin_amdgcn_exp2f(mrun - mnew);
        mrun = mnew; lrun *= f;
#pragma unroll
        for (int c = 0; c < 4; ++c) ot[c] = ot[c] * f;
        float ps = 0.f;
#pragma unroll
        for (int q = 0; q < 16; ++q) { st[q] = __builtin_amdgcn_exp2f(st[q] - mnew); ps += st[q]; }
        lrun += ps;
        bf16x8 pf[2];
#pragma unroll
        for (int sp = 0; sp < 2; ++sp) { u32x4v pk; pk.x = pkbf(st[8 * sp], st[8 * sp + 1]); pk.y = pkbf(st[8 * sp + 2], st[8 * sp + 3]); pk.z = pkbf(st[8 * sp + 4], st[8 * sp + 5]); pk.w = pkbf(st[8 * sp + 6], st[8 * sp + 7]);
            pf[sp] = __builtin_bit_cast(bf16x8, pk); }
#pragma unroll
        for (int c = 0; c < 4; ++c) { u32x4v pk; pk.x = pkbf(vraw[c * 8], vraw[c * 8 + 1]); pk.y = pkbf(vraw[c * 8 + 2], vraw[c * 8 + 3]); pk.z = pkbf(vraw[c * 8 + 4], vraw[c * 8 + 5]); pk.w = pkbf(vraw[c * 8 + 6], vraw[c * 8 + 7]);
            ot[c] = __builtin_amdgcn_mfma_f32_32x32x16_bf16(__builtin_bit_cast(bf16x8, pk), pf[0], ot[c], 0, 0, 0); }
#pragma unroll
        for (int c = 0; c < 4; ++c) { u32x4v pk; pk.x = pkbf(vraw2[c * 8], vraw2[c * 8 + 1]); pk.y = pkbf(vraw2[c * 8 + 2], vraw2[c * 8 + 3]); pk.z = pkbf(vraw2[c * 8 + 4], vraw2[c * 8 + 5]); pk.w = pkbf(vraw2[c * 8 + 6], vraw2[c * 8 + 7]);
            ot[c] = __builtin_amdgcn_mfma_f32_32x32x16_bf16(__builtin_bit_cast(bf16x8, pk), pf[1], ot[c], 0, 0, 0); }
    }
    lrun = sum_halves(lrun);
    LAS float* SM_M = (LAS float*)(L + RING_OFF);
    LAS float* SM_R = (LAS float*)(L + RING_OFF + 1024);
    LAS float* SM_O = (LAS float*)(L + RING_OFF + 1024 + 4 * 64 * 65 * 4);
    if (hi == 0) SM_M[wave * 32 + r] = mrun;
    __syncthreads();
    float mfin = SM_M[r];
#pragma unroll
    for (int w2 = 1; w2 < 8; ++w2) mfin = fmaxf(mfin, SM_M[w2 * 32 + r]);
    { const float sc = __builtin_amdgcn_exp2f(mrun - mfin); lrun *= sc;
#pragma unroll
      for (int c = 0; c < 4; ++c) ot[c] = ot[c] * sc; }
#pragma unroll
    for (int step = 4; step >= 1; step >>= 1) {
        if (wave >= step && wave < 2 * step) { LAS float* dst = SM_R + ((wave - step) * 64 + lane) * 65; dst[64] = lrun;
#pragma unroll
            for (int c = 0; c < 4; ++c)
#pragma unroll
                for (int q = 0; q < 16; ++q) dst[c * 16 + q] = ot[c][q]; }
        __syncthreads();
        if (wave < step) { const LAS float* src = SM_R + (wave * 64 + lane) * 65; lrun += src[64];
#pragma unroll
            for (int c = 0; c < 4; ++c)
#pragma unroll
                for (int q = 0; q < 16; ++q) ot[c][q] += src[c * 16 + q]; }
        __syncthreads();
    }
    if (wave == 0) { const float il = 1.f / lrun;
#pragma unroll
        for (int c = 0; c < 4; ++c)
#pragma unroll
            for (int q = 0; q < 16; ++q) SM_O[r * 129 + 32 * c + crow16(q, hi)] = ot[c][q] * il; }
    __syncthreads();
    {
        const float* LAM = (const float*)(P.ws + WS_LAM); const float lam = LAM[layer], li = LAM[4 + layer];
        const int q = tid >> 5, vd0 = (tid & 31) * 4;
        float a[4]; float ss = 0.f;
#pragma unroll
        for (int k = 0; k < 4; ++k) { a[k] = SM_O[q * 129 + vd0 + k] - lam * SM_O[(q + 16) * 129 + vd0 + k]; ss += a[k] * a[k]; }
        ss += xor_swz<1>(ss); ss += xor_swz<2>(ss); ss += xor_swz<4>(ss); ss += xor_swz<8>(ss); ss += xor_swz<16>(ss);
        const float rr = (1.f - li) / sqrtf(ss * (1.f / 128.f) + RMS_EPS);
        const size_t base = (size_t)(MP + b * 16 + q) * 1024 + h * 128 + vd0;
        const f32x4 sl = *(const f32x4*)(P.in[I_SUBLN] + (size_t)layer * 128 + vd0);
        const u32x2 gt = *(const u32x2*)((const bf16_t*)(P.ws + WS_SAG) + base);
        u32x2 o; o.x = pkbf(a[0] * rr * sl[0] * bflo(gt.x), a[1] * rr * sl[1] * bfhi(gt.x)); o.y = pkbf(a[2] * rr * sl[2] * bflo(gt.y), a[3] * rr * sl[3] * bfhi(gt.y));
        *(u32x2*)((bf16_t*)(P.ws + WS_YB) + base) = o;
    }
    __syncthreads();
}

__global__ void __launch_bounds__(NWAVES * 64, 2) mk_fwd(Params P) {
    extern __shared__ __attribute__((aligned(16))) unsigned char lds[];
    LAS unsigned char* L = (LAS unsigned char*)lds;
    const int wave = __builtin_amdgcn_readfirstlane(threadIdx.x >> 6);
    const int G = gridDim.x, bx = blockIdx.x, vcu = (G % 8 == 0) ? (bx % 8) * (G / 8) + bx / 8 : bx;
    const int gw = vcu * NWAVES + wave, NGW = G * NWAVES;
    for (int u = fresh_tid(wave); u < (LDS_BYTES - LDSCTL_OFF) / 4; u += NWAVES * 64) ((LAS unsigned*)(L + LDSCTL_OFF))[u] = 0u;
    __syncthreads();
    unsigned char* ws = P.ws;
    XcdBarrier bar = xcd_barrier_post((unsigned*)(ws + WS_CTL) + CW_BAR + P.bar_region * XCD_BAR_WORDS, (volatile LAS unsigned*)(L + MISC_OFF) + 8);
    bf16_t* WinT = (bf16_t*)(ws + WS_WIN); bf16_t* WaT = (bf16_t*)(ws + WS_WA); bf16_t* WbT = (bf16_t*)(ws + WS_WB); bf16_t* WoT = (bf16_t*)(ws + WS_WO); bf16_t* WpT = (bf16_t*)(ws + WS_WP);
    float* X = (float*)(ws + WS_X); bf16_t* XB = (bf16_t*)(ws + WS_XB);
    float* ropec = (float*)(ws + WS_ROPEC); float* ropes = (float*)(ws + WS_ROPES);

#ifndef NO_P0
    if (P.do_pro) for (int rp_ = 0; rp_ < REP_P0; ++rp_) {
        const int tid = fresh_tid(wave), lane = tid & 63;
        LAS float* scr = (LAS float*)(L + RING_OFF + wave * 16384);
        constexpr int I_IN = 16 * (D_IN / 32), I_A = 8 * 32, I_B = 16 * 32, I_P = 2 * 4;
        constexpr int N_IN = DEPTH * I_IN, N_A = DEPTH * I_A, N_B = DEPTH * I_B, N_P = DEPTH * 4 * I_P;
        constexpr int NITEMS = N_IN + N_A + 2 * N_B + N_P;
        for (int it = gw; it < NITEMS; it += NGW) {
            int rr = it;
            if (rr < N_IN) { const int l = rr / I_IN; p0_transpose_item<1>(P.in[I_WIN] + (size_t)l * 1024 * D_IN, 1024, D_IN, WinT + (size_t)l * D_IN * 1024, scr, rr % I_IN, lane); continue; } rr -= N_IN;
            if (rr < N_A) { const int l = rr / I_A; p0_transpose_item<0>(P.in[I_WA] + (size_t)l * 512 * 1024, 512, 1024, WaT + (size_t)l * 1024 * 512, scr, rr % I_A, lane); continue; } rr -= N_A;
            if (rr < N_B) { const int l = rr / I_B; p0_transpose_item<0>(P.in[I_WB] + (size_t)l * 1024 * 1024, 1024, 1024, WbT + (size_t)l * 1024 * 1024, scr, rr % I_B, lane); continue; } rr -= N_B;
            if (rr < N_B) { const int l = rr / I_B; p0_transpose_item<0>(P.in[I_WO] + (size_t)l * 1024 * 1024, 1024, 1024, WoT + (size_t)l * 1024 * 1024, scr, rr % I_B, lane); continue; } rr -= N_B;
            { const int lg = rr / I_P; p0_transpose_item<0>(P.in[I_WPOOL] + (size_t)lg * 128 * 128, 128, 128, WpT + (size_t)lg * 128 * 128, scr, rr % I_P, lane); }
        }
        for (int e = gw * 64 + lane; e < SEQ * 32; e += NGW * 64) {
            const int pos = e >> 5, i = e & 31;
            const double inv = exp(-(double)i * (9.210340371976184 / 32.0)), ang = (double)pos * inv;
            ropec[e] = (float)cos(ang); ropes[e] = (float)sin(ang);
        }
        if (bx == 0 && tid < DEPTH) {
            const float* lq = P.in[I_LQK] + tid * 256; float s1 = 0.f, s2 = 0.f;
            for (int i = 0; i < 64; ++i) { s1 += lq[i] * lq[64 + i]; s2 += lq[128 + i] * lq[192 + i]; }
            const float li = 0.8f - 0.6f * expf(-0.3f * (float)tid);
            float* LAM = (float*)(ws + WS_LAM); LAM[tid] = expf(s1) - expf(s2) + li; LAM[4 + tid] = li;
        }
        for (int m = gw; m < M; m += NGW) {
            const float* xr = (m < MP) ? P.in[I_XP] + (size_t)m * 1024 : P.in[I_XS] + (size_t)(m - MP) * 1024;
            ln_row(xr, P.in[I_LIG], P.in[I_LIB], X + (size_t)m * 1024, XB + (size_t)m * 1024);
        }
        xcd_barrier(bar);
    }
#endif

    for (int l = P.l_lo; l < P.l_hi; ++l) {
#ifndef NO_P1
        for (int rp_ = 0; rp_ < REP_P1; ++rp_) {
            if (rp_) xcd_barrier(bar);
            pg8::Gemm g{XB, WinT + (size_t)l * D_IN * 1024, M, D_IN, 1024}; pg8::StaticOrder S; S.init(M, D_IN, G, bx);
            EpiIn E{(bf16_t*)(ws + WS_PXB), (bf16_t*)(ws + WS_SPG), (bf16_t*)(ws + WS_QB), (bf16_t*)(ws + WS_KB), (bf16_t*)(ws + WS_VB), (bf16_t*)(ws + WS_SAG), (bf16_t*)(ws + WS_SGA), (bf16_t*)(ws + WS_SGB),
                    P.out, ropec, ropes, l};
            pg8::gemm_phase<EpiIn, pg8::StaticOrder, true, true>(L + RING_OFF, g, S, E, wave);
        }
#endif
        xcd_barrier(bar);
#ifndef NO_SAMPLE
        for (int rp_ = 0; rp_ < REP_SAMPLE; ++rp_)
        for (int su = vcu; su < DEC_BATCH * 8; su += G) sample_unit(su >> 3, su & 7, l, P, L, wave);
#endif
#ifndef NO_POOL
        for (int rp_ = 0; rp_ < REP_POOL; ++rp_)
        for (int it = gw; it < POOL_NITEMS; it += NGW) pool_item(it, l, P, L + RING_OFF + wave * POOL_TILE_BYTES);
        __syncthreads();
#endif
#ifndef NO_ATTN
        for (int rp_ = 0; rp_ < REP_ATTN; ++rp_)
        for (int su = vcu; su < 256; su += G) {
            const int bh = su >> 2, s4 = su & 3, b = bh >> 3, h = bh & 7;
            const size_t bo = (size_t)b * SEQ * 1024 + h * 128;
            for (int i = 0; i < 4; ++i) {
                const int qb = (i == 0) ? s4 : (i == 1) ? 7 - s4 : (i == 2) ? 8 + s4 : 15 - s4;
                for (int mp = 0; mp < 2; ++mp)
                    attn_body::attn_unit128<8>(qb, (const attn_body::bf16*)(ws + WS_QB) + bo + mp * 64, (const attn_body::bf16*)(ws + WS_KB) + bo + mp * 64,
                                               (const attn_body::bf16*)(ws + WS_VB) + bo, (float*)(ws + (mp ? WS_O2 : WS_O1)) + bo, (char*)lds + RING_OFF, wave);
                asm volatile("s_waitcnt vmcnt(0)" ::: "memory"); __syncthreads();
                combine_rows((size_t)b * SEQ + (size_t)qb * 256, h, l, P, wave);
            }
        }
#endif
        xcd_barrier(bar);
#ifndef NO_P3
        for (int rp_ = 0; rp_ < REP_P3; ++rp_) {
        if (rp_) xcd_barrier(bar);
        {
            pg8::Gemm g{(const bf16_t*)(ws + WS_YA), WaT + (size_t)l * 1024 * 512, M, 1024, 512}; pg8::StaticOrder S; S.init(M, 1024, G, bx);
            EpiMergeA E{(const bf16_t*)(ws + WS_SGA), (float*)(ws + WS_TMPA)};
            pg8::gemm_phase<EpiMergeA, pg8::StaticOrder, true, true>(L + RING_OFF, g, S, E, wave);
        }
        {
            pg8::Gemm g{(const bf16_t*)(ws + WS_YB), WbT + (size_t)l * 1024 * 1024, M, 1024, 1024}; pg8::StaticOrder S; S.init(M, 1024, G, bx);
            EpiMergeB E{(const bf16_t*)(ws + WS_SGB), (const float*)(ws + WS_TMPA), (bf16_t*)(ws + WS_MG)};
            pg8::gemm_phase<EpiMergeB, pg8::StaticOrder, true, true>(L + RING_OFF, g, S, E, wave);
        }
        }
#endif
        xcd_barrier(bar);
#ifndef NO_P4
        {
            pg8::Gemm g{(const bf16_t*)(ws + WS_MG), WoT + (size_t)l * 1024 * 1024, M, 1024, 1024}; pg8::StaticOrder S; S.init(M, 1024, G, bx);
            EpiOut E{X};
            pg8::gemm_phase<EpiOut, pg8::StaticOrder, true, true>(L + RING_OFF, g, S, E, wave);
        }
#endif
        xcd_barrier(bar);
        {
            float* dst = (l == DEPTH - 1) ? P.out + O_Y : X;
            for (int m = gw; m < M; m += NGW) ln_row(X + (size_t)m * 1024, P.in[I_LNG] + (size_t)l * 1024, P.in[I_LNB] + (size_t)l * 1024, dst + (size_t)m * 1024, XB + (size_t)m * 1024);
        }
        if (l + 1 < P.l_hi) xcd_barrier(bar);
    }
}
static int mk_grid_setup() {
    static int grid = 0;
    if (grid == 0) {
        int dev = 0, cus = 0;
        if (hipGetDevice(&dev) != hipSuccess || hipDeviceGetAttribute(&cus, hipDeviceAttributeMultiprocessorCount, dev) != hipSuccess || cus < 8) { fprintf(stderr, "kernel_launch: device query failed\n"); grid = -1; return grid; }
        if (hipFuncSetAttribute((const void*)mk_fwd, hipFuncAttributeMaxDynamicSharedMemorySize, LDS_BYTES) != hipSuccess) { fprintf(stderr, "kernel_launch: hipFuncSetAttribute failed\n"); grid = -1; return grid; }
        int per_cu = 0;
        if (hipOccupancyMaxActiveBlocksPerMultiprocessor(&per_cu, (const void*)mk_fwd, NWAVES * 64, LDS_BYTES) != hipSuccess || per_cu < 1) fprintf(stderr, "kernel_launch: occupancy query reports %d\n", per_cu);
        (void)hipGetLastError();
        grid = cus;
    }
    return grid;
}
static void mk_launch(void* const* d_in, float* out, void* d_ws, int l_lo, int l_hi, int do_pro, int region, hipStream_t stream) {
    const int grid = mk_grid_setup(); if (grid < 0) return;
    Params p{};
    for (int i = 0; i < 17; ++i) p.in[i] = (const float*)d_in[i];
    p.out = out; p.ws = (unsigned char*)d_ws; p.l_lo = l_lo; p.l_hi = l_hi; p.do_pro = do_pro; p.bar_region = region;
    hipLaunchKernelGGL(mk_fwd, dim3(grid), dim3(NWAVES * 64), LDS_BYTES, stream, p);
    const hipError_t le = hipPeekAtLastError();
    if (le != hipSuccess) fprintf(stderr, "kernel_launch: launch failed: %s\n", hipGetErrorName(le));
}

#if !DEBUG_CHECK
extern "C" void kernel_launch(void* const* d_in, const int* in_sizes, int n_in, void* d_out, int out_size, void* d_ws, size_t ws_size, hipStream_t stream) {
    if (n_in != 17 || (size_t)out_size != O_END || ws_size < WS_END || in_sizes[0] != MP * 1024) { fprintf(stderr, "kernel_launch: unexpected sizes n_in %d out %d ws %zu\n", n_in, out_size, ws_size); return; }
    if (hipMemsetAsync((char*)d_ws + WS_CTL, 0, CTL_ZERO_BYTES, stream) != hipSuccess) return;
    mk_launch(d_in, (float*)d_out, d_ws, 0, DEPTH, 1, 0, stream);
}
#else
constexpr int C_PX = 0, C_PG = 512, C_Q = 1024, C_K = 2048, C_V = 3072, C_AG = 4096, C_GA = 5120, C_GB = 6144;
__device__ __forceinline__ float silu_f(float x) { return x / (1.f + __expf(-x)); }
__device__ __forceinline__ float sigmoid_f(float x) { return 1.f / (1.f + __expf(-x)); }
__global__ void __launch_bounds__(256) nv_ln(const float* in, const float* add, float alpha, const float* g, const float* b, float* out, int rows) {
    const int row = blockIdx.x * 4 + (threadIdx.x >> 6), lane = threadIdx.x & 63;
    if (row >= rows) return;
    const float4* xi = (const float4*)(in + (size_t)row * 1024) + lane;
    float4 v[4]; float s = 0.f;
#pragma unroll
    for (int j = 0; j < 4; ++j) {
        v[j] = xi[64 * j];
        if (add) { const float4 a = ((const float4*)(add + (size_t)row * 1024) + lane)[64 * j]; v[j].x = alpha * v[j].x + a.x; v[j].y = alpha * v[j].y + a.y; v[j].z = alpha * v[j].z + a.z; v[j].w = alpha * v[j].w + a.w; }
        s += (v[j].x + v[j].y) + (v[j].z + v[j].w);
    }
    const float mean = wave_sum(s) * (1.f / 1024.f); float s2 = 0.f;
#pragma unroll
    for (int j = 0; j < 4; ++j) { v[j].x -= mean; v[j].y -= mean; v[j].z -= mean; v[j].w -= mean; s2 += (v[j].x * v[j].x + v[j].y * v[j].y) + (v[j].z * v[j].z + v[j].w * v[j].w); }
    const float rstd = 1.f / sqrtf(wave_sum(s2) * (1.f / 1024.f) + LN_EPS);
    float4* o = (float4*)(out + (size_t)row * 1024) + lane;
#pragma unroll
    for (int j = 0; j < 4; ++j) { const float4 gg = ((const float4*)g + lane)[64 * j], bb = ((const float4*)b + lane)[64 * j];
        float4 r; r.x = v[j].x * rstd * gg.x + bb.x; r.y = v[j].y * rstd * gg.y + bb.y; r.z = v[j].z * rstd * gg.z + bb.z; r.w = v[j].w * rstd * gg.w + bb.w; o[64 * j] = r; }
}
__global__ void __launch_bounds__(256) nv_gemm(const float* __restrict__ A, int lda, const float* __restrict__ W, int ldw, float* __restrict__ C, int ldc, int K) {
    __shared__ float As[8][132];
    __shared__ float Ws[8][128];
    const int bm = blockIdx.y * 128, bn = blockIdx.x * 128, tid = threadIdx.x, tx = tid & 15, ty = tid >> 4;
    float acc[8][8];
#pragma unroll
    for (int i = 0; i < 8; ++i)
#pragma unroll
        for (int j = 0; j < 8; ++j) acc[i][j] = 0.f;
    const float* Ap = A + (size_t)(bm + (tid >> 1)) * lda + (tid & 1) * 4;
    const float* Wp = W + (size_t)(tid >> 5) * ldw + bn + (tid & 31) * 4;
    for (int k0 = 0; k0 < K; k0 += 8) {
        const float4 a = *(const float4*)(Ap + k0);
        const float4 w = *(const float4*)(Wp + (size_t)k0 * ldw);
        As[(tid & 1) * 4 + 0][tid >> 1] = a.x; As[(tid & 1) * 4 + 1][tid >> 1] = a.y; As[(tid & 1) * 4 + 2][tid >> 1] = a.z; As[(tid & 1) * 4 + 3][tid >> 1] = a.w;
        *(float4*)&Ws[tid >> 5][(tid & 31) * 4] = w;
        __syncthreads();
#pragma unroll
        for (int kk = 0; kk < 8; ++kk) {
            float av[8], bv[8];
#pragma unroll
            for (int i = 0; i < 8; ++i) av[i] = As[kk][ty * 8 + i];
#pragma unroll
            for (int j = 0; j < 8; ++j) bv[j] = Ws[kk][tx * 8 + j];
#pragma unroll
            for (int i = 0; i < 8; ++i)
#pragma unroll
                for (int j = 0; j < 8; ++j) acc[i][j] += av[i] * bv[j];
        }
        __syncthreads();
    }
#pragma unroll
    for (int i = 0; i < 8; ++i) {
        float* cp = C + (size_t)(bm + ty * 8 + i) * ldc + bn + tx * 8;
        *(float4*)cp = make_float4(acc[i][0], acc[i][1], acc[i][2], acc[i][3]);
        *(float4*)(cp + 4) = make_float4(acc[i][4], acc[i][5], acc[i][6], acc[i][7]);
    }
}
__global__ void nv_lambda(const float* lq, float* lam) {
    const int l = threadIdx.x;
    if (l < DEPTH) {
        float s1 = 0.f, s2 = 0.f;
        for (int i = 0; i < 64; ++i) { s1 += lq[l * 256 + i] * lq[l * 256 + 64 + i]; s2 += lq[l * 256 + 128 + i] * lq[l * 256 + 192 + i]; }
        const float li = 0.8f - 0.6f * expf(-0.3f * (float)l);
        lam[l] = expf(s1) - expf(s2) + li; lam[4 + l] = li;
    }
}
__global__ void __launch_bounds__(256) nv_rope_split(float* H, float* out, int layer) {
    const int row = blockIdx.x;
    const bool samp = row >= MP;
    const int pos = samp ? PAST + ((row - MP) & 15) : (row & (SEQ - 1));
    float* h = H + (size_t)row * D_IN;
    float* ko = samp ? out + O_KS + ((size_t)layer * MS + (row - MP)) * 1024 : out + O_KP + ((size_t)layer * MP + row) * 1024;
    float* vo = samp ? out + O_VS + ((size_t)layer * MS + (row - MP)) * 1024 : out + O_VP + ((size_t)layer * MP + row) * 1024;
    for (int p = threadIdx.x; p < 1024; p += 256) {
        const int pp = p & 511, blk = pp >> 5, i = pp & 31;
        const int c = (p < 512 ? C_Q : C_K) + blk * 64 + i;
        const double inv = exp(-(double)i / 32.0 * 9.210340371976184);
        const double ang = (double)pos * inv;
        const float cs = (float)cos(ang), sn = (float)sin(ang);
        const float x1 = h[c], x2 = h[c + 32];
        const float r1 = x1 * cs - x2 * sn, r2 = x2 * cs + x1 * sn;
        h[c] = r1; h[c + 32] = r2;
        if (p >= 512) { ko[blk * 64 + i] = r1; ko[blk * 64 + i + 32] = r2; }
    }
    for (int c = threadIdx.x; c < 1024; c += 256) vo[c] = h[C_V + c];
    if (!samp) { const int t = row & (SEQ - 1), b = row >> 12;
        if (t >= SEQ - 15) { float* po = out + O_PP + (((size_t)layer * BATCH + b) * 15 + (t - (SEQ - 15))) * 512; for (int c = threadIdx.x; c < 512; c += 256) po[c] = h[C_PX + c]; }
    } else { const int j = (row - MP) & 15, b = (row - MP) >> 4;
        if (j >= 1) { float* po = out + O_PS + (((size_t)layer * DEC_BATCH + b) * 15 + (j - 1)) * 512; for (int c = threadIdx.x; c < 512; c += 256) po[c] = h[C_PX + c]; }
    }
}
__global__ void __launch_bounds__(256) nv_pool(const float* H, const float* state_pool_l, float* pooled) {
    const int row = blockIdx.x;
    const bool samp = row >= MP;
    for (int c = threadIdx.x; c < 512; c += 256) {
        const int g = c >> 7, w = 2 << g;
        float s = 0.f; int cnt;
        if (!samp) { const int t = row & (SEQ - 1); cnt = (t + 1 < w) ? t + 1 : w;
            for (int d = 0; d < cnt; ++d) s += H[(size_t)(row - d) * D_IN + C_PX + c];
        } else { const int j = (row - MP) & 15, b = (row - MP) >> 4; cnt = w;
            for (int d = 0; d < w; ++d) { const int jj = j - d;
                s += (jj >= 0) ? H[(size_t)(row - d) * D_IN + C_PX + c] : state_pool_l[((size_t)b * 15 + (15 + jj)) * 512 + c]; }
        }
        pooled[(size_t)row * 512 + c] = s / (float)cnt - H[(size_t)row * D_IN + C_PX + c];
    }
}
__global__ void __launch_bounds__(256) nv_ya_gate(float* ya, const float* H, const float* pool_scale_l) {
    const int row = blockIdx.x;
    for (int c = threadIdx.x; c < 512; c += 256) ya[(size_t)row * 512 + c] *= pool_scale_l[c] * silu_f(H[(size_t)row * D_IN + C_PG + c]);
}
__global__ void __launch_bounds__(64) nv_attn(const float* __restrict__ H, int rowbase0, int rows_per_batch, int nq,
                                             const float* __restrict__ cK, const float* __restrict__ cV, int n1, int causal, float* O1, float* O2) {
    __shared__ float Ks[16][64];
    __shared__ float Vs[16][128];
    const int qb = blockIdx.x, hm = blockIdx.y, b = blockIdx.z, h = hm >> 1, mp = hm & 1, t = threadIdx.x;
    const int rowb = rowbase0 + b * rows_per_batch;
    const int qrow = rowb + qb * 64 + t;
    const bool act = t < nq;
    float q[64];
#pragma unroll
    for (int d = 0; d < 64; ++d) q[d] = act ? H[(size_t)qrow * D_IN + C_Q + h * 128 + mp * 64 + d] * 0.125f : 0.f;
    float o[128];
#pragma unroll
    for (int d = 0; d < 128; ++d) o[d] = 0.f;
    float mx = -INFINITY, l = 0.f;
    const int n2 = causal ? (qb + 1) * 64 : rows_per_batch;
    const int ntot = n1 + n2;
    for (int k0 = 0; k0 < ntot; k0 += 16) {
        __syncthreads();
#pragma unroll
        for (int i = 0; i < 16; ++i) { const int idx = i * 64 + t, kj = idx >> 6, d = idx & 63, key = k0 + kj;
            float v = 0.f;
            if (key < ntot) v = (key < n1) ? cK[((size_t)b * n1 + key) * 1024 + h * 128 + mp * 64 + d] : H[(size_t)(rowb + key - n1) * D_IN + C_K + h * 128 + mp * 64 + d];
            Ks[kj][d] = v; }
#pragma unroll
        for (int i = 0; i < 32; ++i) { const int idx = i * 64 + t, kj = idx >> 7, d = idx & 127, key = k0 + kj;
            float v = 0.f;
            if (key < ntot) v = (key < n1) ? cV[((size_t)b * n1 + key) * 1024 + h * 128 + d] : H[(size_t)(rowb + key - n1) * D_IN + C_V + h * 128 + d];
            Vs[kj][d] = v; }
        __syncthreads();
        const int kend = (ntot - k0 < 16) ? ntot - k0 : 16;
        for (int kj = 0; kj < kend; ++kj) {
            float s = 0.f;
#pragma unroll
            for (int d = 0; d < 64; ++d) s += q[d] * Ks[kj][d];
            const float mn = fmaxf(mx, s), f = __expf(mx - mn), p = __expf(s - mn);
            l = l * f + p; mx = mn;
#pragma unroll
            for (int d = 0; d < 128; ++d) o[d] = o[d] * f + p * Vs[kj][d];
        }
    }
    if (act) { float* O = (mp ? O2 : O1) + (size_t)qrow * 1024 + h * 128; const float il = 1.f / l;
#pragma unroll
        for (int d = 0; d < 128; d += 4) *(float4*)(O + d) = make_float4(o[d] * il, o[d + 1] * il, o[d + 2] * il, o[d + 3] * il); }
}
__global__ void __launch_bounds__(256) nv_combine(const float* O1, const float* O2, const float* lam, int layer, const float* subln_l, const float* H, float* YB) {
    const int idx = blockIdx.x * 4 + (threadIdx.x >> 6), lane = threadIdx.x & 63;
    const int row = idx >> 3, h = idx & 7;
    const float lm = lam[layer], li = lam[4 + layer];
    const size_t base = (size_t)row * 1024 + h * 128;
    const float a0 = O1[base + lane] - lm * O2[base + lane], a1 = O1[base + 64 + lane] - lm * O2[base + 64 + lane];
    const float ms = wave_sum(a0 * a0 + a1 * a1) * (1.f / 128.f);
    const float r = 1.f / sqrtf(ms + RMS_EPS) * (1.f - li);
    YB[base + lane] = a0 * r * subln_l[lane] * silu_f(H[(size_t)row * D_IN + C_AG + h * 128 + lane]);
    YB[base + 64 + lane] = a1 * r * subln_l[64 + lane] * silu_f(H[(size_t)row * D_IN + C_AG + h * 128 + 64 + lane]);
}
__global__ void __launch_bounds__(256) nv_merge(float* TA, const float* TB, const float* H) {
    const int row = blockIdx.x;
    for (int c = threadIdx.x; c < 1024; c += 256) { const size_t i = (size_t)row * 1024 + c;
        TA[i] = sigmoid_f(H[(size_t)row * D_IN + C_GA + c]) * TA[i] + sigmoid_f(H[(size_t)row * D_IN + C_GB + c]) * TB[i]; }
}
__global__ void __launch_bounds__(256) dbg_cmp(const void* a, int a_bf16, int lda, const float* b, int ldb, int rows, int cols, float ascale, int bact, float* err, int slot) {
    __shared__ float red[2][4];
    float num = 0.f, den = 0.f;
    const size_t n = (size_t)rows * cols;
    for (size_t i = (size_t)blockIdx.x * 256 + threadIdx.x; i < n; i += (size_t)gridDim.x * 256) {
        const size_t r = i / cols, c = i % cols;
        float av = a_bf16 ? __uint_as_float((unsigned)((const unsigned short*)a)[r * lda + c] << 16) : ((const float*)a)[r * lda + c];
        float bv = b[r * ldb + c];
        if (bact == 1) bv = silu_f(bv); else if (bact == 2) bv = sigmoid_f(bv);
        const float d = av * ascale - bv; num += d * d; den += bv * bv;
    }
    num = wave_sum(num); den = wave_sum(den);
    if ((threadIdx.x & 63) == 0) { red[0][threadIdx.x >> 6] = num; red[1][threadIdx.x >> 6] = den; }
    __syncthreads();
    if (threadIdx.x == 0) { atomicAdd(err + 2 * slot, red[0][0] + red[0][1] + red[0][2] + red[0][3]); atomicAdd(err + 2 * slot + 1, red[1][0] + red[1][1] + red[1][2] + red[1][3]); }
}
#ifndef DBG_SLOT
#define DBG_SLOT -1
#endif
__global__ void dbg_final(const float* err, int nslots, float tol, float* pool_sample, int n) {
    __shared__ float sc;
    if (threadIdx.x == 0) {
        float s = 1.f;
        if (DBG_SLOT >= 0) { const float e = err[2 * DBG_SLOT] / fmaxf(err[2 * DBG_SLOT + 1], 1e-30f); s = 1.f + sqrtf(fminf(e, 4.f)); }
        else { for (int i = 0; i < nslots; ++i) { const float e = err[2 * i] / fmaxf(err[2 * i + 1], 1e-30f); if (!(e <= tol)) { s = 1.f + 0.01f * (float)(i + 1); break; } } }
        sc = s;
    }
    __syncthreads();
    for (int i = blockIdx.x * 256 + threadIdx.x; i < n; i += gridDim.x * 256) pool_sample[i] *= sc;
}
#define NSLOT_L 24
extern "C" void kernel_launch(void* const* d_in, const int* in_sizes, int n_in, void* d_out, int out_size, void* d_ws, size_t ws_size, hipStream_t stream) {
    const float* x_prompt = (const float*)d_in[0]; const float* x_sample = (const float*)d_in[1];
    const float* cache_k = (const float*)d_in[2]; const float* cache_v = (const float*)d_in[3]; const float* state_pool = (const float*)d_in[4];
    const float* ln_in_g = (const float*)d_in[5]; const float* ln_in_b = (const float*)d_in[6]; const float* w_in = (const float*)d_in[7];
    const float* w_pool = (const float*)d_in[8]; const float* pool_scale = (const float*)d_in[9]; const float* lambda_qk = (const float*)d_in[10];
    const float* subln_w = (const float*)d_in[11]; const float* w_a = (const float*)d_in[12]; const float* w_b = (const float*)d_in[13];
    const float* w_o = (const float*)d_in[14]; const float* ln_g = (const float*)d_in[15]; const float* ln_b = (const float*)d_in[16];
    float* out = (float*)d_out;
    const size_t R = RB4;
    const size_t NV0 = 1300 * MiB;
    const size_t NV_END = NV0 + 4096 + R + (size_t)M * D_IN * 4 + 7 * R;
    const size_t OUT2 = NV_END;
    const size_t need = OUT2 + O_END * 4;
    if (n_in != 17 || (size_t)out_size != O_END || ws_size < need) { fprintf(stderr, "kernel_launch: unexpected sizes n_in %d out %d ws %zu need %zu\n", n_in, out_size, ws_size, need); return; }
    unsigned char* ws = (unsigned char*)d_ws;
    hipMemsetAsync(ws + WS_CTL, 0, CTL_ZERO_BYTES, stream);
    float* ERR = (float*)(ws + WS_CTL + 512 * 1024);
    float* LAM = (float*)(ws + NV0);
    float* X = (float*)(ws + NV0 + 4096);
    float* H = (float*)(ws + NV0 + 4096 + R);
    unsigned char* p = ws + NV0 + 4096 + R + (size_t)M * D_IN * 4;
    float* POOLED = (float*)p; float* YA = (float*)(p + R / 2);
    float* O1 = (float*)(p + R); float* O2 = (float*)(p + 2 * R); float* YB = (float*)(p + 3 * R);
    float* TA = (float*)(p + 4 * R); float* TB = (float*)(p + 5 * R); float* OUTB = (float*)(p + 6 * R);
    float* out2 = (float*)(ws + OUT2);
    const void* oXB = ws + WS_XB; const void* oPXB = ws + WS_PXB; const void* oSPG = ws + WS_SPG; const void* oQB = ws + WS_QB; const void* oKB = ws + WS_KB; const void* oVB = ws + WS_VB;
    const void* oSAG = ws + WS_SAG; const void* oSGA = ws + WS_SGA; const void* oSGB = ws + WS_SGB; const void* oO1 = ws + WS_O1; const void* oO2 = ws + WS_O2;
    const void* oYA = ws + WS_YA; const void* oYB = ws + WS_YB; const void* oMG = ws + WS_MG; const void* oX = ws + WS_X;
#define CMP(slot, a, abf, lda, b, ldb, rows, cols, asc, bact) dbg_cmp<<<1024, 256, 0, stream>>>(a, abf, lda, b, ldb, rows, cols, asc, bact, ERR, slot)

    nv_lambda<<<1, 64, 0, stream>>>(lambda_qk, LAM);
    nv_ln<<<MP / 4, 256, 0, stream>>>(x_prompt, nullptr, 1.f, ln_in_g, ln_in_b, X, MP);
    nv_ln<<<MS / 4, 256, 0, stream>>>(x_sample, nullptr, 1.f, ln_in_g, ln_in_b, X + (size_t)MP * 1024, MS);
    for (int l = 0; l < DEPTH; ++l) {
        const int s0 = l * NSLOT_L;
        mk_launch(d_in, out2, d_ws, l, l + 1, l == 0, l, stream);
        nv_gemm<<<dim3(D_IN / 128, M / 128), 256, 0, stream>>>(X, 1024, w_in + (size_t)l * 1024 * D_IN, D_IN, H, D_IN, 1024);
        nv_rope_split<<<M, 256, 0, stream>>>(H, out, l);
        nv_pool<<<M, 256, 0, stream>>>(H, state_pool + (size_t)l * DEC_BATCH * 15 * 512, POOLED);
        for (int g = 0; g < 4; ++g)
            nv_gemm<<<dim3(1, M / 128), 256, 0, stream>>>(POOLED + g * 128, 512, w_pool + ((size_t)l * 4 + g) * 128 * 128, 128, YA + g * 128, 512, 128);
        nv_ya_gate<<<M, 256, 0, stream>>>(YA, H, pool_scale + (size_t)l * 512);
        nv_attn<<<dim3(SEQ / 64, 16, BATCH), 64, 0, stream>>>(H, 0, SEQ, 64, nullptr, nullptr, 0, 1, O1, O2);
        nv_attn<<<dim3(1, 16, DEC_BATCH), 64, 0, stream>>>(H, MP, DEC_SEQ, DEC_SEQ, cache_k + (size_t)l * DEC_BATCH * PAST * 1024, cache_v + (size_t)l * DEC_BATCH * PAST * 1024, PAST, 0, O1, O2);
        nv_combine<<<M * 8 / 4, 256, 0, stream>>>(O1, O2, LAM, l, subln_w + (size_t)l * 128, H, YB);
        nv_gemm<<<dim3(1024 / 128, M / 128), 256, 0, stream>>>(YA, 512, w_a + (size_t)l * 512 * 1024, 1024, TA, 1024, 512);
        nv_gemm<<<dim3(1024 / 128, M / 128), 256, 0, stream>>>(YB, 1024, w_b + (size_t)l * 1024 * 1024, 1024, TB, 1024, 1024);
        nv_merge<<<M, 256, 0, stream>>>(TA, TB, H);
        nv_gemm<<<dim3(1024 / 128, M / 128), 256, 0, stream>>>(TA, 1024, w_o + (size_t)l * 1024 * 1024, 1024, OUTB, 1024, 1024);
        nv_ln<<<M / 4, 256, 0, stream>>>(X, OUTB, ALPHA, ln_g + (size_t)l * 1024, ln_b + (size_t)l * 1024, (l == DEPTH - 1) ? out + O_Y : X, M);
        CMP(s0 + 1, oPXB, 1, 512, H + C_PX, D_IN, M, 512, 1.f, 0);
        CMP(s0 + 2, oSPG, 1, 512, H + C_PG, D_IN, M, 512, 1.f, 1);
        CMP(s0 + 3, oVB, 1, 1024, H + C_V, D_IN, M, 1024, 1.f, 0);
        CMP(s0 + 4, oSAG, 1, 1024, H + C_AG, D_IN, M, 1024, 1.f, 1);
        CMP(s0 + 5, oSGA, 1, 1024, H + C_GA, D_IN, M, 1024, 1.f, 2);
        CMP(s0 + 6, oSGB, 1, 1024, H + C_GB, D_IN, M, 1024, 1.f, 2);
        CMP(s0 + 7, oKB, 1, 1024, H + C_K, D_IN, M, 1024, 1.f, 0);
        CMP(s0 + 8, oQB, 1, 1024, H + C_Q, D_IN, M, 1024, 1.f / C2, 0);
        CMP(s0 + 9, out2 + O_KP + (size_t)l * MP * 1024, 0, 1024, out + O_KP + (size_t)l * MP * 1024, 1024, MP, 1024, 1.f, 0);
        CMP(s0 + 10, out2 + O_VP + (size_t)l * MP * 1024, 0, 1024, out + O_VP + (size_t)l * MP * 1024, 1024, MP, 1024, 1.f, 0);
        CMP(s0 + 11, out2 + O_PP + (size_t)l * BATCH * 15 * 512, 0, 512, out + O_PP + (size_t)l * BATCH * 15 * 512, 512, BATCH * 15, 512, 1.f, 0);
        CMP(s0 + 12, out2 + O_KS + (size_t)l * MS * 1024, 0, 1024, out + O_KS + (size_t)l * MS * 1024, 1024, MS, 1024, 1.f, 0);
        CMP(s0 + 13, out2 + O_VS + (size_t)l * MS * 1024, 0, 1024, out + O_VS + (size_t)l * MS * 1024, 1024, MS, 1024, 1.f, 0);
        CMP(s0 + 14, out2 + O_PS + (size_t)l * DEC_BATCH * 15 * 512, 0, 512, out + O_PS + (size_t)l * DEC_BATCH * 15 * 512, 512, DEC_BATCH * 15, 512, 1.f, 0);
        CMP(s0 + 15, oYA, 1, 512, YA, 512, M, 512, 1.f, 0);
        CMP(s0 + 16, oO1, 0, 1024, O1, 1024, MP, 1024, 1.f, 0);
        CMP(s0 + 17, oO2, 0, 1024, O2, 1024, MP, 1024, 1.f, 0);
        CMP(s0 + 18, oYB, 1, 1024, YB, 1024, MP, 1024, 1.f, 0);
        CMP(s0 + 19, (const unsigned short*)oYB + (size_t)MP * 1024, 1, 1024, YB + (size_t)MP * 1024, 1024, MS, 1024, 1.f, 0);
        CMP(s0 + 20, oMG, 1, 1024, TA, 1024, M, 1024, 1.f, 0);
        CMP(s0 + 21, (l == DEPTH - 1) ? (const void*)(out2 + O_Y) : oX, 0, 1024, (l == DEPTH - 1) ? out + O_Y : X, 1024, M, 1024, 1.f, 0);
    }
    dbg_final<<<64, 256, 0, stream>>>(ERR, DEPTH * NSLOT_L, 1e-3f, out + O_PS, DEPTH * DEC_BATCH * 15 * 512);
}
#endif
```

```cpp
#include <hip/hip_runtime.h>
#include <hip/hip_bf16.h>
#include <cstdio>
#include <cstdint>
#include <cmath>

#ifndef DEBUG_CHECK
#define DEBUG_CHECK 0
#endif

constexpr int D_MODEL = 1024, BATCH = 8, SEQ = 4096, DEPTH = 4, DEC_BATCH = 32, DEC_SEQ = 16, PAST = 1024;
constexpr int D_POOL = 512, D_IN = 7168;
constexpr int MP = BATCH * SEQ, MS = DEC_BATCH * DEC_SEQ, M = MP + MS;
constexpr float LN_EPS = 1e-5f, RMS_EPS = 1e-5f;
constexpr float ALPHA = 1.681792830507429f;
constexpr float C2 = 0.125f * 1.4426950408889634f;
constexpr size_t O_Y = 0, O_KP = (size_t)M * 1024, O_VP = O_KP + (size_t)DEPTH * MP * 1024, O_PP = O_VP + (size_t)DEPTH * MP * 1024,
                 O_KS = O_PP + (size_t)DEPTH * BATCH * 15 * 512, O_VS = O_KS + (size_t)DEPTH * MS * 1024, O_PS = O_VS + (size_t)DEPTH * MS * 1024,
                 O_END = O_PS + (size_t)DEPTH * DEC_BATCH * 15 * 512;
constexpr size_t MiB = 1u << 20;
constexpr size_t RB2 = (size_t)M * 1024 * 2, RB4 = (size_t)M * 1024 * 4;
constexpr size_t WS_CTL = 0, CTL_ZERO_BYTES = 1 * MiB;
constexpr size_t WS_LAM = 1 * MiB;
constexpr size_t WS_ROPEC = 2 * MiB, WS_ROPES = WS_ROPEC + 512 * 1024;
constexpr size_t WS_WIN = 4 * MiB, WS_WAB = 60 * MiB  , WS_WO = 72 * MiB, WS_WP = 80 * MiB;
constexpr size_t WS_X = 96 * MiB;
constexpr size_t WS_XB = WS_X + RB4;
constexpr size_t WS_PXB = WS_XB + RB2;
constexpr size_t WS_SPG = WS_PXB + RB2 / 2;
constexpr size_t WS_QB = WS_SPG + RB2 / 2, WS_KB = WS_QB + RB2, WS_VB = WS_KB + RB2;
constexpr size_t WS_SAG = WS_VB + RB2, WS_SGA = WS_SAG + RB2, WS_SGB = WS_SGA + RB2;
constexpr size_t WS_O1 = WS_SGB + RB2, WS_O2 = WS_O1 + RB4;
constexpr size_t WS_YAB = WS_O2 + RB4;
constexpr size_t WS_RSB = WS_YAB + RB2 + RB2 / 2, WS_MG = WS_RSB + RB4;
constexpr size_t WS_END = WS_MG + RB2;
static_assert(WS_END <= 1300 * MiB && WS_WP + 512 * 1024 <= WS_X && WS_WIN + (size_t)DEPTH * D_IN * 1024 * 2 <= WS_WAB && WS_WAB + (size_t)DEPTH * 1024 * 1536 * 2 <= WS_WO, "d_ws map");
constexpr int CW_BAR = 4096;
constexpr int RING_OFF = 0, RING_BYTES = 131072;
constexpr int LDSCTL_OFF = RING_BYTES, MISC_OFF = LDSCTL_OFF + 320;
constexpr int LDS_BYTES = 147456;
constexpr int NWAVES = 8;
#ifndef REP_P0
#define REP_P0 1
#endif
#ifndef REP_P1
#define REP_P1 1
#endif
#ifndef REP_SAMPLE
#define REP_SAMPLE 1
#endif
#ifndef REP_POOL
#define REP_POOL 1
#endif
#ifndef REP_ATTN
#define REP_ATTN 1
#endif
#ifndef REP_P3
#define REP_P3 1
#endif
namespace pg8 {
#define PG8_LAS __attribute__((address_space(3)))
typedef unsigned short bf16_t;
typedef short bf16x8 __attribute__((ext_vector_type(8)));
typedef float f32x4 __attribute__((ext_vector_type(4)));
typedef unsigned u32x4 __attribute__((ext_vector_type(4)));
constexpr int BM = 256, BK = 64, HALF = 128, HTB = HALF * BK * 2  , STAGE_BYTES = 8 * HTB, NXCD = 8, WGM = 8;

__host__ __device__ __forceinline__ int lds_byte(int r, int c) { const int st = (r >> 4) * 2 + (c >> 5), rr = r & 15, cc = c & 31, ob = rr * 64 + cc * 2; return st * 1024 + (ob ^ (((ob >> 9) & 1) << 5)); }
__host__ __device__ __forceinline__ void stage_rc(int b, int& R, int& C) { const int st = b / 1024, sb = b % 1024, swz = sb ^ (((sb >> 9) & 1) << 5); R = (st >> 1) * 16 + swz / 64; C = (st & 1) * 32 + (swz % 64) / 2; }
__host__ __device__ __forceinline__ int perm32(int rho) { const int n = rho >> 4, i = rho & 15; return 8 * (i >> 2) + 4 * n + (i & 3); }

struct Unit { int pm, pn; };
struct Gemm { const bf16_t* A; const bf16_t* Bt; int M, N, K; };

struct StaticOrder {
    int nM, nN, nwg, G, c;
    __host__ __device__ void init(int M, int N, int G_, int c_) { nM = M / BM; nN = N / BM; nwg = nM * nN; G = G_; c = c_; }
    __host__ __device__ bool next(int i, Unit& u) const {
        const long L = (long)i * G + c; if (L >= nwg) return false;
        int wgid = (int)L; { const int q = nwg / NXCD, r = nwg % NXCD, xcd = wgid % NXCD, off = wgid / NXCD; wgid = (xcd < r ? xcd * (q + 1) : r * (q + 1) + (xcd - r) * q) + off; }
        const int nig = WGM * nN, gid = wgid / nig, fm = gid * WGM, gsz = (nM - fm) < WGM ? (nM - fm) : WGM;
        u.pm = fm + ((wgid % nig) % gsz); u.pn = (wgid % nig) / gsz; return true;
    }
    __device__ __forceinline__ void a_ready(const Unit&) const {}
    __device__ __forceinline__ void done(const Unit&) const {}
};

__device__ __forceinline__ unsigned cvt_pk_bf16(float lo, float hi) { unsigned r; asm volatile("v_cvt_pk_bf16_f32 %0, %1, %2" : "=v"(r) : "v"(lo), "v"(hi)); return r; }
typedef float f32x2 __attribute__((ext_vector_type(2)));
template <class Epi, class Sched, bool ALIGN_EPI = false, bool SP2 = false>
__device__ __forceinline__ void gemm_phase(PG8_LAS unsigned char* lds, const Gemm g, const Sched& S, const Epi& E, const int wave_id) {
    int tid_o; asm volatile("v_mbcnt_lo_u32_b32 %0, -1, 0\n\tv_mbcnt_hi_u32_b32 %0, -1, %0" : "=v"(tid_o)); tid_o += wave_id * 64;
    const int tid = tid_o, wid = __builtin_amdgcn_readfirstlane(tid >> 6), lane = tid & 63, wr = wid >> 2, wc = wid & 3, fr = lane & 15, fq = lane >> 4;
    const int K = g.K, nt = K / BK;
    unsigned voffA[2], voffB[2];
#pragma unroll
    for (int i = 0; i < 2; ++i) { int R, C; stage_rc(tid * 16 + i * 8192, R, C); const int Rb = Epi::PERM ? ((R & ~31) + perm32(R & 31)) : R;
        voffA[i] = (unsigned)(R * K + C) * 2u; voffB[i] = (unsigned)(Rb * K + C) * 2u; }
    const size_t kstep = (size_t)(BK * 2);
    const size_t hstep = (size_t)HALF * K * 2;
    const size_t tstep = 2 * hstep;
    const unsigned ldsw = (unsigned)wid * 1024u;
    const int aoff = lds_byte(wr * 64 + fr, fq * 8), boff = lds_byte(wc * 32 + fr, fq * 8);
#define PG8_SA(b, h) (((b) * 2 + (h)) * HTB)
#define PG8_SB(b, h) ((4 + (b) * 2 + (h)) * HTB)
#define PG8_STAGE(bufoff, gbase, voff) do { _Pragma("unroll") for (int _i = 0; _i < 2; ++_i) \
        __builtin_amdgcn_global_load_lds((const unsigned*)((const char*)(gbase) + (voff)[_i]), (PG8_LAS unsigned*)(lds + (bufoff) + ldsw + _i * 8192), 16, 0, 0); } while (0)
#define PG8_LDA(dst, b, h) do { _Pragma("unroll") for (int m = 0; m < 4; ++m) _Pragma("unroll") for (int k = 0; k < 2; ++k) dst[m][k] = *(const PG8_LAS bf16x8*)(lds + PG8_SA(b, h) + aoff + m * 2048 + k * 1024); } while (0)
#define PG8_LDB(dst, b, h) do { _Pragma("unroll") for (int n = 0; n < 2; ++n) _Pragma("unroll") for (int k = 0; k < 2; ++k) dst[n][k] = *(const PG8_LAS bf16x8*)(lds + PG8_SB(b, h) + boff + n * 2048 + k * 1024); } while (0)
#define PG8_MMA(ai, bj, At, Bt) do { __builtin_amdgcn_s_setprio(1); _Pragma("unroll") for (int m = 0; m < 4; ++m) _Pragma("unroll") for (int n = 0; n < 2; ++n) _Pragma("unroll") for (int k = 0; k < 2; ++k) \
        acc[ai][bj][m][n] = __builtin_amdgcn_mfma_f32_16x16x32_bf16(Bt[n][k], At[m][k], acc[ai][bj][m][n], 0, 0, 0); __builtin_amdgcn_s_setprio(0); } while (0)
#define PG8_WAIT_V(n) asm volatile("s_waitcnt vmcnt(" #n ")" ::: "memory")
#define PG8_WAIT_L(n) asm volatile("s_waitcnt lgkmcnt(" #n ")" ::: "memory")
#define PG8_BAR __builtin_amdgcn_s_barrier()
#define PG8_SCHED __builtin_amdgcn_sched_barrier(0)
    Unit cur, nxt; int ui = 0;
    if (!S.next(0, cur)) return;
    f32x4 acc[2][2][4][2];
#pragma unroll
    for (int a = 0; a < 2; ++a)
#pragma unroll
        for (int b = 0; b < 2; ++b)
#pragma unroll
            for (int m = 0; m < 4; ++m)
#pragma unroll
                for (int n = 0; n < 2; ++n) acc[a][b][m][n] = (f32x4){0.f, 0.f, 0.f, 0.f};
    bf16x8 At[4][2], B0[2][2], B1[2][2];
    const char* cA = (const char*)g.A + (size_t)cur.pm * tstep; const char* cB = (const char*)g.Bt + (size_t)cur.pn * tstep;
    S.a_ready(cur);
    if constexpr (SP2) {
        PG8_STAGE(PG8_SB(0, 0), cB, voffB); PG8_STAGE(PG8_SB(0, 1), cB + hstep, voffB); PG8_STAGE(PG8_SA(0, 0), cA, voffA); PG8_STAGE(PG8_SA(0, 1), cA + hstep, voffA);
        if (wr == 1) PG8_BAR;
        PG8_WAIT_V(2); PG8_BAR;
        PG8_STAGE(PG8_SB(1, 0), cB + kstep, voffB); PG8_STAGE(PG8_SA(1, 0), cA + kstep, voffA); PG8_STAGE(PG8_SB(1, 1), cB + hstep + kstep, voffB);
        PG8_WAIT_V(6); PG8_BAR;
    } else {
        PG8_STAGE(PG8_SB(0, 0), cB, voffB); PG8_STAGE(PG8_SA(0, 0), cA, voffA); PG8_STAGE(PG8_SB(0, 1), cB + hstep, voffB); PG8_STAGE(PG8_SA(0, 1), cA + hstep, voffA);
        if (wr == 1) PG8_BAR;
        PG8_WAIT_V(4); PG8_BAR;
        PG8_STAGE(PG8_SB(1, 0), cB + kstep, voffB); PG8_STAGE(PG8_SA(1, 0), cA + kstep, voffA); PG8_STAGE(PG8_SB(1, 1), cB + hstep + kstep, voffB);
        PG8_WAIT_V(6); PG8_BAR;
    }
    for (;;) {
        const bool has_next = S.next(ui + 1, nxt);
        const char* nA = has_next ? (const char*)g.A + (size_t)nxt.pm * tstep : cA; const char* nB = has_next ? (const char*)g.Bt + (size_t)nxt.pn * tstep : cB;
        for (int t = 0; t < nt; t += 2) {
            const bool last = (t == nt - 2);
            const char* a1 = cA + (size_t)(t + 1) * kstep;
            const char* a2 = last ? nA : cA + (size_t)(t + 2) * kstep; const char* b2 = last ? nB : cB + (size_t)(t + 2) * kstep;
            const char* a3 = a2 + kstep; const char* b3 = b2 + kstep;
            if (last && has_next) S.a_ready(nxt);
            if constexpr (Epi::MIDK > 0) { if (t == Epi::MIDK) E.mid(acc, cur, wr, wc, fr, fq); }
            if constexpr (SP2) {
            PG8_LDB(B0, 0, 0); PG8_LDB(B1, 0, 1); PG8_SCHED; PG8_LDA(At, 0, 0); PG8_STAGE(PG8_SA(1, 1), a1 + hstep, voffA);
            PG8_WAIT_V(8); PG8_WAIT_L(0); PG8_BAR; PG8_MMA(0, 0, At, B0); PG8_MMA(0, 1, At, B1); PG8_BAR; PG8_SCHED;
            PG8_LDA(At, 0, 1); PG8_STAGE(PG8_SB(0, 0), b2, voffB); PG8_STAGE(PG8_SB(0, 1), b2 + hstep, voffB); PG8_STAGE(PG8_SA(0, 0), a2, voffA);
            PG8_WAIT_V(8); PG8_WAIT_L(0); PG8_BAR; PG8_MMA(1, 0, At, B0); PG8_MMA(1, 1, At, B1); PG8_BAR; PG8_SCHED;
            PG8_LDB(B0, 1, 0); PG8_LDB(B1, 1, 1); PG8_SCHED; PG8_LDA(At, 1, 0); PG8_STAGE(PG8_SA(0, 1), a2 + hstep, voffA);
            PG8_WAIT_V(8); PG8_WAIT_L(0); PG8_BAR; PG8_MMA(0, 0, At, B0); PG8_MMA(0, 1, At, B1); PG8_BAR; PG8_SCHED;
            PG8_LDA(At, 1, 1); PG8_STAGE(PG8_SB(1, 0), b3, voffB); PG8_STAGE(PG8_SB(1, 1), b3 + hstep, voffB); PG8_STAGE(PG8_SA(1, 0), a3, voffA);
            PG8_WAIT_V(8); PG8_WAIT_L(0); PG8_BAR; PG8_MMA(1, 0, At, B0); PG8_MMA(1, 1, At, B1); PG8_BAR; PG8_SCHED;
            } else {
            PG8_LDB(B0, 0, 0); PG8_SCHED; PG8_LDA(At, 0, 0); PG8_STAGE(PG8_SA(1, 1), a1 + hstep, voffA);
            PG8_WAIT_L(8); PG8_BAR; PG8_WAIT_L(0); PG8_MMA(0, 0, At, B0); PG8_BAR; PG8_SCHED;
            PG8_LDB(B1, 0, 1); PG8_STAGE(PG8_SB(0, 0), b2, voffB);
            PG8_BAR; PG8_WAIT_L(0); PG8_MMA(0, 1, At, B1); PG8_BAR;
            PG8_LDA(At, 0, 1); PG8_STAGE(PG8_SA(0, 0), a2, voffA);
            PG8_BAR; PG8_WAIT_L(0); PG8_MMA(1, 0, At, B0); PG8_BAR; PG8_SCHED;
            PG8_STAGE(PG8_SB(0, 1), b2 + hstep, voffB);
            PG8_WAIT_V(6); PG8_BAR; PG8_MMA(1, 1, At, B1); PG8_BAR;
            PG8_LDB(B0, 1, 0); PG8_SCHED; PG8_LDA(At, 1, 0); PG8_STAGE(PG8_SA(0, 1), a2 + hstep, voffA);
            PG8_WAIT_L(8); PG8_BAR; PG8_WAIT_L(0); PG8_MMA(0, 0, At, B0); PG8_BAR; PG8_SCHED;
            PG8_LDB(B1, 1, 1); PG8_STAGE(PG8_SB(1, 0), b3, voffB);
            PG8_BAR; PG8_WAIT_L(0); PG8_MMA(0, 1, At, B1); PG8_BAR;
            PG8_LDA(At, 1, 1); PG8_STAGE(PG8_SA(1, 0), a3, voffA);
            PG8_BAR; PG8_WAIT_L(0); PG8_MMA(1, 0, At, B0); PG8_BAR; PG8_SCHED;
            PG8_STAGE(PG8_SB(1, 1), b3 + hstep, voffB);
            PG8_WAIT_V(6); PG8_BAR; PG8_MMA(1, 1, At, B1); PG8_BAR;
            }
        }
        if constexpr (ALIGN_EPI) { if (wr == 0) PG8_BAR; }
        if constexpr (!Epi::AFTER_DRAIN) { E(acc, cur, wr, wc, fr, fq); S.done(cur); }
        if (!has_next) break;
#pragma unroll
        for (int a = 0; a < 2; ++a)
#pragma unroll
            for (int b = 0; b < 2; ++b)
#pragma unroll
                for (int m = 0; m < 4; ++m)
#pragma unroll
                    for (int n = 0; n < 2; ++n) acc[a][b][m][n] = (f32x4){0.f, 0.f, 0.f, 0.f};
        cur = nxt; cA = nA; cB = nB; ++ui;
        if constexpr (ALIGN_EPI) { if (wr == 1) PG8_BAR; }
    }
    PG8_WAIT_V(0);
    if constexpr (!ALIGN_EPI) { if (wr == 0) PG8_BAR; }
    PG8_BAR;
    if constexpr (Epi::AFTER_DRAIN) { E.fused(acc, cur, wr, wc, fr, fq, lds, wid, lane); S.done(cur); }
#undef PG8_SA
#undef PG8_SB
#undef PG8_STAGE
#undef PG8_LDA
#undef PG8_LDB
#undef PG8_MMA
#undef PG8_WAIT_V
#undef PG8_WAIT_L
#undef PG8_BAR
#undef PG8_SCHED
}
}
#include <hip/hip_bf16.h>
#include <cmath>
namespace attn_body {
using bf16=__hip_bfloat16;
using bf16x8=__attribute__((ext_vector_type(8)))short;
using s16x4=__attribute__((ext_vector_type(4)))short;
using f32x16=__attribute__((ext_vector_type(16)))float;
using u32x4=__attribute__((ext_vector_type(4)))unsigned;
constexpr int D=64,DM=1024;
constexpr int NW=8,QBLK=32,QB=QBLK*NW,KVBLK=64;
constexpr int ATTN_PITCH=DM, ATTN_UNIT_ROWS=QB;
__device__ __forceinline__ int crow(int r,int hi){return (r&3)+8*(r>>2)+4*hi;}
#define SBAR() __builtin_amdgcn_sched_barrier(0)
__device__ __forceinline__ void cmask(f32x16&p0,f32x16&p1,int jb,int qchunk){
  const float NEG=-INFINITY;
  if(jb>qchunk){
  #pragma unroll
  for(int r=0;r<16;++r){p0[r]=NEG;p1[r]=NEG;} }
}
constexpr int NSLOT=3, SLOTB=8192;
constexpr int LDS_K=0, LDS_V=NSLOT*SLOTB, LDS_WS=2*NSLOT*SLOTB, LDS_OST=LDS_WS+NW*64*4, LDS_BYTES=LDS_OST+NW*8192;
constexpr float C2=0.125f*1.4426950408889634f;
__device__ __forceinline__ void glds16(const void*gsrc,unsigned lds_dst){unsigned keep;
  asm volatile("s_mov_b32 %0, m0\n\ts_mov_b32 m0, %2\n\ts_nop 0\n\tglobal_load_lds_dwordx4 %1, off\n\ts_mov_b32 m0, %0":"=&s"(keep):"v"(gsrc),"s"(lds_dst):"memory");}
__device__ __forceinline__ float max3f(float a,float b,float c){float r;asm("v_max3_f32 %0, %1, %2, %3":"=v"(r):"v"(a),"v"(b),"v"(c));return r;}
__device__ __forceinline__ float max2f(float a,float b){float r;asm("v_max_f32_e32 %0, %1, %2":"=v"(r):"v"(a),"v"(b));return r;}
__device__ __forceinline__ float fadd_s(float a,float b){float r;asm("v_add_f32_e32 %0, %1, %2":"=v"(r):"v"(a),"v"(b));return r;}
__device__ __forceinline__ float fsub_s(float a,float b){float r;asm("v_sub_f32_e32 %0, %1, %2":"=v"(r):"v"(a),"v"(b));return r;}
typedef float f32x2_t __attribute__((ext_vector_type(2))); typedef __bf16 bf16x2_t __attribute__((ext_vector_type(2)));
__device__ __forceinline__ unsigned cvtpk_s(float lo,float hi){f32x2_t v={lo,hi};bf16x2_t b=__builtin_convertvector(v,bf16x2_t);return __builtin_bit_cast(unsigned,b);}
#define WAIT_BAR(N) asm volatile("s_waitcnt vmcnt(" #N ") lgkmcnt(0)\n\ts_barrier":::"memory")

__device__ __forceinline__ void qkt(f32x16&p0,f32x16&p1,const char*Kslot,const bf16x8*qr,const f32x16&negm,int r32,int hi){
  const char*kb=Kslot+hi*1024+r32*16;
  #pragma unroll
  for(int d0=0;d0<4;++d0){
    const bf16x8 b0=*reinterpret_cast<const bf16x8*>(kb+d0*2048);
    const bf16x8 b1=*reinterpret_cast<const bf16x8*>(kb+d0*2048+512);
    if(d0==0){p0=__builtin_amdgcn_mfma_f32_32x32x16_bf16(b0,qr[0],negm,0,0,0);p1=__builtin_amdgcn_mfma_f32_32x32x16_bf16(b1,qr[0],negm,0,0,0);}
    else{p0=__builtin_amdgcn_mfma_f32_32x32x16_bf16(b0,qr[d0],p0,0,0,0);p1=__builtin_amdgcn_mfma_f32_32x32x16_bf16(b1,qr[d0],p1,0,0,0);}}
}
typedef __attribute__((address_space(3))) const char* lds_cptr;
typedef short v4i16_t __attribute__((ext_vector_type(4)));
__device__ __forceinline__ void kload8(bf16x8*kf,lds_cptr kp){
  kf[0]=*(const __attribute__((address_space(3))) bf16x8*)(kp);      kf[1]=*(const __attribute__((address_space(3))) bf16x8*)(kp+512);
  kf[2]=*(const __attribute__((address_space(3))) bf16x8*)(kp+2048); kf[3]=*(const __attribute__((address_space(3))) bf16x8*)(kp+2560);
  kf[4]=*(const __attribute__((address_space(3))) bf16x8*)(kp+4096); kf[5]=*(const __attribute__((address_space(3))) bf16x8*)(kp+4608);
  kf[6]=*(const __attribute__((address_space(3))) bf16x8*)(kp+6144); kf[7]=*(const __attribute__((address_space(3))) bf16x8*)(kp+6656);
}
__device__ __forceinline__ void kload2(bf16x8*kf,lds_cptr kp,int j){ kf[2*j]=*(const __attribute__((address_space(3))) bf16x8*)(kp+j*2048); kf[2*j+1]=*(const __attribute__((address_space(3))) bf16x8*)(kp+j*2048+512); }
__device__ __forceinline__ s16x4 vtr(lds_cptr p){ return __builtin_bit_cast(s16x4,__builtin_amdgcn_ds_read_tr16_b64_v4i16((__attribute__((address_space(3))) v4i16_t*)p)); }
__device__ __forceinline__ float rowmax(const f32x16&p0,const f32x16&p1){
  float a=max3f(p0[0],p0[1],p1[0]),b=max3f(p0[2],p0[3],p1[1]);a=max3f(a,p1[2],p1[3]);
  #pragma unroll
  for(int r=4;r<16;r+=4){a=max3f(a,p0[r],p0[r+1]);b=max3f(b,p0[r+2],p0[r+3]);a=max3f(a,p1[r],p1[r+1]);b=max3f(b,p1[r+2],p1[r+3]);}
  const float m=max2f(a,b);
  auto rr=__builtin_amdgcn_permlane32_swap(__float_as_uint(m),__float_as_uint(m),false,false);
  return max2f(__uint_as_float(rr[0]),__uint_as_float(rr[1]));
}
__device__ __forceinline__ void pv(f32x16*o,int vb,bf16x8 pa0,bf16x8 pa1,bf16x8 pa2,bf16x8 pa3){
  #pragma unroll
  for(int d0=0;d0<2;++d0){s16x4 lo[4],hi[4];
    #pragma unroll
    for(int ks=0;ks<4;++ks){
      asm volatile("ds_read_b64_tr_b16 %0,%1 offset:%c2":"=&v"(lo[ks]):"v"(vb),"i"(d0*4096+ks*1024):"memory");
      asm volatile("ds_read_b64_tr_b16 %0,%1 offset:%c2":"=&v"(hi[ks]):"v"(vb),"i"(d0*4096+ks*1024+512):"memory");}
    asm volatile("s_waitcnt lgkmcnt(0)":::"memory");SBAR();
    #define PK(k) (bf16x8){lo[k][0],lo[k][1],lo[k][2],lo[k][3],hi[k][0],hi[k][1],hi[k][2],hi[k][3]}
    o[d0]=__builtin_amdgcn_mfma_f32_32x32x16_bf16(pa0,PK(0),o[d0],0,0,0);
    o[d0]=__builtin_amdgcn_mfma_f32_32x32x16_bf16(pa1,PK(1),o[d0],0,0,0);
    o[d0]=__builtin_amdgcn_mfma_f32_32x32x16_bf16(pa2,PK(2),o[d0],0,0,0);
    o[d0]=__builtin_amdgcn_mfma_f32_32x32x16_bf16(pa3,PK(3),o[d0],0,0,0);
    #undef PK
  }
}

#ifndef ATTN_STORE16
#define ATTN_STORE16(p,v) (*(u32x4*)(p)=(v))
#endif
template<int THRL> __device__ __forceinline__ void attn_unit(int qb,const bf16*Q,const bf16*__restrict__ K,const bf16*__restrict__ V,float*O,char*shm){
  int tid_o=threadIdx.x; asm volatile("":"+v"(tid_o));
  const int tid=tid_o,lane=tid&63,r32=lane&31,hi=lane>>5; const int wid=__builtin_amdgcn_readfirstlane(tid>>6);
  const int q0=qb*QB;
  const bf16*Qw=Q+(long)(q0+wid*QBLK)*DM;
  const bf16*Kh=K,*Vh=V;
  const unsigned lds0=(unsigned)(uintptr_t)shm;
  float*wsf=(float*)(shm+LDS_WS)+wid*64;
  const bf16*ksrc=Kh+(long)lane*DM+wid*8;
  const bf16*vsrc=Vh+(long)(16*(wid&3)+(lane>>2))*DM+(wid>>2)*32+(lane&3)*8;
  const unsigned kdst=lds0+LDS_K+wid*1024, vdst=lds0+LDS_V+wid*1024;
  #define DMA_K(t,slot) glds16(ksrc+(long)(t)*KVBLK*DM,(unsigned)__builtin_amdgcn_readfirstlane(kdst+(slot)))
  #define DMA_V(t,slot) glds16(vsrc+(long)(t)*KVBLK*DM,(unsigned)__builtin_amdgcn_readfirstlane(vdst+(slot)))
  const int vb0=(int)(lds0+LDS_V)+((lane>>4)&1)*32+(lane&3)*8+(4*hi+((lane&15)>>2))*64;
  const char*Kbase=shm+LDS_K; bf16x8 kf[8];
  const lds_cptr shm3=(lds_cptr)shm; const lds_cptr kp0=shm3+LDS_K+hi*1024+r32*16; const lds_cptr vp0=shm3+LDS_V+((lane>>4)&1)*32+(lane&3)*8+(4*hi+((lane&15)>>2))*64;
  const int NT=(q0+QB)/KVBLK;
  DMA_K(0,0);DMA_V(0,0);DMA_K(1,SLOTB);
  bf16x8 qr[4];
  #pragma unroll
  for(int d0=0;d0<4;++d0)qr[d0]=*reinterpret_cast<const bf16x8*>(&Qw[(long)r32*DM+d0*16+hi*8]);
  float mhat=0.f,l_reg=0.f;f32x16 o[2];o[0]=f32x16{};o[1]=f32x16{};f32x16 negm=f32x16{};asm volatile("":"+v"(negm));

  #define CMASK(P0,P1,t) do{int jb_=(t)-(NT-4); if(jb_>=0)cmask(P0,P1,jb_,wid>>1);}while(0)
  bool resc=false;
  #define START(P0,P1) do{ const float rm=rowmax(P0,P1); resc=false; \
    { const float dl=rm; mhat=fadd_s(mhat,dl); \
      _Pragma("unroll") for(int r=0;r<16;++r){P0[r]=fsub_s(P0[r],dl);P1[r]=fsub_s(P1[r],dl);} \
      _Pragma("unroll") for(int r=0;r<16;++r)negm[r]=-mhat; asm volatile("":"+v"(negm)); } \
    _Pragma("unroll") for(int r=0;r<16;++r)P0[r]=__builtin_amdgcn_exp2f(P0[r]); }while(0)
  #define RESC() do{ if(resc){ asm volatile("s_waitcnt lgkmcnt(0)":::"memory"); \
      _Pragma("unroll") for(int d_=0;d_<2;++d_) _Pragma("unroll") for(int r=0;r<16;++r)o[d_][r]*=wsf[crow(r,hi)]; } }while(0)
  f32x16 pA0,pA1,pB0,pB1;
  int sl_prev=0,sl_cur=0,sl_next=SLOTB;
  #define ROT() do{sl_prev=sl_cur;sl_cur=sl_next;sl_next=(sl_next==(NSLOT-1)*SLOTB)?0:sl_next+SLOTB;}while(0)
  DMA_K(2,2*SLOTB);
  WAIT_BAR(3);
  qkt(pA0,pA1,Kbase,qr,negm,r32,hi);asm volatile("s_nop 15\n\ts_nop 7":"+v"(pA0),"+v"(pA1));CMASK(pA0,pA1,0);
  START(pA0,pA1);
  _Pragma("unroll") for(int r=0;r<16;++r)pA1[r]=__builtin_amdgcn_exp2f(pA1[r]);
  WAIT_BAR(0);
  DMA_K(3,0);DMA_V(1,SLOTB);
  ROT();
  kload8(kf,kp0+sl_cur);
  WAIT_BAR(2);
  s16x4 vlo[8],vhi[8]; u32x4 pw0,pw1,pw2,pw3;
  #define PKW(P,B) cvtpk_s(P[B],P[B+1])
  #define PAF(k) __builtin_bit_cast(bf16x8,pw##k)
  #define VFR(i) (bf16x8){vlo[i][0],vlo[i][1],vlo[i][2],vlo[i][3],vhi[i][0],vhi[i][1],vhi[i][2],vhi[i][3]}
  #define PIN(x) asm volatile("":"+v"(x))
  #define MX3(a,b,c) __builtin_fmaxf(__builtin_fmaxf((a),(b)),(c))
  #define GAPA(MF,A0,A1,A2,A3,W0,W1,PW) do{ MF; sacc+=A0; sacc+=A1; sacc+=A2; sacc+=A3; PIN(sacc); W0; W1; PIN(PW); SBAR(); }while(0)
  #define EX(v) __builtin_amdgcn_exp2f(v)
  #define GAPB(MF,X,B) do{ MF; X[B]=EX(X[B]); X[B+1]=EX(X[B+1]); X[B+2]=EX(X[B+2]); X[B+3]=EX(X[B+3]); PIN(X); SBAR(); }while(0)
  #define VRD(i) do{ vlo[i]=vtr(vp_+(((i)>>2)*4096+((i)&3)*1024)); vhi[i]=vtr(vp_+(((i)>>2)*4096+((i)&3)*1024+512)); }while(0)
  #define KRD(G,j) do{ if(G){ kload2(kf,kp0+sl_next,j); SBAR(); } }while(0)
  #define STEP(C0,C1,P0,P1,t,GK,GV,GL) do{ SBAR(); \
    const lds_cptr vp_=vp0+sl_prev; \
    VRD(0); SBAR(); float sacc=(P0[0]+P0[1]); \
    GAPA(C0=__builtin_amdgcn_mfma_f32_32x32x16_bf16(kf[0],qr[0],negm,0,0,0), P0[2],P0[3],P0[4],P0[5],     pw0[0]=PKW(P0,0), pw0[1]=PKW(P0,2), pw0); \
    VRD(4); SBAR(); GAPA(C1=__builtin_amdgcn_mfma_f32_32x32x16_bf16(kf[1],qr[0],negm,0,0,0), P0[6],P0[7],P0[8],P0[9],     pw0[2]=PKW(P0,4), pw0[3]=PKW(P0,6), pw0); \
    VRD(1); SBAR(); GAPA(C0=__builtin_amdgcn_mfma_f32_32x32x16_bf16(kf[2],qr[1],C0,0,0,0),   P0[10],P0[11],P0[12],P0[13], pw1[0]=PKW(P0,8), pw1[1]=PKW(P0,10), pw1); \
    VRD(5); SBAR(); GAPA(C1=__builtin_amdgcn_mfma_f32_32x32x16_bf16(kf[3],qr[1],C1,0,0,0),   P0[14],P0[15],P1[0],P1[1],   pw1[2]=PKW(P0,12),pw1[3]=PKW(P0,14), pw1); \
    VRD(2); SBAR(); GAPA(C0=__builtin_amdgcn_mfma_f32_32x32x16_bf16(kf[4],qr[2],C0,0,0,0),   P1[2],P1[3],P1[4],P1[5],     pw2[0]=PKW(P1,0), pw2[1]=PKW(P1,2), pw2); \
    VRD(6); SBAR(); GAPA(C1=__builtin_amdgcn_mfma_f32_32x32x16_bf16(kf[5],qr[2],C1,0,0,0),   P1[6],P1[7],P1[8],P1[9],     pw2[2]=PKW(P1,4), pw2[3]=PKW(P1,6), pw2); \
    VRD(3); SBAR(); GAPA(C0=__builtin_amdgcn_mfma_f32_32x32x16_bf16(kf[6],qr[3],C0,0,0,0),   P1[10],P1[11],P1[12],P1[13], pw3[0]=PKW(P1,8), pw3[1]=PKW(P1,10), pw3); \
    VRD(7); SBAR(); GAPA(C1=__builtin_amdgcn_mfma_f32_32x32x16_bf16(kf[7],qr[3],C1,0,0,0),   P1[14],P1[15],0.f,0.f,       pw3[2]=PKW(P1,12),pw3[3]=PKW(P1,14), pw3); \
    l_reg+=sacc; \
    if(GK){DMA_K((t)+3,sl_cur);} if(GV){DMA_V((t)+1,sl_next);} \
    CMASK(C0,C1,t); \
    { float a=MX3(C0[0],C0[1],C1[0]),b=MX3(C0[2],C0[3],C1[1]); a=MX3(a,C1[2],C1[3]); \
      _Pragma("unroll") for(int r=4;r<16;r+=4){a=MX3(a,C0[r],C0[r+1]);b=MX3(b,C0[r+2],C0[r+3]);a=MX3(a,C1[r],C1[r+1]);b=MX3(b,C1[r+2],C1[r+3]);} \
      float rm=__builtin_fmaxf(a,b); { auto rr=__builtin_amdgcn_permlane32_swap(__float_as_uint(rm),__float_as_uint(rm),false,false); rm=__builtin_fmaxf(__uint_as_float(rr[0]),__uint_as_float(rr[1])); } \
      resc=false; \
      if(__builtin_expect(__any(rm>(float)THRL),0)){ const float dl=__builtin_fmaxf(rm,0.f); mhat+=dl; \
        _Pragma("unroll") for(int r=0;r<16;++r){C0[r]-=dl;C1[r]-=dl;} \
        _Pragma("unroll") for(int r=0;r<16;++r)negm[r]=-mhat; asm volatile("":"+v"(negm)); \
        const float f=__builtin_amdgcn_exp2f(-dl); l_reg*=f; if(hi==0)wsf[r32]=f; resc=true; } } \
    SBAR(); \
    GAPB(o[0]=__builtin_amdgcn_mfma_f32_32x32x16_bf16(PAF(0),VFR(0),o[0],0,0,0), C0,0); \
    GAPB(o[1]=__builtin_amdgcn_mfma_f32_32x32x16_bf16(PAF(0),VFR(4),o[1],0,0,0), C0,4); \
    KRD(GL,0); GAPB(o[0]=__builtin_amdgcn_mfma_f32_32x32x16_bf16(PAF(1),VFR(1),o[0],0,0,0), C0,8); \
    KRD(GL,1); GAPB(o[1]=__builtin_amdgcn_mfma_f32_32x32x16_bf16(PAF(1),VFR(5),o[1],0,0,0), C0,12); \
    KRD(GL,2); GAPB(o[0]=__builtin_amdgcn_mfma_f32_32x32x16_bf16(PAF(2),VFR(2),o[0],0,0,0), C1,0); \
    KRD(GL,3); GAPB(o[1]=__builtin_amdgcn_mfma_f32_32x32x16_bf16(PAF(2),VFR(6),o[1],0,0,0), C1,4); \
    GAPB(o[0]=__builtin_amdgcn_mfma_f32_32x32x16_bf16(PAF(3),VFR(3),o[0],0,0,0), C1,8); \
    GAPB(o[1]=__builtin_amdgcn_mfma_f32_32x32x16_bf16(PAF(3),VFR(7),o[1],0,0,0), C1,12); \
    }while(0)
  int t=1;
  #undef CMASK
  #define CMASK(P0,P1,t) do{}while(0)
  for(;t+5<NT;t+=2){
    STEP(pB0,pB1,pA0,pA1,t,true,true,true);     WAIT_BAR(2); RESC(); ROT();
    STEP(pA0,pA1,pB0,pB1,t+1,true,true,true);   WAIT_BAR(2); RESC(); ROT();
  }
  #undef CMASK
  #define CMASK(P0,P1,t) do{int jb_=(t)-(NT-4); if(jb_>=0)cmask(P0,P1,jb_,wid>>1);}while(0)
  #define ENDW(tt) do{ if((tt)+3<NT){WAIT_BAR(2);} else if((tt)+2<NT){WAIT_BAR(1);} else {WAIT_BAR(0);} }while(0)
  for(;t+1<NT;t+=2){
    STEP(pB0,pB1,pA0,pA1,t,(t+3<NT),(t+1<NT),(t+1<NT));       ENDW(t);   RESC(); ROT();
    STEP(pA0,pA1,pB0,pB1,t+1,(t+4<NT),(t+2<NT),(t+2<NT));     ENDW(t+1); RESC(); ROT();
  }
  STEP(pB0,pB1,pA0,pA1,NT-1,false,false,false); RESC();
  { float sacc=pB0[0]+pB0[1]; _Pragma("unroll") for(int r=2;r<16;++r)sacc+=pB0[r]; _Pragma("unroll") for(int r=0;r<16;++r)sacc+=pB1[r]; l_reg+=sacc;
    pw0=(u32x4){PKW(pB0,0),PKW(pB0,2),PKW(pB0,4),PKW(pB0,6)};pw1=(u32x4){PKW(pB0,8),PKW(pB0,10),PKW(pB0,12),PKW(pB0,14)};pw2=(u32x4){PKW(pB1,0),PKW(pB1,2),PKW(pB1,4),PKW(pB1,6)};pw3=(u32x4){PKW(pB1,8),PKW(pB1,10),PKW(pB1,12),PKW(pB1,14)};
    SBAR(); pv(o,vb0+sl_cur,PAF(0),PAF(1),PAF(2),PAF(3)); }
  #undef PKW
  #undef PAF
  #undef VFR
  #undef PIN
  #undef MX3
  #undef GAPA
  #undef GAPB
  #undef EX
  #undef VRD
  #undef KRD
  #undef STEP
  #undef ENDW
  {auto rr=__builtin_amdgcn_permlane32_swap(__float_as_uint(l_reg),__float_as_uint(l_reg),false,false);l_reg=__uint_as_float(rr[0])+__uint_as_float(rr[1]);}
  if(hi==0)wsf[32+r32]=l_reg;asm volatile("s_waitcnt lgkmcnt(0)":::"memory");
  float rli[16];
  #pragma unroll
  for(int r=0;r<16;++r)rli[r]=__builtin_amdgcn_rcpf(wsf[32+crow(r,hi)]);
  float*Ow=O+(long)(q0+wid*QBLK)*DM;
  { float*stg=(float*)(shm+LDS_OST)+wid*2048;
    #pragma unroll
    for(int r=0;r<16;++r){const int orow=crow(r,hi);
      #pragma unroll
      for(int d0=0;d0<2;++d0)stg[orow*64+d0*32+r32]=o[d0][r]*rli[r];}
    asm volatile("s_waitcnt lgkmcnt(0)":::"memory");
    #pragma unroll
    for(int i=0;i<8;++i){const int row=i*4+(lane>>4),ch=lane&15; const u32x4 v=*(const u32x4*)(stg+row*64+ch*4); *(u32x4*)(Ow+(long)row*DM+ch*4)=v;} }
  asm volatile("s_waitcnt lgkmcnt(0)\n\ts_barrier":::"memory");
  #undef DMA_K
  #undef DMA_V
  #undef CMASK
  #undef START
  #undef RESC
  #undef ROT
}

constexpr int W_LDS_K=0, W_LDS_V=3*8192, W_LDS_WS=W_LDS_V+3*16384, W_LDS_OST=W_LDS_WS+NW*64*4, W_LDS_BYTES=W_LDS_OST+NW*4096;
template<int THRL> __device__ __forceinline__ void attn_unit128(int qb,const bf16*Q,const bf16*__restrict__ K,const bf16*__restrict__ V,float*O,char*shm,const int wave_id){
  int tid_o; asm volatile("v_mbcnt_lo_u32_b32 %0, -1, 0\n\tv_mbcnt_hi_u32_b32 %0, -1, %0":"=v"(tid_o)); tid_o+=wave_id*64;
  const int tid=tid_o,lane=tid&63,r32=lane&31,hi=lane>>5; const int wid=__builtin_amdgcn_readfirstlane(tid>>6);
  const int q0=qb*QB;
  const bf16*Qw=Q+(long)(q0+wid*QBLK)*DM;
  const unsigned lds0=(unsigned)(uintptr_t)shm;
  const bf16*ksrc=K+(long)lane*DM+wid*8;
  const bf16*vsrc=V+(long)(16*(wid&3)+(lane>>2))*DM+(wid>>2)*32+(lane&3)*8;
  const unsigned kdst=lds0+W_LDS_K+wid*1024, vdst=lds0+W_LDS_V+wid*1024;
  #define DMA_K(t,slot) glds16(ksrc+(long)(t)*KVBLK*DM,(unsigned)__builtin_amdgcn_readfirstlane(kdst+(slot)))
  #define DMA_V(t,slot) do{ glds16(vsrc+(long)(t)*KVBLK*DM,(unsigned)__builtin_amdgcn_readfirstlane(vdst+2*(slot))); glds16(vsrc+(long)(t)*KVBLK*DM+64,(unsigned)__builtin_amdgcn_readfirstlane(vdst+2*(slot)+8192)); }while(0)
  const char*Kbase=shm+W_LDS_K; bf16x8 kf[8];
  const lds_cptr shm3=(lds_cptr)shm; __attribute__((address_space(3))) float*const wsf=(__attribute__((address_space(3))) float*)(shm3+W_LDS_WS)+wid*64;
  const lds_cptr kp0=shm3+W_LDS_K+hi*1024+r32*16; const lds_cptr vp0=shm3+W_LDS_V+((lane>>4)&1)*32+(lane&3)*8+(4*hi+((lane&15)>>2))*64;
  const int NT=(q0+QB)/KVBLK;
  DMA_K(0,0);DMA_V(0,0);DMA_K(1,SLOTB);
  bf16x8 qr[4];
  #pragma unroll
  for(int d0=0;d0<4;++d0)qr[d0]=*reinterpret_cast<const bf16x8*>(&Qw[(long)r32*DM+d0*16+hi*8]);
  float mhat=0.f,l_reg=0.f;f32x16 o[4];o[0]=f32x16{};o[1]=f32x16{};o[2]=f32x16{};o[3]=f32x16{};f32x16 negm; { float z_=0.f; asm volatile("":"+v"(z_)); _Pragma("unroll") for(int r=0;r<16;++r)negm[r]=z_; }
  #define CMASK(P0,P1,t) do{int jb_=(t)-(NT-4); if(jb_>=0)cmask(P0,P1,jb_,wid>>1);}while(0)
  bool resc=false;
  #define RESC() do{ if(resc){ asm volatile("s_waitcnt lgkmcnt(0)":::"memory"); \
      _Pragma("unroll") for(int d_=0;d_<4;++d_) _Pragma("unroll") for(int r=0;r<16;++r)o[d_][r]*=wsf[crow(r,hi)]; } }while(0)
  f32x16 c0,c1;
  u32x4 pa0,pa1,pa2,pa3,pb0,pb1,pb2,pb3;
  int sl_prev=0,sl_cur=0,sl_next=SLOTB;
  #define ROT() do{sl_prev=sl_cur;sl_cur=sl_next;sl_next=(sl_next==(NSLOT-1)*SLOTB)?0:sl_next+SLOTB;}while(0)
  #define PKW(P,B) cvtpk_s(P[B],P[B+1])
  DMA_K(2,2*SLOTB);
  WAIT_BAR(3);
  qkt(c0,c1,Kbase,qr,negm,r32,hi);asm volatile("s_nop 15\n\ts_nop 7":"+v"(c0),"+v"(c1));CMASK(c0,c1,0);
  { const float rm=rowmax(c0,c1); mhat=fadd_s(mhat,rm);
    _Pragma("unroll") for(int r=0;r<16;++r){c0[r]=fsub_s(c0[r],rm);c1[r]=fsub_s(c1[r],rm);}
    _Pragma("unroll") for(int r=0;r<16;++r)negm[r]=-mhat; asm volatile("":"+v"(negm));
    _Pragma("unroll") for(int r=0;r<16;++r){c0[r]=__builtin_amdgcn_exp2f(c0[r]);c1[r]=__builtin_amdgcn_exp2f(c1[r]);}
    float sacc=c0[0]+c0[1]; _Pragma("unroll") for(int r=2;r<16;++r)sacc+=c0[r]; _Pragma("unroll") for(int r=0;r<16;++r)sacc+=c1[r]; l_reg+=sacc;
    pa0=(u32x4){PKW(c0,0),PKW(c0,2),PKW(c0,4),PKW(c0,6)};pa1=(u32x4){PKW(c0,8),PKW(c0,10),PKW(c0,12),PKW(c0,14)};pa2=(u32x4){PKW(c1,0),PKW(c1,2),PKW(c1,4),PKW(c1,6)};pa3=(u32x4){PKW(c1,8),PKW(c1,10),PKW(c1,12),PKW(c1,14)}; }
  WAIT_BAR(0);
  DMA_K(3,0);DMA_V(1,SLOTB);
  ROT();
  kload8(kf,kp0+sl_cur);
  WAIT_BAR(3);
  s16x4 vlo[8],vhi[8];
  #define PAFX(x) __builtin_bit_cast(bf16x8,x)
  #define VFR(i) (bf16x8){vlo[i][0],vlo[i][1],vlo[i][2],vlo[i][3],vhi[i][0],vhi[i][1],vhi[i][2],vhi[i][3]}
  #define PIN(x) asm volatile("":"+v"(x))
  #define MX3(a,b,c) __builtin_fmaxf(__builtin_fmaxf((a),(b)),(c))
  #define EX(v) __builtin_amdgcn_exp2f(v)
  #define MFM(a,b,c) __builtin_amdgcn_mfma_f32_32x32x16_bf16(a,b,c,0,0,0)
  #define VRDQ(i,qoff) do{ vlo[i]=vtr(vp_+((qoff)+(((i)>>2)*4096+((i)&3)*1024))); vhi[i]=vtr(vp_+((qoff)+(((i)>>2)*4096+((i)&3)*1024+512))); }while(0)
  #define KRD(G,j) do{ if(G){ kload2(kf,kp0+sl_next,j); SBAR(); } }while(0)
  #define GAPA(MF) do{ MF; SBAR(); }while(0)
  #define GAPB(MF,X,B,I) do{ MF; X[B]=EX(X[B]); X[B+1]=EX(X[B+1]); X[B+2]=EX(X[B+2]); X[B+3]=EX(X[B+3]); PIN(X); VRDQ(I,8192); SBAR(); }while(0)
  #define GAPC(MF,A0,A1,A2,A3,W0,W1,PW) do{ MF; sacc+=A0; sacc+=A1; sacc+=A2; sacc+=A3; PIN(sacc); W0; W1; PIN(PW); SBAR(); }while(0)
  #define STEPW(PO0,PO1,PO2,PO3,PN0,PN1,PN2,PN3,t,GK,GV,GL) do{ SBAR(); \
    const lds_cptr vp_=vp0+2*sl_prev; \
    VRDQ(0,0); SBAR(); GAPA(c0=MFM(kf[0],qr[0],negm)); \
    VRDQ(4,0); SBAR(); GAPA(c1=MFM(kf[1],qr[0],negm)); \
    VRDQ(1,0); SBAR(); GAPA(c0=MFM(kf[2],qr[1],c0)); \
    VRDQ(5,0); SBAR(); GAPA(c1=MFM(kf[3],qr[1],c1)); \
    VRDQ(2,0); SBAR(); GAPA(c0=MFM(kf[4],qr[2],c0)); \
    VRDQ(6,0); SBAR(); GAPA(c1=MFM(kf[5],qr[2],c1)); \
    VRDQ(3,0); SBAR(); GAPA(c0=MFM(kf[6],qr[3],c0)); \
    VRDQ(7,0); SBAR(); GAPA(c1=MFM(kf[7],qr[3],c1)); \
    if(GK){DMA_K((t)+3,sl_cur);} if(GV){DMA_V((t)+1,sl_next);} \
    CMASK(c0,c1,t); \
    { float a=MX3(c0[0],c0[1],c1[0]),b=MX3(c0[2],c0[3],c1[1]); a=MX3(a,c1[2],c1[3]); \
      _Pragma("unroll") for(int r=4;r<16;r+=4){a=MX3(a,c0[r],c0[r+1]);b=MX3(b,c0[r+2],c0[r+3]);a=MX3(a,c1[r],c1[r+1]);b=MX3(b,c1[r+2],c1[r+3]);} \
      float rm=__builtin_fmaxf(a,b); { auto rr=__builtin_amdgcn_permlane32_swap(__float_as_uint(rm),__float_as_uint(rm),false,false); rm=__builtin_fmaxf(__uint_as_float(rr[0]),__uint_as_float(rr[1])); } \
      resc=false; \
      if(__builtin_expect(__any(rm>(float)THRL),0)){ const float dl=__builtin_fmaxf(rm,0.f); mhat+=dl; \
        _Pragma("unroll") for(int r=0;r<16;++r){c0[r]-=dl;c1[r]-=dl;} \
        _Pragma("unroll") for(int r=0;r<16;++r)negm[r]=-mhat; asm volatile("":"+v"(negm)); \
        const float f=__builtin_amdgcn_exp2f(-dl); l_reg*=f; if(hi==0)wsf[r32]=f; resc=true; } } \
    SBAR(); \
    GAPB(o[0]=MFM(PAFX(PO0),VFR(0),o[0]), c0,0, 0); \
    GAPB(o[1]=MFM(PAFX(PO0),VFR(4),o[1]), c0,4, 4); \
    KRD(GL,0); GAPB(o[0]=MFM(PAFX(PO1),VFR(1),o[0]), c0,8, 1); \
    KRD(GL,1); GAPB(o[1]=MFM(PAFX(PO1),VFR(5),o[1]), c0,12, 5); \
    KRD(GL,2); GAPB(o[0]=MFM(PAFX(PO2),VFR(2),o[0]), c1,0, 2); \
    KRD(GL,3); GAPB(o[1]=MFM(PAFX(PO2),VFR(6),o[1]), c1,4, 6); \
    GAPB(o[0]=MFM(PAFX(PO3),VFR(3),o[0]), c1,8, 3); \
    GAPB(o[1]=MFM(PAFX(PO3),VFR(7),o[1]), c1,12, 7); \
    float sacc=(c0[0]+c0[1]); \
    GAPC(o[2]=MFM(PAFX(PO0),VFR(0),o[2]), c0[2],c0[3],c0[4],c0[5],     PN0[0]=PKW(c0,0), PN0[1]=PKW(c0,2), PN0); \
    GAPC(o[3]=MFM(PAFX(PO0),VFR(4),o[3]), c0[6],c0[7],c0[8],c0[9],     PN0[2]=PKW(c0,4), PN0[3]=PKW(c0,6), PN0); \
    GAPC(o[2]=MFM(PAFX(PO1),VFR(1),o[2]), c0[10],c0[11],c0[12],c0[13], PN1[0]=PKW(c0,8), PN1[1]=PKW(c0,10), PN1); \
    GAPC(o[3]=MFM(PAFX(PO1),VFR(5),o[3]), c0[14],c0[15],c1[0],c1[1],   PN1[2]=PKW(c0,12),PN1[3]=PKW(c0,14), PN1); \
    GAPC(o[2]=MFM(PAFX(PO2),VFR(2),o[2]), c1[2],c1[3],c1[4],c1[5],     PN2[0]=PKW(c1,0), PN2[1]=PKW(c1,2), PN2); \
    GAPC(o[3]=MFM(PAFX(PO2),VFR(6),o[3]), c1[6],c1[7],c1[8],c1[9],     PN2[2]=PKW(c1,4), PN2[3]=PKW(c1,6), PN2); \
    GAPC(o[2]=MFM(PAFX(PO3),VFR(3),o[2]), c1[10],c1[11],c1[12],c1[13], PN3[0]=PKW(c1,8), PN3[1]=PKW(c1,10), PN3); \
    GAPC(o[3]=MFM(PAFX(PO3),VFR(7),o[3]), c1[14],c1[15],0.f,0.f,       PN3[2]=PKW(c1,12),PN3[3]=PKW(c1,14), PN3); \
    l_reg+=sacc; \
    }while(0)
  int t=1;
  #undef CMASK
  #define CMASK(P0,P1,t) do{}while(0)
  for(;t+5<NT;t+=2){
    STEPW(pa0,pa1,pa2,pa3,pb0,pb1,pb2,pb3,t,true,true,true);     WAIT_BAR(3); RESC(); ROT();
    STEPW(pb0,pb1,pb2,pb3,pa0,pa1,pa2,pa3,t+1,true,true,true);   WAIT_BAR(3); RESC(); ROT();
  }
  #undef CMASK
  #define CMASK(P0,P1,t) do{int jb_=(t)-(NT-4); if(jb_>=0)cmask(P0,P1,jb_,wid>>1);}while(0)
  #define ENDW(tt) do{ if((tt)+3<NT){WAIT_BAR(3);} else if((tt)+2<NT){WAIT_BAR(2);} else {WAIT_BAR(0);} }while(0)
  for(;t+1<NT;t+=2){
    STEPW(pa0,pa1,pa2,pa3,pb0,pb1,pb2,pb3,t,(t+3<NT),(t+1<NT),(t+1<NT));       ENDW(t);   RESC(); ROT();
    STEPW(pb0,pb1,pb2,pb3,pa0,pa1,pa2,pa3,t+1,(t+4<NT),(t+2<NT),(t+2<NT));     ENDW(t+1); RESC(); ROT();
  }
  STEPW(pa0,pa1,pa2,pa3,pb0,pb1,pb2,pb3,NT-1,false,false,false); RESC();
  { SBAR();
    #pragma unroll
    for(int q=0;q<4;++q){ s16x4 lo[4],hh[4]; const int vb=(int)(unsigned)(uintptr_t)vp0+2*sl_cur;
      #pragma unroll
      for(int ks=0;ks<4;++ks){
        asm volatile("ds_read_b64_tr_b16 %0,%1 offset:%c2":"=&v"(lo[ks]):"v"(vb),"i"(q*4096+ks*1024):"memory");
        asm volatile("ds_read_b64_tr_b16 %0,%1 offset:%c2":"=&v"(hh[ks]):"v"(vb),"i"(q*4096+ks*1024+512):"memory");}
      asm volatile("s_waitcnt lgkmcnt(0)":::"memory");SBAR();
      #define PK(k) (bf16x8){lo[k][0],lo[k][1],lo[k][2],lo[k][3],hh[k][0],hh[k][1],hh[k][2],hh[k][3]}
      o[q]=MFM(PAFX(pb0),PK(0),o[q]); o[q]=MFM(PAFX(pb1),PK(1),o[q]); o[q]=MFM(PAFX(pb2),PK(2),o[q]); o[q]=MFM(PAFX(pb3),PK(3),o[q]);
      #undef PK
    } }
  #undef PKW
  #undef PAFX
  #undef VFR
  #undef PIN
  #undef MX3
  #undef EX
  #undef MFM
  #undef VRDQ
  #undef KRD
  #undef GAPA
  #undef GAPB
  #undef GAPC
  #undef STEPW
  #undef ENDW
  {auto rr=__builtin_amdgcn_permlane32_swap(__float_as_uint(l_reg),__float_as_uint(l_reg),false,false);l_reg=__uint_as_float(rr[0])+__uint_as_float(rr[1]);}
  if(hi==0)wsf[32+r32]=l_reg;asm volatile("s_waitcnt lgkmcnt(0)":::"memory");
  float rli[16];
  #pragma unroll
  for(int r=0;r<16;++r)rli[r]=__builtin_amdgcn_rcpf(wsf[32+crow(r,hi)]);
  float*Ow=O+(long)(q0+wid*QBLK)*DM;
  { float*stg=(float*)(shm+W_LDS_OST)+wid*1024;
    #pragma unroll
    for(int q=0;q<4;++q){
      #pragma unroll
      for(int r=0;r<16;++r)stg[crow(r,hi)*32+r32]=o[q][r]*rli[r];
      asm volatile("s_waitcnt lgkmcnt(0)":::"memory");
      #pragma unroll
      for(int i=0;i<4;++i){const int row=i*8+(lane>>3),ch=lane&7; const u32x4 v=*(const u32x4*)(stg+row*32+ch*4); *(u32x4*)(Ow+(long)row*DM+q*32+ch*4)=v;}
      asm volatile("s_waitcnt lgkmcnt(0)":::"memory");
    } }
  asm volatile("s_waitcnt lgkmcnt(0)\n\ts_barrier":::"memory");
  #undef DMA_K
  #undef DMA_V
  #undef CMASK
  #undef RESC
  #undef ROT
}
constexpr int ATTN_LDS_BYTES=W_LDS_BYTES>LDS_BYTES?W_LDS_BYTES:LDS_BYTES;
#undef SBAR
#undef WAIT_BAR
}
#define GAS __attribute__((address_space(1)))
#define LAS __attribute__((address_space(3)))
typedef unsigned short bf16;
typedef unsigned v4u __attribute__((ext_vector_type(4)));
typedef float f32x4 __attribute__((ext_vector_type(4)));
typedef short bf16x8 __attribute__((ext_vector_type(8)));
typedef GAS unsigned gu32;
typedef GAS unsigned long long gu64;
#define RLX_AGENT __ATOMIC_RELAXED, __HIP_MEMORY_SCOPE_AGENT
#define LDS_WAIT() asm volatile("s_waitcnt lgkmcnt(0)" ::: "memory")
#define VM_WAIT() asm volatile("s_waitcnt vmcnt(0)" ::: "memory")
__device__ __forceinline__ unsigned long long rt() { return __builtin_amdgcn_s_memrealtime(); }
__device__ __forceinline__ unsigned f2bf(float f) { unsigned u = __builtin_bit_cast(unsigned, f); return (u + 0x7fffu + ((u >> 16) & 1u)) >> 16; }
__device__ __forceinline__ unsigned pk2(float lo, float hi) { return f2bf(lo) | (f2bf(hi) << 16); }

#define XB_TMO      128
#define XB_XCNT(j)  (256  + 64 * (j))
#define XB_XSUB(j)  (1280 + 64 * (j))
#define XB_XGEN(j)  (2304 + 64 * (j))
#define XB_TOP      3328
#define XB_TOPGEN   3392
#define XCD_BAR_WORDS 3456
#define XB_SPIN_CAP (1u << 18)

__device__ __forceinline__ unsigned xb_ld(unsigned* p)              { return __hip_atomic_load(p, __ATOMIC_RELAXED, __HIP_MEMORY_SCOPE_AGENT); }
__device__ __forceinline__ unsigned xb_add(unsigned* p, unsigned v) { return __hip_atomic_fetch_add(p, v, __ATOMIC_RELAXED, __HIP_MEMORY_SCOPE_AGENT); }
__device__ __forceinline__ unsigned xb_xcc_id() { return (unsigned)__builtin_amdgcn_s_getreg((3 << 11) | 20) & 0xFu; }
#define XB_SPIN(cond, bar) do { unsigned _sp = 0; while (cond) { __builtin_amdgcn_s_sleep(1); \
    if ((++_sp & 255u) == 0u) { if (xb_ld(&(bar)[XB_TMO])) break; if (_sp > XB_SPIN_CAP) { atomicAdd(&(bar)[XB_TMO], 1u); break; } } } } while (0)

struct XcdBarrier {
    unsigned* bar; unsigned x;
    volatile LAS unsigned* st;
};

__device__ __forceinline__ XcdBarrier xcd_barrier_post(unsigned* bar, volatile LAS unsigned* st) {
    XcdBarrier b; b.bar = bar; b.x = xb_xcc_id(); b.st = st;
    if (threadIdx.x == 0) (void)xb_add(&bar[XB_XCNT(b.x)], 1u);
    return b;
}
__device__ __forceinline__ void xcd_barrier_complete(unsigned* bar, unsigned x, unsigned& nloc, unsigned& nx) {
    const unsigned G = gridDim.x * gridDim.y * gridDim.z;
    unsigned sum, cnt, mine, sp = 0u;
    for (;;) {
        sum = 0u; cnt = 0u; mine = 0u;
#pragma unroll
        for (unsigned j = 0; j < 16; ++j) { const unsigned c = xb_ld(&bar[XB_XCNT(j)]); sum += c; cnt += (c > 0u) ? 1u : 0u; mine = (j == x) ? c : mine; }
        if (sum == G) break;
        __builtin_amdgcn_s_sleep(1);
        if ((++sp & 255u) == 0u) { if (xb_ld(&bar[XB_TMO])) break; if (sp > XB_SPIN_CAP) { atomicAdd(&bar[XB_TMO], 1u); break; } }
    }
    nloc = mine > 0u ? mine : 1u; nx = cnt > 0u ? cnt : 1u;
}

__device__ __forceinline__ void xcd_barrier(const XcdBarrier& b) {
    asm volatile("s_waitcnt vmcnt(0)" ::: "memory");
    __syncthreads();
    if (threadIdx.x == 0) {
        unsigned* bar = b.bar;
        __builtin_amdgcn_s_waitcnt(0);
        unsigned nloc = b.st[0], nx = b.st[1];
        if (nloc == 0u) { xcd_barrier_complete(bar, b.x, nloc, nx); b.st[0] = nloc; b.st[1] = nx; }
        const unsigned old = xb_add(&bar[XB_XSUB(b.x)], 1u);
        const unsigned gen = old / nloc;
        if (old + 1u == (gen + 1u) * nloc) {
            __builtin_amdgcn_fence(__ATOMIC_RELEASE, "agent");
            asm volatile("s_waitcnt vmcnt(0)" ::: "memory");
            const unsigned og = xb_add(&bar[XB_TOP], 1u);
            const unsigned tg = og / nx;
            if (og + 1u == (tg + 1u) * nx) xb_add(&bar[XB_TOPGEN], 1u);
            else XB_SPIN(xb_ld(&bar[XB_TOPGEN]) == tg, bar);
            __builtin_amdgcn_fence(__ATOMIC_ACQUIRE, "agent");
            xb_add(&bar[XB_XGEN(b.x)], 1u);
            asm volatile("s_waitcnt vmcnt(0)" ::: "memory");
        } else {
            XB_SPIN(xb_ld(&bar[XB_XGEN(b.x)]) == gen, bar);
            __builtin_amdgcn_fence(__ATOMIC_ACQUIRE, "agent");
            asm volatile("s_waitcnt vmcnt(0)" ::: "memory");
        }
    }
    __syncthreads();
}
typedef unsigned short bf16_t;
typedef float f32x4 __attribute__((ext_vector_type(4)));
typedef float f32x16 __attribute__((ext_vector_type(16)));
typedef unsigned u32x2 __attribute__((ext_vector_type(2)));
typedef unsigned u32x4v __attribute__((ext_vector_type(4)));
typedef short bf16x8 __attribute__((ext_vector_type(8)));
__device__ __forceinline__ float bflo(unsigned w) { return __uint_as_float(w << 16); }
__device__ __forceinline__ float bfhi(unsigned w) { return __uint_as_float(w & 0xffff0000u); }
__device__ __forceinline__ unsigned pkbf(float lo, float hi) { return pg8::cvt_pk_bf16(lo, hi); }
__device__ __forceinline__ float sigm(float x) { return __builtin_amdgcn_rcpf(1.f + __builtin_amdgcn_exp2f(-1.4426950408889634f * x)); }
template <int MSK> __device__ __forceinline__ float xor_swz(float v) { return __int_as_float(__builtin_amdgcn_ds_swizzle(__float_as_int(v), (MSK << 10) | 0x1f)); }
__device__ __forceinline__ float sum_halves(float v) { auto rr = __builtin_amdgcn_permlane32_swap(__float_as_uint(v), __float_as_uint(v), false, false); return __uint_as_float(rr[0]) + __uint_as_float(rr[1]); }
__device__ __forceinline__ float max_halves(float v) { auto rr = __builtin_amdgcn_permlane32_swap(__float_as_uint(v), __float_as_uint(v), false, false); return fmaxf(__uint_as_float(rr[0]), __uint_as_float(rr[1])); }
__device__ __forceinline__ float wave_sum(float v) { v += xor_swz<1>(v); v += xor_swz<2>(v); v += xor_swz<4>(v); v += xor_swz<8>(v); v += xor_swz<16>(v); return sum_halves(v); }
__device__ __forceinline__ int fresh_tid(int wave) { int l_; asm volatile("v_mbcnt_lo_u32_b32 %0, -1, 0\n\tv_mbcnt_hi_u32_b32 %0, -1, %0" : "=v"(l_)); return wave * 64 + l_; }
__device__ __forceinline__ int crow16(int r, int hi) { return (r & 3) + 8 * (r >> 2) + 4 * hi; }

struct EpiIn {
    static constexpr bool PERM = false, AFTER_DRAIN = false; static constexpr int MIDK = 0;
    bf16_t *PXB, *SPG, *QB, *KB, *VB, *SAG, *SGA, *SGB, *RSB; float* out; const float* rc; const float* rs; int layer;
    __device__ __forceinline__ void operator()(const pg8::f32x4 (&acc)[2][2][4][2], const pg8::Unit& u, int wr, int wc, int fr, int fq) const {
        const int pn = u.pn, row0 = u.pm * 256 + wr * 64 + fr;
        const bool samp = u.pm >= MP / 256;
        if (pn >= 4 && pn < 12) {
            const bool isk = pn >= 8;
            const int cbase = (pn - (isk ? 8 : 4)) * 256 + (wc >> 1) * 64 + (wc & 1) * 16 + 4 * fq;
            const int i0 = (wc & 1) * 16 + 4 * fq;
            bf16_t* dstb = isk ? KB : QB; const float sc = isk ? 1.f : C2;
#pragma unroll
            for (int ai = 0; ai < 2; ++ai)
#pragma unroll
                for (int m = 0; m < 4; ++m) {
                    const int row = row0 + ai * 128 + m * 16;
                    const int pos = samp ? PAST + ((row - MP) & 15) : (row & (SEQ - 1));
                    const f32x4 c = *(const f32x4*)(rc + pos * 32 + i0), s = *(const f32x4*)(rs + pos * 32 + i0);
                    float* ko = samp ? out + O_KS + ((size_t)layer * MS + (row - MP)) * 1024 : out + O_KP + ((size_t)layer * MP + row) * 1024;
#pragma unroll
                    for (int bj = 0; bj < 2; ++bj) {
                        const f32x4 x1 = acc[ai][bj][m][0], x2 = acc[ai][bj][m][1];
                        const f32x4 r1 = x1 * c - x2 * s, r2 = x2 * c + x1 * s;
                        const int col = cbase + bj * 128;
                        if (isk) { *(f32x4*)(ko + col) = r1; *(f32x4*)(ko + col + 32) = r2; }
                        u32x2 w1, w2; w1.x = pkbf(r1[0] * sc, r1[1] * sc); w1.y = pkbf(r1[2] * sc, r1[3] * sc); w2.x = pkbf(r2[0] * sc, r2[1] * sc); w2.y = pkbf(r2[2] * sc, r2[3] * sc);
                        *(u32x2*)(dstb + (size_t)row * 1024 + col) = w1; *(u32x2*)(dstb + (size_t)row * 1024 + col + 32) = w2;
                    }
                }
        } else {
            int mode, ld, cb; bf16_t* dst;
            if (pn < 2) { dst = PXB; ld = 512; cb = pn * 256; mode = 0; }
            else if (pn < 4) { dst = SPG; ld = 512; cb = (pn - 2) * 256; mode = 1; }
            else if (pn < 16) { dst = VB; ld = 1024; cb = (pn - 12) * 256; mode = 0; }
            else if (pn < 20) { dst = SAG; ld = 1024; cb = (pn - 16) * 256; mode = 1; }
            else if (pn < 24) { dst = SGA; ld = 1024; cb = (pn - 20) * 256; mode = 2; }
            else { dst = SGB; ld = 1024; cb = (pn - 24) * 256; mode = 3; }
            cb += 32 * wc + 8 * fq;
            const bool isv = pn >= 12 && pn < 16, ispx = pn < 2;
#pragma unroll
            for (int ai = 0; ai < 2; ++ai)
#pragma unroll
                for (int m = 0; m < 4; ++m) {
                    const int row = row0 + ai * 128 + m * 16;
                    float* fo = nullptr;
                    if (isv) fo = samp ? out + O_VS + ((size_t)layer * MS + (row - MP)) * 1024 : out + O_VP + ((size_t)layer * MP + row) * 1024;
                    else if (ispx) {
                        if (!samp) { const int t = row & (SEQ - 1); if (t >= SEQ - 15) fo = out + O_PP + (((size_t)layer * BATCH + (row >> 12)) * 15 + (t - (SEQ - 15))) * 512; }
                        else { const int rs_ = row - MP, j = rs_ & 15; if (j >= 1) fo = out + O_PS + (((size_t)layer * DEC_BATCH + (rs_ >> 4)) * 15 + (j - 1)) * 512; }
                    }
#pragma unroll
                    for (int bj = 0; bj < 2; ++bj) {
                        f32x4 v0 = acc[ai][bj][m][0], v1 = acc[ai][bj][m][1];
                        const int col = cb + bj * 128;
                        if (fo) { *(f32x4*)(fo + col) = v0; *(f32x4*)(fo + col + 4) = v1; }
                        if (mode == 1) {
#pragma unroll
                            for (int k = 0; k < 4; ++k) { v0[k] = v0[k] * sigm(v0[k]); v1[k] = v1[k] * sigm(v1[k]); }
                        } else if (mode == 2) {
#pragma unroll
                            for (int k = 0; k < 4; ++k) { v0[k] = sigm(v0[k]); v1[k] = sigm(v1[k]); }
                        } else if (mode == 3) {
                            f32x4 e0, e1;
#pragma unroll
                            for (int k = 0; k < 4; ++k) { e0[k] = 1.f + __builtin_amdgcn_exp2f(-1.4426950408889634f * v0[k]); e1[k] = 1.f + __builtin_amdgcn_exp2f(-1.4426950408889634f * v1[k]);
                                v0[k] = __builtin_amdgcn_rcpf(e0[k]); v1[k] = __builtin_amdgcn_rcpf(e1[k]); }
                            u32x4v w2; w2.x = pkbf(e0[0], e0[1]); w2.y = pkbf(e0[2], e0[3]); w2.z = pkbf(e1[0], e1[1]); w2.w = pkbf(e1[2], e1[3]);
                            *(u32x4v*)(RSB + (size_t)row * ld + col) = w2;
                        }
                        u32x4v w; w.x = pkbf(v0[0], v0[1]); w.y = pkbf(v0[2], v0[3]); w.z = pkbf(v1[0], v1[1]); w.w = pkbf(v1[2], v1[3]);
                        *(u32x4v*)(dst + (size_t)row * ld + col) = w;
                    }
                }
        }
    }
};
struct EpiMerge {
    static constexpr bool PERM = false, AFTER_DRAIN = false; static constexpr int MIDK = 8;
    const bf16_t *SGA, *SGB, *RSB; bf16_t* MG;
    __device__ __forceinline__ void mid(pg8::f32x4 (&acc)[2][2][4][2], const pg8::Unit& u, int wr, int wc, int fr, int fq) const {
        asm volatile("" : "+v"(fr), "+v"(fq));
        const int row0 = u.pm * 256 + wr * 64 + fr, col0 = u.pn * 256 + wc * 32 + 4 * fq;
#pragma unroll
        for (int ai = 0; ai < 2; ++ai)
#pragma unroll
            for (int m = 0; m < 4; ++m) { const size_t ro = (size_t)(row0 + ai * 128 + m * 16) * 1024 + col0;
                u32x2 ga[2][2], rb[2][2];
#pragma unroll
                for (int bj = 0; bj < 2; ++bj)
#pragma unroll
                    for (int n = 0; n < 2; ++n) { const size_t o = ro + bj * 128 + n * 16; ga[bj][n] = *(const u32x2*)(SGA + o); rb[bj][n] = *(const u32x2*)(RSB + o); }
#pragma unroll
                for (int bj = 0; bj < 2; ++bj)
#pragma unroll
                    for (int n = 0; n < 2; ++n) { pg8::f32x4& a = acc[ai][bj][m][n]; const u32x2 g = ga[bj][n], r = rb[bj][n];
                        a[0] *= bflo(g.x) * bflo(r.x); a[1] *= bfhi(g.x) * bfhi(r.x); a[2] *= bflo(g.y) * bflo(r.y); a[3] *= bfhi(g.y) * bfhi(r.y); } }
    }
    __device__ __forceinline__ void operator()(const pg8::f32x4 (&acc)[2][2][4][2], const pg8::Unit& u, int wr, int wc, int fr, int fq) const {
        const int row0 = u.pm * 256 + wr * 64 + fr, col0 = u.pn * 256 + wc * 32 + 4 * fq;
#pragma unroll
        for (int ai = 0; ai < 2; ++ai)
#pragma unroll
            for (int m = 0; m < 4; ++m) { const size_t ro = (size_t)(row0 + ai * 128 + m * 16) * 1024 + col0;
#pragma unroll
                for (int bj = 0; bj < 2; ++bj)
#pragma unroll
                    for (int n = 0; n < 2; ++n) { const size_t o = ro + bj * 128 + n * 16; const u32x2 g = *(const u32x2*)(SGB + o);
                        const pg8::f32x4 a = acc[ai][bj][m][n];
                        u32x2 w; w.x = pkbf(a[0] * bflo(g.x), a[1] * bfhi(g.x)); w.y = pkbf(a[2] * bflo(g.y), a[3] * bfhi(g.y)); *(u32x2*)(MG + o) = w; } }
    }
};
struct EpiOut {
    static constexpr bool PERM = false, AFTER_DRAIN = false; static constexpr int MIDK = 0;
    float* X;
    __device__ __forceinline__ void operator()(const pg8::f32x4 (&acc)[2][2][4][2], const pg8::Unit& u, int wr, int wc, int fr, int fq) const {
        const int row0 = u.pm * 256 + wr * 64 + fr, col0 = u.pn * 256 + wc * 32 + 4 * fq;
#pragma unroll
        for (int ai = 0; ai < 2; ++ai)
#pragma unroll
            for (int m = 0; m < 4; ++m) { const size_t ro = (size_t)(row0 + ai * 128 + m * 16) * 1024 + col0;
#pragma unroll
                for (int bj = 0; bj < 2; ++bj)
#pragma unroll
                    for (int n = 0; n < 2; ++n) { const size_t o = ro + bj * 128 + n * 16; const f32x4 x = *(const f32x4*)(X + o); *(f32x4*)(X + o) = x * ALPHA + acc[ai][bj][m][n]; } }
    }
};

__device__ __forceinline__ int inv_perm_S(int a) { const int bj = a >> 7, wc = (a >> 5) & 3, fq = (a >> 3) & 3, n = (a >> 2) & 1, j = a & 3; return 128 * bj + 32 * wc + 16 * n + 4 * fq + j; }
__device__ __forceinline__ int inv_perm_R(int a) { const int bj = a >> 7, wch = (a >> 6) & 1, n = (a >> 5) & 1, wcl = (a >> 4) & 1, fq = (a >> 2) & 3, j = a & 3; return 128 * bj + 32 * (2 * wch + wcl) + 16 * n + 4 * fq + j; }
template <int PM>
__device__ __forceinline__ void p0_transpose_item(const float* W, int K, int N, bf16_t* WT, int ldt, LAS float* scr, int item, int lane) {
    const int nblk = N / 32, kb = item / nblk, nb = item % nblk, k0 = 64 * kb, n0 = 32 * nb;
#pragma unroll 8
    for (int i = 0; i < 32; ++i) { const int kk = 2 * i + (lane >> 5); scr[kk * 33 + (lane & 31)] = W[(size_t)(k0 + kk) * N + n0 + (lane & 31)]; }
    LDS_WAIT(); asm volatile("" ::: "memory");
    const int c = lane & 7;
#pragma unroll
    for (int j = 0; j < 4; ++j) { const int n = (lane >> 3) + 8 * j; const LAS float* s = scr + (8 * c) * 33 + n;
        v4u o; o.x = pkbf(s[0 * 33], s[1 * 33]); o.y = pkbf(s[2 * 33], s[3 * 33]); o.z = pkbf(s[4 * 33], s[5 * 33]); o.w = pkbf(s[6 * 33], s[7 * 33]);
        int nr = n0 + n;
        if (PM == 1) { const int tile = nr >> 8, a = nr & 255; nr = (nr & ~255) + ((tile >= 4 && tile < 12) ? inv_perm_R(a) : inv_perm_S(a)); }
        *(GAS v4u*)(WT + (size_t)nr * ldt + k0 + 8 * c) = o; }
    LDS_WAIT(); asm volatile("" ::: "memory");
}
__device__ __forceinline__ void ln_row(const float* xrow, const float* g, const float* b, float* of, bf16_t* ob) {
    const int lane = fresh_tid(0);
    const GAS f32x4* xr = (const GAS f32x4*)xrow + lane;
    f32x4 v[4]; float s = 0.f;
#pragma unroll
    for (int j = 0; j < 4; ++j) { v[j] = xr[64 * j]; s += (v[j].x + v[j].y) + (v[j].z + v[j].w); }
    const float mean = wave_sum(s) * (1.f / 1024.f); float s2 = 0.f;
#pragma unroll
    for (int j = 0; j < 4; ++j) { v[j] = v[j] - mean; s2 += (v[j].x * v[j].x + v[j].y * v[j].y) + (v[j].z * v[j].z + v[j].w * v[j].w); }
    const float rstd = 1.f / sqrtf(wave_sum(s2) * (1.f / 1024.f) + LN_EPS);
    GAS f32x4* o4 = (GAS f32x4*)of + lane; GAS u32x2* o8 = (GAS u32x2*)ob + lane;
#pragma unroll
    for (int j = 0; j < 4; ++j) { const f32x4 gg = ((const GAS f32x4*)g + lane)[64 * j], bb = ((const GAS f32x4*)b + lane)[64 * j];
        const f32x4 y = v[j] * rstd * gg + bb; o4[64 * j] = y; u32x2 w; w.x = pkbf(y.x, y.y); w.y = pkbf(y.z, y.w); o8[64 * j] = w; }
}

struct Params { const float* in[17]; float* out; unsigned char* ws; int l_lo, l_hi, do_pro, bar_region; };
enum { I_XP = 0, I_XS, I_CK, I_CV, I_SP, I_LIG, I_LIB, I_WIN, I_WPOOL, I_PSC, I_LQK, I_SUBLN, I_WA, I_WB, I_WO, I_LNG, I_LNB };

constexpr int POOL_TILE_PITCH = 272, POOL_TILE_BYTES = 12800, POOL_NITEMS = (MP / 32) * 4 + DEC_BATCH * 4;
__device__ __forceinline__ void pool_item(int item, int layer, const Params& P, LAS unsigned char* tile) {
    const int lane = fresh_tid(0);
    constexpr int NPI = (MP / 32) * 4;
    const bool samp = item >= NPI;
    int g, R0, nrows;
    if (!samp) { g = item / (MP / 32); R0 = (item % (MP / 32)) * 32; nrows = 32; } else { const int si = item - NPI; g = si / DEC_BATCH; R0 = MP + (si % DEC_BATCH) * 16; nrows = 16; }
    const int w = 2 << g, ntr = 15 + nrows;
    const bf16_t* PXB = (const bf16_t*)(P.ws + WS_PXB); const bf16_t* SPG = (const bf16_t*)(P.ws + WS_SPG); bf16_t* YA = (bf16_t*)(P.ws + WS_YAB);
    const bf16_t* WpT = (const bf16_t*)(P.ws + WS_WP) + (size_t)(layer * 4 + g) * 128 * 128;
    if (!samp) {
        const int t0 = R0 & (SEQ - 1);
        u32x4v v[12];
#pragma unroll
        for (int i = 0; i < 12; ++i) { const int p = i * 64 + lane, trow = p >> 4, c16 = p & 15; const bool ok = trow < ntr && (t0 + trow - 15) >= 0;
            const int grow = ok ? (R0 - 15 + trow) : R0; v[i] = *(const u32x4v*)(PXB + (size_t)grow * 512 + g * 128 + c16 * 8); if (!ok) v[i] = (u32x4v){0u, 0u, 0u, 0u}; }
#pragma unroll
        for (int i = 0; i < 12; ++i) { const int p = i * 64 + lane, trow = p >> 4, c16 = p & 15; if (trow < ntr) *(LAS u32x4v*)(tile + trow * POOL_TILE_PITCH + c16 * 16) = v[i]; }
    } else {
        const float* hist = P.in[I_SP] + ((size_t)layer * DEC_BATCH + ((R0 - MP) >> 4)) * 15 * 512 + g * 128;
#pragma unroll
        for (int i = 0; i < 8; ++i) { const int p = i * 64 + lane, trow = p >> 4, c16 = p & 15;
            if (trow < ntr) { u32x4v v;
                if (trow >= 15) v = *(const u32x4v*)(PXB + (size_t)(R0 + trow - 15) * 512 + g * 128 + c16 * 8);
                else { const float* hp = hist + (size_t)trow * 512 + c16 * 8; const f32x4 h0 = *(const f32x4*)hp, h1 = *(const f32x4*)(hp + 4);
                    v.x = pkbf(h0[0], h0[1]); v.y = pkbf(h0[2], h0[3]); v.z = pkbf(h1[0], h1[1]); v.w = pkbf(h1[2], h1[3]); }
                *(LAS u32x4v*)(tile + trow * POOL_TILE_PITCH + c16 * 16) = v; } }
    }
    asm volatile("s_waitcnt lgkmcnt(0)" ::: "memory");
    const int r = lane & 31, hi = lane >> 5, rl = r & (nrows - 1), row = R0 + rl;
    bf16x8 afirst[8];
#pragma unroll
    for (int s = 0; s < 8; ++s) afirst[s] = *(const bf16x8*)(WpT + (size_t)r * 128 + 16 * s + 8 * hi);
    int cnt = w; if (!samp) { const int navail = (row & (SEQ - 1)) + 1; cnt = navail < w ? navail : w; }
    const float rcnt = 1.f / (float)cnt;
    bf16x8 bfr[8];
#pragma unroll
    for (int s = 0; s < 8; ++s) {
        const LAS unsigned char* bp = tile + (15 + rl) * POOL_TILE_PITCH + (16 * s + 8 * hi) * 2;
        const u32x4v tk = *(const LAS u32x4v*)bp;
        const float t0[8] = {bflo(tk.x), bfhi(tk.x), bflo(tk.y), bfhi(tk.y), bflo(tk.z), bfhi(tk.z), bflo(tk.w), bfhi(tk.w)};
        float a[8];
#pragma unroll
        for (int k = 0; k < 8; ++k) a[k] = t0[k];
#pragma unroll 4
        for (int d = 1; d < w; ++d) { const u32x4v v = *(const LAS u32x4v*)(bp - d * POOL_TILE_PITCH);
            a[0] += bflo(v.x); a[1] += bfhi(v.x); a[2] += bflo(v.y); a[3] += bfhi(v.y); a[4] += bflo(v.z); a[5] += bfhi(v.z); a[6] += bflo(v.w); a[7] += bfhi(v.w); }
        u32x4v pk; pk.x = pkbf(a[0] * rcnt - t0[0], a[1] * rcnt - t0[1]); pk.y = pkbf(a[2] * rcnt - t0[2], a[3] * rcnt - t0[3]);
        pk.z = pkbf(a[4] * rcnt - t0[4], a[5] * rcnt - t0[5]); pk.w = pkbf(a[6] * rcnt - t0[6], a[7] * rcnt - t0[7]);
        bfr[s] = __builtin_bit_cast(bf16x8, pk);
    }
    const float* psc = P.in[I_PSC] + (size_t)layer * 512 + g * 128;
    bf16x8 af[2][8];
#pragma unroll
    for (int db = 0; db < 4; ++db) {
        if (db == 0) {
#pragma unroll
            for (int s = 0; s < 8; ++s) af[0][s] = afirst[s];
        }
        if (db < 3) {
#pragma unroll
            for (int s = 0; s < 8; ++s) af[(db + 1) & 1][s] = *(const bf16x8*)(WpT + (size_t)(32 * (db + 1) + r) * 128 + 16 * s + 8 * hi);
        }
        f32x4 sc[4]; u32x2 gt[4];
#pragma unroll
        for (int q = 0; q < 4; ++q) { const int d0 = 32 * db + 8 * q + 4 * hi; sc[q] = *(const f32x4*)(psc + d0); gt[q] = *(const u32x2*)(SPG + (size_t)row * 512 + g * 128 + d0); }
        f32x16 acc = {};
#pragma unroll
        for (int s = 0; s < 8; ++s) acc = __builtin_amdgcn_mfma_f32_32x32x16_bf16(af[db & 1][s], bfr[s], acc, 0, 0, 0);
        if (r < nrows) {
#pragma unroll
        for (int q = 0; q < 4; ++q) { const int d0 = 32 * db + 8 * q + 4 * hi;
            u32x2 o; o.x = pkbf(acc[4 * q] * sc[q][0] * bflo(gt[q].x), acc[4 * q + 1] * sc[q][1] * bfhi(gt[q].x)); o.y = pkbf(acc[4 * q + 2] * sc[q][2] * bflo(gt[q].y), acc[4 * q + 3] * sc[q][3] * bfhi(gt[q].y));
            *(u32x2*)(YA + (size_t)row * 1536 + g * 128 + d0) = o; }
        }
    }
    asm volatile("s_waitcnt lgkmcnt(0)" ::: "memory");
}

__device__ __forceinline__ void combine_rows(size_t rowbase, int h, int layer, const Params& P, int wave) {
    const int tid = fresh_tid(wave);
    const float* O1 = (const float*)(P.ws + WS_O1); const float* O2 = (const float*)(P.ws + WS_O2);
    const bf16_t* SAG = (const bf16_t*)(P.ws + WS_SAG); bf16_t* YB = (bf16_t*)(P.ws + WS_YAB) + 512;
    const float* LAM = (const float*)(P.ws + WS_LAM); const float lam = LAM[layer], li = LAM[4 + layer];
    const int rsub = tid >> 4, c8 = (tid & 15) * 8;
    const float* sl = P.in[I_SUBLN] + (size_t)layer * 128 + c8;
    const f32x4 s0 = *(const f32x4*)sl, s1 = *(const f32x4*)(sl + 4);
#pragma unroll 2
    for (int p = 0; p < 8; ++p) {
        const size_t rowi = rowbase + p * 32 + rsub, base = rowi * 1024 + h * 128 + c8;
        const f32x4 a0 = *(const f32x4*)(O1 + base) - lam * *(const f32x4*)(O2 + base), a1 = *(const f32x4*)(O1 + base + 4) - lam * *(const f32x4*)(O2 + base + 4);
        float ss = (a0[0] * a0[0] + a0[1] * a0[1]) + (a0[2] * a0[2] + a0[3] * a0[3]) + (a1[0] * a1[0] + a1[1] * a1[1]) + (a1[2] * a1[2] + a1[3] * a1[3]);
        ss += xor_swz<1>(ss); ss += xor_swz<2>(ss); ss += xor_swz<4>(ss); ss += xor_swz<8>(ss);
        const float rr = (1.f - li) / sqrtf(ss * (1.f / 128.f) + RMS_EPS);
        const u32x4v gt = *(const u32x4v*)(SAG + base);
        u32x4v o; o.x = pkbf(a0[0] * rr * s0[0] * bflo(gt.x), a0[1] * rr * s0[1] * bfhi(gt.x)); o.y = pkbf(a0[2] * rr * s0[2] * bflo(gt.y), a0[3] * rr * s0[3] * bfhi(gt.y));
        o.z = pkbf(a1[0] * rr * s1[0] * bflo(gt.z), a1[1] * rr * s1[1] * bfhi(gt.z)); o.w = pkbf(a1[2] * rr * s1[2] * bflo(gt.w), a1[3] * rr * s1[3] * bfhi(gt.w));
        *(u32x4v*)(YB + rowi * 1536 + h * 128 + c8) = o;
    }
}

__device__ __forceinline__ void sample_unit(int b, int h, int layer, const Params& P, LAS unsigned char* L, int wave) {
    const int tid = fresh_tid(wave), lane = tid & 63;
    const int r = lane & 31, hi = lane >> 5;
    const bf16_t* QB = (const bf16_t*)(P.ws + WS_QB);
    const bf16_t* qrow = QB + (size_t)(MP + b * 16 + (r & 15)) * 1024 + h * 128 + 8 * hi;
    bf16x8 qf[8];
#pragma unroll
    for (int s = 0; s < 8; ++s) { const bool nz = (s < 4) ? (r < 16) : (r >= 16); bf16x8 z = {}; qf[s] = nz ? *(const bf16x8*)(qrow + 16 * s) : z; }
    f32x16 ot[4]; ot[0] = f32x16{}; ot[1] = f32x16{}; ot[2] = f32x16{}; ot[3] = f32x16{};
    float mrun = -INFINITY, lrun = 0.f;
    const float* ck = P.in[I_CK] + ((size_t)(layer * DEC_BATCH + b) * PAST) * 1024 + h * 128;
    const float* cv = P.in[I_CV] + ((size_t)(layer * DEC_BATCH + b) * PAST) * 1024 + h * 128;
    const float* nk = P.out + O_KS + ((size_t)layer * MS + b * 16) * 1024 + h * 128;
    const float* nv = P.out + O_VS + ((size_t)layer * MS + b * 16) * 1024 + h * 128;
    const int ntile = (wave == 0) ? 5 : 4;
    for (int ti = 0; ti < ntile; ++ti) {
        const bool newt = ti == 4;
        const float* kb = newt ? nk : ck + (size_t)(32 * (wave + 8 * ti)) * 1024;
        const float* vb = newt ? nv : cv + (size_t)(32 * (wave + 8 * ti)) * 1024;
        const int rmask = newt ? 15 : 31;
        const float* kr = kb + (size_t)(r & rmask) * 1024 + 8 * hi;
        f32x4 kraw[16];
#pragma unroll
        for (int s = 0; s < 8; ++s) { kraw[2 * s] = *(const f32x4*)(kr + 16 * s); kraw[2 * s + 1] = *(const f32x4*)(kr + 16 * s + 4); }
        float vraw[32];
#pragma unroll
        for (int c = 0; c < 4; ++c)
#pragma unroll
            for (int j = 0; j < 8; ++j) { const int key = (8 * (j >> 2) + 4 * hi + (j & 3)) & rmask; vraw[c * 8 + j] = vb[(size_t)key * 1024 + 32 * c + r]; }
        __builtin_amdgcn_sched_barrier(0);
        f32x16 st = {};
#pragma unroll
        for (int s = 0; s < 8; ++s) { const f32x4 k0 = kraw[2 * s], k1 = kraw[2 * s + 1];
            u32x4v pk; pk.x = pkbf(k0[0], k0[1]); pk.y = pkbf(k0[2], k0[3]); pk.z = pkbf(k1[0], k1[1]); pk.w = pkbf(k1[2], k1[3]);
            st = __builtin_amdgcn_mfma_f32_32x32x16_bf16(__builtin_bit_cast(bf16x8, pk), qf[s], st, 0, 0, 0); }
        float vraw2[32];
#pragma unroll
        for (int c = 0; c < 4; ++c)
#pragma unroll
            for (int j = 0; j < 8; ++j) { const int key = (16 + 8 * (j >> 2) + 4 * hi + (j & 3)) & rmask; vraw2[c * 8 + j] = vb[(size_t)key * 1024 + 32 * c + r]; }
        __builtin_amdgcn_sched_barrier(0);
        if (newt) {
#pragma unroll
            for (int q = 8; q < 16; ++q) st[q] = -INFINITY;
        }
        float tm = st[0];
#pragma unroll
        for (int q = 1; q < 16; ++q) tm = fmaxf(tm, st[q]);
        tm = max_halves(tm);
        const float mnew = fmaxf(mrun, tm), f = __builtin_amdgcn_exp2f(mrun - mnew);
        mrun = mnew; lrun *= f;
#pragma unroll
        for (int c = 0; c < 4; ++c) ot[c] = ot[c] * f;
        float ps = 0.f;
#pragma unroll
        for (int q = 0; q < 16; ++q) { st[q] = __builtin_amdgcn_exp2f(st[q] - mnew); ps += st[q]; }
        lrun += ps;
        bf16x8 pf[2];
#pragma unroll
        for (int sp = 0; sp < 2; ++sp) { u32x4v pk; pk.x = pkbf(st[8 * sp], st[8 * sp + 1]); pk.y = pkbf(st[8 * sp + 2], st[8 * sp + 3]); pk.z = pkbf(st[8 * sp + 4], st[8 * sp + 5]); pk.w = pkbf(st[8 * sp + 6], st[8 * sp + 7]);
            pf[sp] = __builtin_bit_cast(bf16x8, pk); }
#pragma unroll
        for (int c = 0; c < 4; ++c) { u32x4v pk; pk.x = pkbf(vraw[c * 8], vraw[c * 8 + 1]); pk.y = pkbf(vraw[c * 8 + 2], vraw[c * 8 + 3]); pk.z = pkbf(vraw[c * 8 + 4], vraw[c * 8 + 5]); pk.w = pkbf(vraw[c * 8 + 6], vraw[c * 8 + 7]);
            ot[c] = __builtin_amdgcn_mfma_f32_32x32x16_bf16(__builtin_bit_cast(bf16x8, pk), pf[0], ot[c], 0, 0, 0); }
#pragma unroll
        for (int c = 0; c < 4; ++c) { u32x4v pk; pk.x = pkbf(vraw2[c * 8], vraw2[c * 8 + 1]); pk.y = pkbf(vraw2[c * 8 + 2], vraw2[c * 8 + 3]); pk.z = pkbf(vraw2[c * 8 + 4], vraw2[c * 8 + 5]); pk.w = pkbf(vraw2[c * 8 + 6], vraw2[c * 8 + 7]);
            ot[c] = __builtin_amdgcn_mfma_f32_32x32x16_bf16(__builtin_bit_cast(bf16x8, pk), pf[1], ot[c], 0, 0, 0); }
    }
    lrun = sum_halves(lrun);
    LAS float* SM_M = (LAS float*)(L + RING_OFF);
    LAS float* SM_R = (LAS float*)(L + RING_OFF + 1024);
    LAS float* SM_O = (LAS float*)(L + RING_OFF + 1024 + 4 * 64 * 65 * 4);
    if (hi == 0) SM_M[wave * 32 + r] = mrun;
    __syncthreads();
    float mfin = SM_M[r];
#pragma unroll
    for (int w2 = 1; w2 < 8; ++w2) mfin = fmaxf(mfin, SM_M[w2 * 32 + r]);
    { const float sc = __builtin_amdgcn_exp2f(mrun - mfin); lrun *= sc;
#pragma unroll
      for (int c = 0; c < 4; ++c) ot[c] = ot[c] * sc; }
#pragma unroll
    for (int step = 4; step >= 1; step >>= 1) {
        if (wave >= step && wave < 2 * step) { LAS float* dst = SM_R + ((wave - step) * 64 + lane) * 65; dst[64] = lrun;
#pragma unroll
            for (int c = 0; c < 4; ++c)
#pragma unroll
                for (int q = 0; q < 16; ++q) dst[c * 16 + q] = ot[c][q]; }
        __syncthreads();
        if (wave < step) { const LAS float* src = SM_R + (wave * 64 + lane) * 65; lrun += src[64];
#pragma unroll
            for (int c = 0; c < 4; ++c)
#pragma unroll
                for (int q = 0; q < 16; ++q) ot[c][q] += src[c * 16 + q]; }
        __syncthreads();
    }
    if (wave == 0) { const float il = 1.f / lrun;
#pragma unroll
        for (int c = 0; c < 4; ++c)
#pragma unroll
            for (int q = 0; q < 16; ++q) SM_O[r * 129 + 32 * c + crow16(q, hi)] = ot[c][q] * il; }
    __syncthreads();
    {
        const float* LAM = (const float*)(P.ws + WS_LAM); const float lam = LAM[layer], li = LAM[4 + layer];
        const int q = tid >> 5, vd0 = (tid & 31) * 4;
        float a[4]; float ss = 0.f;
#pragma unroll
        for (int k = 0; k < 4; ++k) { a[k] = SM_O[q * 129 + vd0 + k] - lam * SM_O[(q + 16) * 129 + vd0 + k]; ss += a[k] * a[k]; }
        ss += xor_swz<1>(ss); ss += xor_swz<2>(ss); ss += xor_swz<4>(ss); ss += xor_swz<8>(ss); ss += xor_swz<16>(ss);
        const float rr = (1.f - li) / sqrtf(ss * (1.f / 128.f) + RMS_EPS);
        const size_t base = (size_t)(MP + b * 16 + q) * 1024 + h * 128 + vd0;
        const f32x4 sl = *(const f32x4*)(P.in[I_SUBLN] + (size_t)layer * 128 + vd0);
        const u32x2 gt = *(const u32x2*)((const bf16_t*)(P.ws + WS_SAG) + base);
        u32x2 o; o.x = pkbf(a[0] * rr * sl[0] * bflo(gt.x), a[1] * rr * sl[1] * bfhi(gt.x)); o.y = pkbf(a[2] * rr * sl[2] * bflo(gt.y), a[3] * rr * sl[3] * bfhi(gt.y));
        *(u32x2*)((bf16_t*)(P.ws + WS_YAB) + (size_t)(MP + b * 16 + q) * 1536 + 512 + h * 128 + vd0) = o;
    }
    __syncthreads();
}

__global__ void __launch_bounds__(NWAVES * 64, 2) mk_fwd(Params P) {
    extern __shared__ __attribute__((aligned(16))) unsigned char lds[];
    LAS unsigned char* L = (LAS unsigned char*)lds;
    const int wave = __builtin_amdgcn_readfirstlane(threadIdx.x >> 6);
    const int G = gridDim.x, bx = blockIdx.x, vcu = (G % 8 == 0) ? (bx % 8) * (G / 8) + bx / 8 : bx;
    const int gw = vcu * NWAVES + wave, NGW = G * NWAVES;
    for (int u = fresh_tid(wave); u < (LDS_BYTES - LDSCTL_OFF) / 4; u += NWAVES * 64) ((LAS unsigned*)(L + LDSCTL_OFF))[u] = 0u;
    __syncthreads();
    unsigned char* ws = P.ws;
    XcdBarrier bar = xcd_barrier_post((unsigned*)(ws + WS_CTL) + CW_BAR + P.bar_region * XCD_BAR_WORDS, (volatile LAS unsigned*)(L + MISC_OFF) + 8);
    bf16_t* WinT = (bf16_t*)(ws + WS_WIN); bf16_t* WabT = (bf16_t*)(ws + WS_WAB); bf16_t* WoT = (bf16_t*)(ws + WS_WO); bf16_t* WpT = (bf16_t*)(ws + WS_WP);
    float* X = (float*)(ws + WS_X); bf16_t* XB = (bf16_t*)(ws + WS_XB);
    float* ropec = (float*)(ws + WS_ROPEC); float* ropes = (float*)(ws + WS_ROPES);

#ifndef NO_P0
    if (P.do_pro) for (int rp_ = 0; rp_ < REP_P0; ++rp_) {
        const int tid = fresh_tid(wave), lane = tid & 63;
        LAS float* scr = (LAS float*)(L + RING_OFF + wave * 16384);
        constexpr int I_IN = 16 * (D_IN / 32), I_A = 8 * 32, I_B = 16 * 32, I_P = 2 * 4;
        constexpr int N_IN = DEPTH * I_IN, N_A = DEPTH * I_A, N_B = DEPTH * I_B, N_P = DEPTH * 4 * I_P;
        constexpr int NITEMS = N_IN + N_A + 2 * N_B + N_P;
        for (int it = gw; it < NITEMS; it += NGW) {
            int rr = it;
            if (rr < N_IN) { const int l = rr / I_IN; p0_transpose_item<1>(P.in[I_WIN] + (size_t)l * 1024 * D_IN, 1024, D_IN, WinT + (size_t)l * D_IN * 1024, 1024, scr, rr % I_IN, lane); continue; } rr -= N_IN;
            if (rr < N_A) { const int l = rr / I_A; p0_transpose_item<0>(P.in[I_WA] + (size_t)l * 512 * 1024, 512, 1024, WabT + (size_t)l * 1024 * 1536, 1536, scr, rr % I_A, lane); continue; } rr -= N_A;
            if (rr < N_B) { const int l = rr / I_B; p0_transpose_item<0>(P.in[I_WB] + (size_t)l * 1024 * 1024, 1024, 1024, WabT + (size_t)l * 1024 * 1536 + 512, 1536, scr, rr % I_B, lane); continue; } rr -= N_B;
            if (rr < N_B) { const int l = rr / I_B; p0_transpose_item<0>(P.in[I_WO] + (size_t)l * 1024 * 1024, 1024, 1024, WoT + (size_t)l * 1024 * 1024, 1024, scr, rr % I_B, lane); continue; } rr -= N_B;
            { const int lg = rr / I_P; p0_transpose_item<0>(P.in[I_WPOOL] + (size_t)lg * 128 * 128, 128, 128, WpT + (size_t)lg * 128 * 128, 128, scr, rr % I_P, lane); }
        }
        for (int e = gw * 64 + lane; e < SEQ * 32; e += NGW * 64) {
            const int pos = e >> 5, i = e & 31;
            const double inv = exp(-(double)i * (9.210340371976184 / 32.0)), ang = (double)pos * inv;
            ropec[e] = (float)cos(ang); ropes[e] = (float)sin(ang);
        }
        if (bx == 0 && tid < DEPTH) {
            const float* lq = P.in[I_LQK] + tid * 256; float s1 = 0.f, s2 = 0.f;
            for (int i = 0; i < 64; ++i) { s1 += lq[i] * lq[64 + i]; s2 += lq[128 + i] * lq[192 + i]; }
            const float li = 0.8f - 0.6f * expf(-0.3f * (float)tid);
            float* LAM = (float*)(ws + WS_LAM); LAM[tid] = expf(s1) - expf(s2) + li; LAM[4 + tid] = li;
        }
        for (int m = gw; m < M; m += NGW) {
            const float* xr = (m < MP) ? P.in[I_XP] + (size_t)m * 1024 : P.in[I_XS] + (size_t)(m - MP) * 1024;
            ln_row(xr, P.in[I_LIG], P.in[I_LIB], X + (size_t)m * 1024, XB + (size_t)m * 1024);
        }
        xcd_barrier(bar);
    }
#endif

    for (int l = P.l_lo; l < P.l_hi; ++l) {
#ifndef NO_P1
        for (int rp_ = 0; rp_ < REP_P1; ++rp_) {
            if (rp_) xcd_barrier(bar);
            pg8::Gemm g{XB, WinT + (size_t)l * D_IN * 1024, M, D_IN, 1024}; pg8::StaticOrder S; S.init(M, D_IN, G, bx);
            EpiIn E{(bf16_t*)(ws + WS_PXB), (bf16_t*)(ws + WS_SPG), (bf16_t*)(ws + WS_QB), (bf16_t*)(ws + WS_KB), (bf16_t*)(ws + WS_VB), (bf16_t*)(ws + WS_SAG), (bf16_t*)(ws + WS_SGA), (bf16_t*)(ws + WS_SGB), (bf16_t*)(ws + WS_RSB),
                    P.out, ropec, ropes, l};
            pg8::gemm_phase<EpiIn, pg8::StaticOrder, true, true>(L + RING_OFF, g, S, E, wave);
        }
#endif
        xcd_barrier(bar);
#ifndef NO_SAMPLE
        for (int rp_ = 0; rp_ < REP_SAMPLE; ++rp_)
        for (int su = vcu; su < DEC_BATCH * 8; su += G) sample_unit(su >> 3, su & 7, l, P, L, wave);
#endif
#ifndef NO_POOL
        for (int rp_ = 0; rp_ < REP_POOL; ++rp_)
        for (int it = gw; it < POOL_NITEMS; it += NGW) pool_item(it, l, P, L + RING_OFF + wave * POOL_TILE_BYTES);
        __syncthreads();
#endif
#ifndef NO_ATTN
        for (int rp_ = 0; rp_ < REP_ATTN; ++rp_)
        for (int su = vcu; su < 256; su += G) {
            const int bh = su >> 2, s4 = su & 3, b = bh >> 3, h = bh & 7;
            const size_t bo = (size_t)b * SEQ * 1024 + h * 128;
            for (int i = 0; i < 4; ++i) {
                const int qb = (i == 0) ? s4 : (i == 1) ? 7 - s4 : (i == 2) ? 8 + s4 : 15 - s4;
                for (int mp = 0; mp < 2; ++mp)
                    attn_body::attn_unit128<8>(qb, (const attn_body::bf16*)(ws + WS_QB) + bo + mp * 64, (const attn_body::bf16*)(ws + WS_KB) + bo + mp * 64,
                                               (const attn_body::bf16*)(ws + WS_VB) + bo, (float*)(ws + (mp ? WS_O2 : WS_O1)) + bo, (char*)lds + RING_OFF, wave);
                asm volatile("s_waitcnt vmcnt(0)" ::: "memory"); __syncthreads();
                combine_rows((size_t)b * SEQ + (size_t)qb * 256, h, l, P, wave);
            }
        }
#endif
        xcd_barrier(bar);
#ifndef NO_P3
        for (int rp_ = 0; rp_ < REP_P3; ++rp_) {
        if (rp_) xcd_barrier(bar);
        {
            pg8::Gemm g{(const bf16_t*)(ws + WS_YAB), WabT + (size_t)l * 1024 * 1536, M, 1024, 1536}; pg8::StaticOrder S; S.init(M, 1024, G, bx);
            EpiMerge E{(const bf16_t*)(ws + WS_SGA), (const bf16_t*)(ws + WS_SGB), (const bf16_t*)(ws + WS_RSB), (bf16_t*)(ws + WS_MG)};
            pg8::gemm_phase<EpiMerge, pg8::StaticOrder, true, true>(L + RING_OFF, g, S, E, wave);
        }
        }
#endif
        xcd_barrier(bar);
#ifndef NO_P4
        {
            pg8::Gemm g{(const bf16_t*)(ws + WS_MG), WoT + (size_t)l * 1024 * 1024, M, 1024, 1024}; pg8::StaticOrder S; S.init(M, 1024, G, bx);
            EpiOut E{X};
            pg8::gemm_phase<EpiOut, pg8::StaticOrder, true, true>(L + RING_OFF, g, S, E, wave);
        }
#endif
        xcd_barrier(bar);
        {
            float* dst = (l == DEPTH - 1) ? P.out + O_Y : X;
            for (int m = gw; m < M; m += NGW) ln_row(X + (size_t)m * 1024, P.in[I_LNG] + (size_t)l * 1024, P.in[I_LNB] + (size_t)l * 1024, dst + (size_t)m * 1024, XB + (size_t)m * 1024);
        }
        if (l + 1 < P.l_hi) xcd_barrier(bar);
    }
}
static int mk_grid_setup() {
    static int grid = 0;
    if (grid == 0) {
        int dev = 0, cus = 0;
        if (hipGetDevice(&dev) != hipSuccess || hipDeviceGetAttribute(&cus, hipDeviceAttributeMultiprocessorCount, dev) != hipSuccess || cus < 8) { fprintf(stderr, "kernel_launch: device query failed\n"); grid = -1; return grid; }
        if (hipFuncSetAttribute((const void*)mk_fwd, hipFuncAttributeMaxDynamicSharedMemorySize, LDS_BYTES) != hipSuccess) { fprintf(stderr, "kernel_launch: hipFuncSetAttribute failed\n"); grid = -1; return grid; }
        int per_cu = 0;
        if (hipOccupancyMaxActiveBlocksPerMultiprocessor(&per_cu, (const void*)mk_fwd, NWAVES * 64, LDS_BYTES) != hipSuccess || per_cu < 1) fprintf(stderr, "kernel_launch: occupancy query reports %d\n", per_cu);
        (void)hipGetLastError();
        grid = cus;
    }
    return grid;
}
static void mk_launch(void* const* d_in, float* out, void* d_ws, int l_lo, int l_hi, int do_pro, int region, hipStream_t stream) {
    const int grid = mk_grid_setup(); if (grid < 0) return;
    Params p{};
    for (int i = 0; i < 17; ++i) p.in[i] = (const float*)d_in[i];
    p.out = out; p.ws = (unsigned char*)d_ws; p.l_lo = l_lo; p.l_hi = l_hi; p.do_pro = do_pro; p.bar_region = region;
    hipLaunchKernelGGL(mk_fwd, dim3(grid), dim3(NWAVES * 64), LDS_BYTES, stream, p);
    const hipError_t le = hipPeekAtLastError();
    if (le != hipSuccess) fprintf(stderr, "kernel_launch: launch failed: %s\n", hipGetErrorName(le));
}

#if !DEBUG_CHECK
extern "C" void kernel_launch(void* const* d_in, const int* in_sizes, int n_in, void* d_out, int out_size, void* d_ws, size_t ws_size, hipStream_t stream) {
    if (n_in != 17 || (size_t)out_size != O_END || ws_size < WS_END || in_sizes[0] != MP * 1024) { fprintf(stderr, "kernel_launch: unexpected sizes n_in %d out %d ws %zu\n", n_in, out_size, ws_size); return; }
    if (hipMemsetAsync((char*)d_ws + WS_CTL, 0, CTL_ZERO_BYTES, stream) != hipSuccess) return;
    mk_launch(d_in, (float*)d_out, d_ws, 0, DEPTH, 1, 0, stream);
}
#else
constexpr int C_PX = 0, C_PG = 512, C_Q = 1024, C_K = 2048, C_V = 3072, C_AG = 4096, C_GA = 5120, C_GB = 6144;
__device__ __forceinline__ float silu_f(float x) { return x / (1.f + __expf(-x)); }
__device__ __forceinline__ float sigmoid_f(float x) { return 1.f / (1.f + __expf(-x)); }
__global__ void __launch_bounds__(256) nv_ln(const float* in, const float* add, float alpha, const float* g, const float* b, float* out, int rows) {
    const int row = blockIdx.x * 4 + (threadIdx.x >> 6), lane = threadIdx.x & 63;
    if (row >= rows) return;
    const float4* xi = (const float4*)(in + (size_t)row * 1024) + lane;
    float4 v[4]; float s = 0.f;
#pragma unroll
    for (int j = 0; j < 4; ++j) {
        v[j] = xi[64 * j];
        if (add) { const float4 a = ((const float4*)(add + (size_t)row * 1024) + lane)[64 * j]; v[j].x = alpha * v[j].x + a.x; v[j].y = alpha * v[j].y + a.y; v[j].z = alpha * v[j].z + a.z; v[j].w = alpha * v[j].w + a.w; }
        s += (v[j].x + v[j].y) + (v[j].z + v[j].w);
    }
    const float mean = wave_sum(s) * (1.f / 1024.f); float s2 = 0.f;
#pragma unroll
    for (int j = 0; j < 4; ++j) { v[j].x -= mean; v[j].y -= mean; v[j].z -= mean; v[j].w -= mean; s2 += (v[j].x * v[j].x + v[j].y * v[j].y) + (v[j].z * v[j].z + v[j].w * v[j].w); }
    const float rstd = 1.f / sqrtf(wave_sum(s2) * (1.f / 1024.f) + LN_EPS);
    float4* o = (float4*)(out + (size_t)row * 1024) + lane;
#pragma unroll
    for (int j = 0; j < 4; ++j) { const float4 gg = ((const float4*)g + lane)[64 * j], bb = ((const float4*)b + lane)[64 * j];
        float4 r; r.x = v[j].x * rstd * gg.x + bb.x; r.y = v[j].y * rstd * gg.y + bb.y; r.z = v[j].z * rstd * gg.z + bb.z; r.w = v[j].w * rstd * gg.w + bb.w; o[64 * j] = r; }
}
__global__ void __launch_bounds__(256) nv_gemm(const float* __restrict__ A, int lda, const float* __restrict__ W, int ldw, float* __restrict__ C, int ldc, int K) {
    __shared__ float As[8][132];
    __shared__ float Ws[8][128];
    const int bm = blockIdx.y * 128, bn = blockIdx.x * 128, tid = threadIdx.x, tx = tid & 15, ty = tid >> 4;
    float acc[8][8];
#pragma unroll
    for (int i = 0; i < 8; ++i)
#pragma unroll
        for (int j = 0; j < 8; ++j) acc[i][j] = 0.f;
    const float* Ap = A + (size_t)(bm + (tid >> 1)) * lda + (tid & 1) * 4;
    const float* Wp = W + (size_t)(tid >> 5) * ldw + bn + (tid & 31) * 4;
    for (int k0 = 0; k0 < K; k0 += 8) {
        const float4 a = *(const float4*)(Ap + k0);
        const float4 w = *(const float4*)(Wp + (size_t)k0 * ldw);
        As[(tid & 1) * 4 + 0][tid >> 1] = a.x; As[(tid & 1) * 4 + 1][tid >> 1] = a.y; As[(tid & 1) * 4 + 2][tid >> 1] = a.z; As[(tid & 1) * 4 + 3][tid >> 1] = a.w;
        *(float4*)&Ws[tid >> 5][(tid & 31) * 4] = w;
        __syncthreads();
#pragma unroll
        for (int kk = 0; kk < 8; ++kk) {
            float av[8], bv[8];
#pragma unroll
            for (int i = 0; i < 8; ++i) av[i] = As[kk][ty * 8 + i];
#pragma unroll
            for (int j = 0; j < 8; ++j) bv[j] = Ws[kk][tx * 8 + j];
#pragma unroll
            for (int i = 0; i < 8; ++i)
#pragma unroll
                for (int j = 0; j < 8; ++j) acc[i][j] += av[i] * bv[j];
        }
        __syncthreads();
    }
#pragma unroll
    for (int i = 0; i < 8; ++i) {
        float* cp = C + (size_t)(bm + ty * 8 + i) * ldc + bn + tx * 8;
        *(float4*)cp = make_float4(acc[i][0], acc[i][1], acc[i][2], acc[i][3]);
        *(float4*)(cp + 4) = make_float4(acc[i][4], acc[i][5], acc[i][6], acc[i][7]);
    }
}
__global__ void nv_lambda(const float* lq, float* lam) {
    const int l = threadIdx.x;
    if (l < DEPTH) {
        float s1 = 0.f, s2 = 0.f;
        for (int i = 0; i < 64; ++i) { s1 += lq[l * 256 + i] * lq[l * 256 + 64 + i]; s2 += lq[l * 256 + 128 + i] * lq[l * 256 + 192 + i]; }
        const float li = 0.8f - 0.6f * expf(-0.3f * (float)l);
        lam[l] = expf(s1) - expf(s2) + li; lam[4 + l] = li;
    }
}
__global__ void __launch_bounds__(256) nv_rope_split(float* H, float* out, int layer) {
    const int row = blockIdx.x;
    const bool samp = row >= MP;
    const int pos = samp ? PAST + ((row - MP) & 15) : (row & (SEQ - 1));
    float* h = H + (size_t)row * D_IN;
    float* ko = samp ? out + O_KS + ((size_t)layer * MS + (row - MP)) * 1024 : out + O_KP + ((size_t)layer * MP + row) * 1024;
    float* vo = samp ? out + O_VS + ((size_t)layer * MS + (row - MP)) * 1024 : out + O_VP + ((size_t)layer * MP + row) * 1024;
    for (int p = threadIdx.x; p < 1024; p += 256) {
        const int pp = p & 511, blk = pp >> 5, i = pp & 31;
        const int c = (p < 512 ? C_Q : C_K) + blk * 64 + i;
        const double inv = exp(-(double)i / 32.0 * 9.210340371976184);
        const double ang = (double)pos * inv;
        const float cs = (float)cos(ang), sn = (float)sin(ang);
        const float x1 = h[c], x2 = h[c + 32];
        const float r1 = x1 * cs - x2 * sn, r2 = x2 * cs + x1 * sn;
        h[c] = r1; h[c + 32] = r2;
        if (p >= 512) { ko[blk * 64 + i] = r1; ko[blk * 64 + i + 32] = r2; }
    }
    for (int c = threadIdx.x; c < 1024; c += 256) vo[c] = h[C_V + c];
    if (!samp) { const int t = row & (SEQ - 1), b = row >> 12;
        if (t >= SEQ - 15) { float* po = out + O_PP + (((size_t)layer * BATCH + b) * 15 + (t - (SEQ - 15))) * 512; for (int c = threadIdx.x; c < 512; c += 256) po[c] = h[C_PX + c]; }
    } else { const int j = (row - MP) & 15, b = (row - MP) >> 4;
        if (j >= 1) { float* po = out + O_PS + (((size_t)layer * DEC_BATCH + b) * 15 + (j - 1)) * 512; for (int c = threadIdx.x; c < 512; c += 256) po[c] = h[C_PX + c]; }
    }
}
__global__ void __launch_bounds__(256) nv_pool(const float* H, const float* state_pool_l, float* pooled) {
    const int row = blockIdx.x;
    const bool samp = row >= MP;
    for (int c = threadIdx.x; c < 512; c += 256) {
        const int g = c >> 7, w = 2 << g;
        float s = 0.f; int cnt;
        if (!samp) { const int t = row & (SEQ - 1); cnt = (t + 1 < w) ? t + 1 : w;
            for (int d = 0; d < cnt; ++d) s += H[(size_t)(row - d) * D_IN + C_PX + c];
        } else { const int j = (row - MP) & 15, b = (row - MP) >> 4; cnt = w;
            for (int d = 0; d < w; ++d) { const int jj = j - d;
                s += (jj >= 0) ? H[(size_t)(row - d) * D_IN + C_PX + c] : state_pool_l[((size_t)b * 15 + (15 + jj)) * 512 + c]; }
        }
        pooled[(size_t)row * 512 + c] = s / (float)cnt - H[(size_t)row * D_IN + C_PX + c];
    }
}
__global__ void __launch_bounds__(256) nv_ya_gate(float* ya, const float* H, const float* pool_scale_l) {
    const int row = blockIdx.x;
    for (int c = threadIdx.x; c < 512; c += 256) ya[(size_t)row * 512 + c] *= pool_scale_l[c] * silu_f(H[(size_t)row * D_IN + C_PG + c]);
}
__global__ void __launch_bounds__(64) nv_attn(const float* __restrict__ H, int rowbase0, int rows_per_batch, int nq,
                                             const float* __restrict__ cK, const float* __restrict__ cV, int n1, int causal, float* O1, float* O2) {
    __shared__ float Ks[16][64];
    __shared__ float Vs[16][128];
    const int qb = blockIdx.x, hm = blockIdx.y, b = blockIdx.z, h = hm >> 1, mp = hm & 1, t = threadIdx.x;
    const int rowb = rowbase0 + b * rows_per_batch;
    const int qrow = rowb + qb * 64 + t;
    const bool act = t < nq;
    float q[64];
#pragma unroll
    for (int d = 0; d < 64; ++d) q[d] = act ? H[(size_t)qrow * D_IN + C_Q + h * 128 + mp * 64 + d] * 0.125f : 0.f;
    float o[128];
#pragma unroll
    for (int d = 0; d < 128; ++d) o[d] = 0.f;
    float mx = -INFINITY, l = 0.f;
    const int n2 = causal ? (qb + 1) * 64 : rows_per_batch;
    const int ntot = n1 + n2;
    for (int k0 = 0; k0 < ntot; k0 += 16) {
        __syncthreads();
#pragma unroll
        for (int i = 0; i < 16; ++i) { const int idx = i * 64 + t, kj = idx >> 6, d = idx & 63, key = k0 + kj;
            float v = 0.f;
            if (key < ntot) v = (key < n1) ? cK[((size_t)b * n1 + key) * 1024 + h * 128 + mp * 64 + d] : H[(size_t)(rowb + key - n1) * D_IN + C_K + h * 128 + mp * 64 + d];
            Ks[kj][d] = v; }
#pragma unroll
        for (int i = 0; i < 32; ++i) { const int idx = i * 64 + t, kj = idx >> 7, d = idx & 127, key = k0 + kj;
            float v = 0.f;
            if (key < ntot) v = (key < n1) ? cV[((size_t)b * n1 + key) * 1024 + h * 128 + d] : H[(size_t)(rowb + key - n1) * D_IN + C_V + h * 128 + d];
            Vs[kj][d] = v; }
        __syncthreads();
        const int kend = (ntot - k0 < 16) ? ntot - k0 : 16;
        for (int kj = 0; kj < kend; ++kj) {
            float s = 0.f;
#pragma unroll
            for (int d = 0; d < 64; ++d) s += q[d] * Ks[kj][d];
            const float mn = fmaxf(mx, s), f = __expf(mx - mn), p = __expf(s - mn);
            l = l * f + p; mx = mn;
#pragma unroll
            for (int d = 0; d < 128; ++d) o[d] = o[d] * f + p * Vs[kj][d];
        }
    }
    if (act) { float* O = (mp ? O2 : O1) + (size_t)qrow * 1024 + h * 128; const float il = 1.f / l;
#pragma unroll
        for (int d = 0; d < 128; d += 4) *(float4*)(O + d) = make_float4(o[d] * il, o[d + 1] * il, o[d + 2] * il, o[d + 3] * il); }
}
__global__ void __launch_bounds__(256) nv_combine(const float* O1, const float* O2, const float* lam, int layer, const float* subln_l, const float* H, float* YB) {
    const int idx = blockIdx.x * 4 + (threadIdx.x >> 6), lane = threadIdx.x & 63;
    const int row = idx >> 3, h = idx & 7;
    const float lm = lam[layer], li = lam[4 + layer];
    const size_t base = (size_t)row * 1024 + h * 128;
    const float a0 = O1[base + lane] - lm * O2[base + lane], a1 = O1[base + 64 + lane] - lm * O2[base + 64 + lane];
    const float ms = wave_sum(a0 * a0 + a1 * a1) * (1.f / 128.f);
    const float r = 1.f / sqrtf(ms + RMS_EPS) * (1.f - li);
    YB[base + lane] = a0 * r * subln_l[lane] * silu_f(H[(size_t)row * D_IN + C_AG + h * 128 + lane]);
    YB[base + 64 + lane] = a1 * r * subln_l[64 + lane] * silu_f(H[(size_t)row * D_IN + C_AG + h * 128 + 64 + lane]);
}
__global__ void __launch_bounds__(256) nv_merge(float* TA, const float* TB, const float* H) {
    const int row = blockIdx.x;
    for (int c = threadIdx.x; c < 1024; c += 256) { const size_t i = (size_t)row * 1024 + c;
        TA[i] = sigmoid_f(H[(size_t)row * D_IN + C_GA + c]) * TA[i] + sigmoid_f(H[(size_t)row * D_IN + C_GB + c]) * TB[i]; }
}
__global__ void __launch_bounds__(256) dbg_cmp(const void* a, int a_bf16, int lda, const float* b, int ldb, int rows, int cols, float ascale, int bact, float* err, int slot) {
    __shared__ float red[2][4];
    float num = 0.f, den = 0.f;
    const size_t n = (size_t)rows * cols;
    for (size_t i = (size_t)blockIdx.x * 256 + threadIdx.x; i < n; i += (size_t)gridDim.x * 256) {
        const size_t r = i / cols, c = i % cols;
        float av = a_bf16 ? __uint_as_float((unsigned)((const unsigned short*)a)[r * lda + c] << 16) : ((const float*)a)[r * lda + c];
        float bv = b[r * ldb + c];
        if (bact == 1) bv = silu_f(bv); else if (bact == 2) bv = sigmoid_f(bv);
        const float d = av * ascale - bv; num += d * d; den += bv * bv;
    }
    num = wave_sum(num); den = wave_sum(den);
    if ((threadIdx.x & 63) == 0) { red[0][threadIdx.x >> 6] = num; red[1][threadIdx.x >> 6] = den; }
    __syncthreads();
    if (threadIdx.x == 0) { atomicAdd(err + 2 * slot, red[0][0] + red[0][1] + red[0][2] + red[0][3]); atomicAdd(err + 2 * slot + 1, red[1][0] + red[1][1] + red[1][2] + red[1][3]); }
}
#ifndef DBG_SLOT
#define DBG_SLOT -1
#endif
__global__ void dbg_final(const float* err, int nslots, float tol, float* pool_sample, int n) {
    __shared__ float sc;
    if (threadIdx.x == 0) {
        float s = 1.f;
        if (DBG_SLOT >= 0) { const float e = err[2 * DBG_SLOT] / fmaxf(err[2 * DBG_SLOT + 1], 1e-30f); s = 1.f + sqrtf(fminf(e, 4.f)); }
        else { for (int i = 0; i < nslots; ++i) { const float e = err[2 * i] / fmaxf(err[2 * i + 1], 1e-30f); if (!(e <= tol)) { s = 1.f + 0.01f * (float)(i + 1); break; } } }
        sc = s;
    }
    __syncthreads();
    for (int i = blockIdx.x * 256 + threadIdx.x; i < n; i += gridDim.x * 256) pool_sample[i] *= sc;
}
#define NSLOT_L 24
extern "C" void kernel_launch(void* const* d_in, const int* in_sizes, int n_in, void* d_out, int out_size, void* d_ws, size_t ws_size, hipStream_t stream) {
    const float* x_prompt = (const float*)d_in[0]; const float* x_sample = (const float*)d_in[1];
    const float* cache_k = (const float*)d_in[2]; const float* cache_v = (const float*)d_in[3]; const float* state_pool = (const float*)d_in[4];
    const float* ln_in_g = (const float*)d_in[5]; const float* ln_in_b = (const float*)d_in[6]; const float* w_in = (const float*)d_in[7];
    const float* w_pool = (const float*)d_in[8]; const float* pool_scale = (const float*)d_in[9]; const float* lambda_qk = (const float*)d_in[10];
    const float* subln_w = (const float*)d_in[11]; const float* w_a = (const float*)d_in[12]; const float* w_b = (const float*)d_in[13];
    const float* w_o = (const float*)d_in[14]; const float* ln_g = (const float*)d_in[15]; const float* ln_b = (const float*)d_in[16];
    float* out = (float*)d_out;
    const size_t R = RB4;
    const size_t NV0 = 1300 * MiB;
    const size_t NV_END = NV0 + 4096 + R + (size_t)M * D_IN * 4 + 7 * R;
    const size_t OUT2 = NV_END;
    const size_t need = OUT2 + O_END * 4;
    if (n_in != 17 || (size_t)out_size != O_END || ws_size < need) { fprintf(stderr, "kernel_launch: unexpected sizes n_in %d out %d ws %zu need %zu\n", n_in, out_size, ws_size, need); return; }
    unsigned char* ws = (unsigned char*)d_ws;
    hipMemsetAsync(ws + WS_CTL, 0, CTL_ZERO_BYTES, stream);
    float* ERR = (float*)(ws + WS_CTL + 512 * 1024);
    float* LAM = (float*)(ws + NV0);
    float* X = (float*)(ws + NV0 + 4096);
    float* H = (float*)(ws + NV0 + 4096 + R);
    unsigned char* p = ws + NV0 + 4096 + R + (size_t)M * D_IN * 4;
    float* POOLED = (float*)p; float* YA = (float*)(p + R / 2);
    float* O1 = (float*)(p + R); float* O2 = (float*)(p + 2 * R); float* YB = (float*)(p + 3 * R);
    float* TA = (float*)(p + 4 * R); float* TB = (float*)(p + 5 * R); float* OUTB = (float*)(p + 6 * R);
    float* out2 = (float*)(ws + OUT2);
    const void* oXB = ws + WS_XB; const void* oPXB = ws + WS_PXB; const void* oSPG = ws + WS_SPG; const void* oQB = ws + WS_QB; const void* oKB = ws + WS_KB; const void* oVB = ws + WS_VB;
    const void* oSAG = ws + WS_SAG; const void* oSGA = ws + WS_SGA; const void* oSGB = ws + WS_SGB; const void* oO1 = ws + WS_O1; const void* oO2 = ws + WS_O2;
    const void* oYA = ws + WS_YAB; const void* oYB = (const unsigned short*)(ws + WS_YAB) + 512; const void* oMG = ws + WS_MG; const void* oX = ws + WS_X;
#define CMP(slot, a, abf, lda, b, ldb, rows, cols, asc, bact) dbg_cmp<<<1024, 256, 0, stream>>>(a, abf, lda, b, ldb, rows, cols, asc, bact, ERR, slot)

    nv_lambda<<<1, 64, 0, stream>>>(lambda_qk, LAM);
    nv_ln<<<MP / 4, 256, 0, stream>>>(x_prompt, nullptr, 1.f, ln_in_g, ln_in_b, X, MP);
    nv_ln<<<MS / 4, 256, 0, stream>>>(x_sample, nullptr, 1.f, ln_in_g, ln_in_b, X + (size_t)MP * 1024, MS);
    for (int l = 0; l < DEPTH; ++l) {
        const int s0 = l * NSLOT_L;
        mk_launch(d_in, out2, d_ws, l, l + 1, l == 0, l, stream);
        nv_gemm<<<dim3(D_IN / 128, M / 128), 256, 0, stream>>>(X, 1024, w_in + (size_t)l * 1024 * D_IN, D_IN, H, D_IN, 1024);
        nv_rope_split<<<M, 256, 0, stream>>>(H, out, l);
        nv_pool<<<M, 256, 0, stream>>>(H, state_pool + (size_t)l * DEC_BATCH * 15 * 512, POOLED);
        for (int g = 0; g < 4; ++g)
            nv_gemm<<<dim3(1, M / 128), 256, 0, stream>>>(POOLED + g * 128, 512, w_pool + ((size_t)l * 4 + g) * 128 * 128, 128, YA + g * 128, 512, 128);
        nv_ya_gate<<<M, 256, 0, stream>>>(YA, H, pool_scale + (size_t)l * 512);
        nv_attn<<<dim3(SEQ / 64, 16, BATCH), 64, 0, stream>>>(H, 0, SEQ, 64, nullptr, nullptr, 0, 1, O1, O2);
        nv_attn<<<dim3(1, 16, DEC_BATCH), 64, 0, stream>>>(H, MP, DEC_SEQ, DEC_SEQ, cache_k + (size_t)l * DEC_BATCH * PAST * 1024, cache_v + (size_t)l * DEC_BATCH * PAST * 1024, PAST, 0, O1, O2);
        nv_combine<<<M * 8 / 4, 256, 0, stream>>>(O1, O2, LAM, l, subln_w + (size_t)l * 128, H, YB);
        nv_gemm<<<dim3(1024 / 128, M / 128), 256, 0, stream>>>(YA, 512, w_a + (size_t)l * 512 * 1024, 1024, TA, 1024, 512);
        nv_gemm<<<dim3(1024 / 128, M / 128), 256, 0, stream>>>(YB, 1024, w_b + (size_t)l * 1024 * 1024, 1024, TB, 1024, 1024);
        nv_merge<<<M, 256, 0, stream>>>(TA, TB, H);
        nv_gemm<<<dim3(1024 / 128, M / 128), 256, 0, stream>>>(TA, 1024, w_o + (size_t)l * 1024 * 1024, 1024, OUTB, 1024, 1024);
        nv_ln<<<M / 4, 256, 0, stream>>>(X, OUTB, ALPHA, ln_g + (size_t)l * 1024, ln_b + (size_t)l * 1024, (l == DEPTH - 1) ? out + O_Y : X, M);
        CMP(s0 + 1, oPXB, 1, 512, H + C_PX, D_IN, M, 512, 1.f, 0);
        CMP(s0 + 2, oSPG, 1, 512, H + C_PG, D_IN, M, 512, 1.f, 1);
        CMP(s0 + 3, oVB, 1, 1024, H + C_V, D_IN, M, 1024, 1.f, 0);
        CMP(s0 + 4, oSAG, 1, 1024, H + C_AG, D_IN, M, 1024, 1.f, 1);
        CMP(s0 + 5, oSGA, 1, 1024, H + C_GA, D_IN, M, 1024, 1.f, 2);
        CMP(s0 + 6, oSGB, 1, 1024, H + C_GB, D_IN, M, 1024, 1.f, 2);
        CMP(s0 + 7, oKB, 1, 1024, H + C_K, D_IN, M, 1024, 1.f, 0);
        CMP(s0 + 8, oQB, 1, 1024, H + C_Q, D_IN, M, 1024, 1.f / C2, 0);
        CMP(s0 + 9, out2 + O_KP + (size_t)l * MP * 1024, 0, 1024, out + O_KP + (size_t)l * MP * 1024, 1024, MP, 1024, 1.f, 0);
        CMP(s0 + 10, out2 + O_VP + (size_t)l * MP * 1024, 0, 1024, out + O_VP + (size_t)l * MP * 1024, 1024, MP, 1024, 1.f, 0);
        CMP(s0 + 11, out2 + O_PP + (size_t)l * BATCH * 15 * 512, 0, 512, out + O_PP + (size_t)l * BATCH * 15 * 512, 512, BATCH * 15, 512, 1.f, 0);
        CMP(s0 + 12, out2 + O_KS + (size_t)l * MS * 1024, 0, 1024, out + O_KS + (size_t)l * MS * 1024, 1024, MS, 1024, 1.f, 0);
        CMP(s0 + 13, out2 + O_VS + (size_t)l * MS * 1024, 0, 1024, out + O_VS + (size_t)l * MS * 1024, 1024, MS, 1024, 1.f, 0);
        CMP(s0 + 14, out2 + O_PS + (size_t)l * DEC_BATCH * 15 * 512, 0, 512, out + O_PS + (size_t)l * DEC_BATCH * 15 * 512, 512, DEC_BATCH * 15, 512, 1.f, 0);
        CMP(s0 + 15, oYA, 1, 1536, YA, 512, M, 512, 1.f, 0);
        CMP(s0 + 16, oO1, 0, 1024, O1, 1024, MP, 1024, 1.f, 0);
        CMP(s0 + 17, oO2, 0, 1024, O2, 1024, MP, 1024, 1.f, 0);
        CMP(s0 + 18, oYB, 1, 1536, YB, 1024, MP, 1024, 1.f, 0);
        CMP(s0 + 19, (const unsigned short*)oYB + (size_t)MP * 1536, 1, 1536, YB + (size_t)MP * 1024, 1024, MS, 1024, 1.f, 0);
        CMP(s0 + 20, oMG, 1, 1024, TA, 1024, M, 1024, 1.f, 0);
        CMP(s0 + 21, (l == DEPTH - 1) ? (const void*)(out2 + O_Y) : oX, 0, 1024, (l == DEPTH - 1) ? out + O_Y : X, 1024, M, 1024, 1.f, 0);
    }
    dbg_final<<<64, 256, 0, stream>>>(ERR, DEPTH * NSLOT_L, 1e-3f, out + O_PS, DEPTH * DEC_BATCH * 15 * 512);
}
#endif
```

```cpp
#include <hip/hip_runtime.h>
#include <hip/hip_bf16.h>
#include <cstdio>
#include <cstdint>
#include <cmath>

#ifndef DEBUG_CHECK
#define DEBUG_CHECK 0
#endif

constexpr int D_MODEL = 1024, BATCH = 8, SEQ = 4096, DEPTH = 4, DEC_BATCH = 32, DEC_SEQ = 16, PAST = 1024;
constexpr int D_POOL = 512, D_IN = 7168;
constexpr int MP = BATCH * SEQ, MS = DEC_BATCH * DEC_SEQ, M = MP + MS;
constexpr float LN_EPS = 1e-5f, RMS_EPS = 1e-5f;
constexpr float ALPHA = 1.681792830507429f;
constexpr float C2 = 0.125f * 1.4426950408889634f;
constexpr size_t O_Y = 0, O_KP = (size_t)M * 1024, O_VP = O_KP + (size_t)DEPTH * MP * 1024, O_PP = O_VP + (size_t)DEPTH * MP * 1024,
                 O_KS = O_PP + (size_t)DEPTH * BATCH * 15 * 512, O_VS = O_KS + (size_t)DEPTH * MS * 1024, O_PS = O_VS + (size_t)DEPTH * MS * 1024,
                 O_END = O_PS + (size_t)DEPTH * DEC_BATCH * 15 * 512;
constexpr size_t MiB = 1u << 20;
constexpr size_t RB2 = (size_t)M * 1024 * 2, RB4 = (size_t)M * 1024 * 4;
constexpr size_t WS_CTL = 0, CTL_ZERO_BYTES = 1 * MiB;
constexpr size_t WS_LAM = 1 * MiB;
constexpr size_t WS_ROPEC = 2 * MiB, WS_ROPES = WS_ROPEC + 512 * 1024;
constexpr size_t WS_WIN = 4 * MiB, WS_WAB = 60 * MiB  , WS_WO = 72 * MiB, WS_WP = 80 * MiB;
constexpr size_t WS_X = 96 * MiB;
constexpr size_t WS_XB = WS_X + RB4;
constexpr size_t WS_PXB = WS_XB + RB2;
constexpr size_t WS_SPG = WS_PXB + RB2 / 2;
constexpr size_t WS_QB = WS_SPG + RB2 / 2, WS_KB = WS_QB + RB2, WS_VB = WS_KB + RB2;
constexpr size_t WS_SAG = WS_VB + RB2, WS_SGA = WS_SAG + RB2, WS_SGB = WS_SGA + RB2;
constexpr size_t WS_O1 = WS_SGB + RB2, WS_O2 = WS_O1 + RB4;
constexpr size_t WS_YAB = WS_O2 + RB4;
constexpr size_t WS_RSB = WS_YAB + RB2 + RB2 / 2, WS_MG = WS_RSB + RB4;
constexpr size_t WS_END = WS_MG + RB2;
static_assert(WS_END <= 1300 * MiB && WS_WP + 512 * 1024 <= WS_X && WS_WIN + (size_t)DEPTH * D_IN * 1024 * 2 <= WS_WAB && WS_WAB + (size_t)DEPTH * 1024 * 1536 * 2 <= WS_WO, "d_ws map");
constexpr int CW_BAR = 4096;
constexpr int RING_OFF = 0, RING_BYTES = 131072;
constexpr int LDSCTL_OFF = RING_BYTES, MISC_OFF = LDSCTL_OFF + 320;
constexpr int LDS_BYTES = 147456;
constexpr int NWAVES = 8;
#ifndef REP_P0
#define REP_P0 1
#endif
#ifndef REP_P1
#define REP_P1 1
#endif
#ifndef REP_SAMPLE
#define REP_SAMPLE 1
#endif
#ifndef REP_POOL
#define REP_POOL 1
#endif
#ifndef REP_ATTN
#define REP_ATTN 1
#endif
#ifndef REP_P3
#define REP_P3 1
#endif
#ifndef STAG_P1
#define STAG_P1 700u
#endif
#ifndef STAG_P3
#define STAG_P3 1200u
#endif
#ifndef STAG_P4
#define STAG_P4 800u
#endif
namespace pg8 {
#define PG8_LAS __attribute__((address_space(3)))
typedef unsigned short bf16_t;
typedef short bf16x8 __attribute__((ext_vector_type(8)));
typedef float f32x4 __attribute__((ext_vector_type(4)));
typedef unsigned u32x4 __attribute__((ext_vector_type(4)));
constexpr int BM = 256, BK = 64, HALF = 128, HTB = HALF * BK * 2  , STAGE_BYTES = 8 * HTB, NXCD = 8, WGM = 8;

__host__ __device__ __forceinline__ int lds_byte(int r, int c) { const int st = (r >> 4) * 2 + (c >> 5), rr = r & 15, cc = c & 31, ob = rr * 64 + cc * 2; return st * 1024 + (ob ^ (((ob >> 9) & 1) << 5)); }
__host__ __device__ __forceinline__ void stage_rc(int b, int& R, int& C) { const int st = b / 1024, sb = b % 1024, swz = sb ^ (((sb >> 9) & 1) << 5); R = (st >> 1) * 16 + swz / 64; C = (st & 1) * 32 + (swz % 64) / 2; }
__host__ __device__ __forceinline__ int perm32(int rho) { const int n = rho >> 4, i = rho & 15; return 8 * (i >> 2) + 4 * n + (i & 3); }

struct Unit { int pm, pn; };
struct Gemm { const bf16_t* A; const bf16_t* Bt; int M, N, K; };

struct StaticOrder {
    int nM, nN, nwg, G, c;
    __host__ __device__ void init(int M, int N, int G_, int c_) { nM = M / BM; nN = N / BM; nwg = nM * nN; G = G_; c = c_; }
    __host__ __device__ bool next(int i, Unit& u) const {
        const long L = (long)i * G + c; if (L >= nwg) return false;
        int wgid = (int)L; { const int q = nwg / NXCD, r = nwg % NXCD, xcd = wgid % NXCD, off = wgid / NXCD; wgid = (xcd < r ? xcd * (q + 1) : r * (q + 1) + (xcd - r) * q) + off; }
        const int nig = WGM * nN, gid = wgid / nig, fm = gid * WGM, gsz = (nM - fm) < WGM ? (nM - fm) : WGM;
        u.pm = fm + ((wgid % nig) % gsz); u.pn = (wgid % nig) / gsz; return true;
    }
    __device__ __forceinline__ void a_ready(const Unit&) const {}
    __device__ __forceinline__ void done(const Unit&) const {}
};

__device__ __forceinline__ unsigned cvt_pk_bf16(float lo, float hi) { unsigned r; asm volatile("v_cvt_pk_bf16_f32 %0, %1, %2" : "=v"(r) : "v"(lo), "v"(hi)); return r; }
typedef float f32x2 __attribute__((ext_vector_type(2)));
template <class Epi, class Sched, bool ALIGN_EPI = false, bool SP2 = false>
__device__ __forceinline__ void gemm_phase(PG8_LAS unsigned char* lds, const Gemm g, const Sched& S, const Epi& E, const int wave_id) {
    int tid_o; asm volatile("v_mbcnt_lo_u32_b32 %0, -1, 0\n\tv_mbcnt_hi_u32_b32 %0, -1, %0" : "=v"(tid_o)); tid_o += wave_id * 64;
    const int tid = tid_o, wid = __builtin_amdgcn_readfirstlane(tid >> 6), lane = tid & 63, wr = wid >> 2, wc = wid & 3, fr = lane & 15, fq = lane >> 4;
    const int K = g.K, nt = K / BK;
    unsigned voffA[2], voffB[2];
#pragma unroll
    for (int i = 0; i < 2; ++i) { int R, C; stage_rc(tid * 16 + i * 8192, R, C); const int Rb = Epi::PERM ? ((R & ~31) + perm32(R & 31)) : R;
        voffA[i] = (unsigned)(R * K + C) * 2u; voffB[i] = (unsigned)(Rb * K + C) * 2u; }
    const size_t kstep = (size_t)(BK * 2);
    const size_t hstep = (size_t)HALF * K * 2;
    const size_t tstep = 2 * hstep;
    const unsigned ldsw = (unsigned)wid * 1024u;
    const int aoff = lds_byte(wr * 64 + fr, fq * 8), boff = lds_byte(wc * 32 + fr, fq * 8);
#define PG8_SA(b, h) (((b) * 2 + (h)) * HTB)
#define PG8_SB(b, h) ((4 + (b) * 2 + (h)) * HTB)
#define PG8_STAGE(bufoff, gbase, voff) do { _Pragma("unroll") for (int _i = 0; _i < 2; ++_i) \
        __builtin_amdgcn_global_load_lds((const unsigned*)((const char*)(gbase) + (voff)[_i]), (PG8_LAS unsigned*)(lds + (bufoff) + ldsw + _i * 8192), 16, 0, 0); } while (0)
#define PG8_LDA(dst, b, h) do { _Pragma("unroll") for (int m = 0; m < 4; ++m) _Pragma("unroll") for (int k = 0; k < 2; ++k) dst[m][k] = *(const PG8_LAS bf16x8*)(lds + PG8_SA(b, h) + aoff + m * 2048 + k * 1024); } while (0)
#define PG8_LDB(dst, b, h) do { _Pragma("unroll") for (int n = 0; n < 2; ++n) _Pragma("unroll") for (int k = 0; k < 2; ++k) dst[n][k] = *(const PG8_LAS bf16x8*)(lds + PG8_SB(b, h) + boff + n * 2048 + k * 1024); } while (0)
#define PG8_MMA(ai, bj, At, Bt) do { __builtin_amdgcn_s_setprio(1); _Pragma("unroll") for (int m = 0; m < 4; ++m) _Pragma("unroll") for (int n = 0; n < 2; ++n) _Pragma("unroll") for (int k = 0; k < 2; ++k) \
        acc[ai][bj][m][n] = __builtin_amdgcn_mfma_f32_16x16x32_bf16(Bt[n][k], At[m][k], acc[ai][bj][m][n], 0, 0, 0); __builtin_amdgcn_s_setprio(0); } while (0)
#define PG8_WAIT_V(n) asm volatile("s_waitcnt vmcnt(" #n ")" ::: "memory")
#define PG8_WAIT_L(n) asm volatile("s_waitcnt lgkmcnt(" #n ")" ::: "memory")
#define PG8_BAR __builtin_amdgcn_s_barrier()
#define PG8_SCHED __builtin_amdgcn_sched_barrier(0)
    Unit cur, nxt; int ui = 0;
    if (!S.next(0, cur)) return;
    f32x4 acc[2][2][4][2];
#pragma unroll
    for (int a = 0; a < 2; ++a)
#pragma unroll
        for (int b = 0; b < 2; ++b)
#pragma unroll
            for (int m = 0; m < 4; ++m)
#pragma unroll
                for (int n = 0; n < 2; ++n) acc[a][b][m][n] = (f32x4){0.f, 0.f, 0.f, 0.f};
    bf16x8 At[4][2], B0[2][2], B1[2][2];
    const char* cA = (const char*)g.A + (size_t)cur.pm * tstep; const char* cB = (const char*)g.Bt + (size_t)cur.pn * tstep;
    S.a_ready(cur);
    if constexpr (SP2) {
        PG8_STAGE(PG8_SB(0, 0), cB, voffB); PG8_STAGE(PG8_SB(0, 1), cB + hstep, voffB); PG8_STAGE(PG8_SA(0, 0), cA, voffA); PG8_STAGE(PG8_SA(0, 1), cA + hstep, voffA);
        if (wr == 1) PG8_BAR;
        PG8_WAIT_V(2); PG8_BAR;
        PG8_STAGE(PG8_SB(1, 0), cB + kstep, voffB); PG8_STAGE(PG8_SA(1, 0), cA + kstep, voffA); PG8_STAGE(PG8_SB(1, 1), cB + hstep + kstep, voffB);
        PG8_WAIT_V(6); PG8_BAR;
    } else {
        PG8_STAGE(PG8_SB(0, 0), cB, voffB); PG8_STAGE(PG8_SA(0, 0), cA, voffA); PG8_STAGE(PG8_SB(0, 1), cB + hstep, voffB); PG8_STAGE(PG8_SA(0, 1), cA + hstep, voffA);
        if (wr == 1) PG8_BAR;
        PG8_WAIT_V(4); PG8_BAR;
        PG8_STAGE(PG8_SB(1, 0), cB + kstep, voffB); PG8_STAGE(PG8_SA(1, 0), cA + kstep, voffA); PG8_STAGE(PG8_SB(1, 1), cB + hstep + kstep, voffB);
        PG8_WAIT_V(6); PG8_BAR;
    }
    for (;;) {
        const bool has_next = S.next(ui + 1, nxt);
        const char* nA = has_next ? (const char*)g.A + (size_t)nxt.pm * tstep : cA; const char* nB = has_next ? (const char*)g.Bt + (size_t)nxt.pn * tstep : cB;
        for (int t = 0; t < nt; t += 2) {
            const bool last = (t == nt - 2);
            const char* a1 = cA + (size_t)(t + 1) * kstep;
            const char* a2 = last ? nA : cA + (size_t)(t + 2) * kstep; const char* b2 = last ? nB : cB + (size_t)(t + 2) * kstep;
            const char* a3 = a2 + kstep; const char* b3 = b2 + kstep;
            if (last && has_next) S.a_ready(nxt);
            if constexpr (Epi::MIDK > 0) { if (t == Epi::MIDK) E.mid(acc, cur, wr, wc, fr, fq); }
            if constexpr (SP2) {
            PG8_LDB(B0, 0, 0); PG8_LDB(B1, 0, 1); PG8_SCHED; PG8_LDA(At, 0, 0); PG8_STAGE(PG8_SA(1, 1), a1 + hstep, voffA);
            PG8_WAIT_V(8); PG8_WAIT_L(0); PG8_BAR; PG8_MMA(0, 0, At, B0); PG8_MMA(0, 1, At, B1); PG8_BAR; PG8_SCHED;
            PG8_LDA(At, 0, 1); PG8_STAGE(PG8_SB(0, 0), b2, voffB); PG8_STAGE(PG8_SB(0, 1), b2 + hstep, voffB); PG8_STAGE(PG8_SA(0, 0), a2, voffA);
            PG8_WAIT_V(8); PG8_WAIT_L(0); PG8_BAR; PG8_MMA(1, 0, At, B0); PG8_MMA(1, 1, At, B1); PG8_BAR; PG8_SCHED;
            PG8_LDB(B0, 1, 0); PG8_LDB(B1, 1, 1); PG8_SCHED; PG8_LDA(At, 1, 0); PG8_STAGE(PG8_SA(0, 1), a2 + hstep, voffA);
            PG8_WAIT_V(8); PG8_WAIT_L(0); PG8_BAR; PG8_MMA(0, 0, At, B0); PG8_MMA(0, 1, At, B1); PG8_BAR; PG8_SCHED;
            PG8_LDA(At, 1, 1); PG8_STAGE(PG8_SB(1, 0), b3, voffB); PG8_STAGE(PG8_SB(1, 1), b3 + hstep, voffB); PG8_STAGE(PG8_SA(1, 0), a3, voffA);
            PG8_WAIT_V(8); PG8_WAIT_L(0); PG8_BAR; PG8_MMA(1, 0, At, B0); PG8_MMA(1, 1, At, B1); PG8_BAR; PG8_SCHED;
            } else {
            PG8_LDB(B0, 0, 0); PG8_SCHED; PG8_LDA(At, 0, 0); PG8_STAGE(PG8_SA(1, 1), a1 + hstep, voffA);
            PG8_WAIT_L(8); PG8_BAR; PG8_WAIT_L(0); PG8_MMA(0, 0, At, B0); PG8_BAR; PG8_SCHED;
            PG8_LDB(B1, 0, 1); PG8_STAGE(PG8_SB(0, 0), b2, voffB);
            PG8_BAR; PG8_WAIT_L(0); PG8_MMA(0, 1, At, B1); PG8_BAR;
            PG8_LDA(At, 0, 1); PG8_STAGE(PG8_SA(0, 0), a2, voffA);
            PG8_BAR; PG8_WAIT_L(0); PG8_MMA(1, 0, At, B0); PG8_BAR; PG8_SCHED;
            PG8_STAGE(PG8_SB(0, 1), b2 + hstep, voffB);
            PG8_WAIT_V(6); PG8_BAR; PG8_MMA(1, 1, At, B1); PG8_BAR;
            PG8_LDB(B0, 1, 0); PG8_SCHED; PG8_LDA(At, 1, 0); PG8_STAGE(PG8_SA(0, 1), a2 + hstep, voffA);
            PG8_WAIT_L(8); PG8_BAR; PG8_WAIT_L(0); PG8_MMA(0, 0, At, B0); PG8_BAR; PG8_SCHED;
            PG8_LDB(B1, 1, 1); PG8_STAGE(PG8_SB(1, 0), b3, voffB);
            PG8_BAR; PG8_WAIT_L(0); PG8_MMA(0, 1, At, B1); PG8_BAR;
            PG8_LDA(At, 1, 1); PG8_STAGE(PG8_SA(1, 0), a3, voffA);
            PG8_BAR; PG8_WAIT_L(0); PG8_MMA(1, 0, At, B0); PG8_BAR; PG8_SCHED;
            PG8_STAGE(PG8_SB(1, 1), b3 + hstep, voffB);
            PG8_WAIT_V(6); PG8_BAR; PG8_MMA(1, 1, At, B1); PG8_BAR;
            }
        }
        if constexpr (ALIGN_EPI) { if (wr == 0) PG8_BAR; }
        if constexpr (!Epi::AFTER_DRAIN) { E(acc, cur, wr, wc, fr, fq); S.done(cur); }
        if (!has_next) break;
#pragma unroll
        for (int a = 0; a < 2; ++a)
#pragma unroll
            for (int b = 0; b < 2; ++b)
#pragma unroll
                for (int m = 0; m < 4; ++m)
#pragma unroll
                    for (int n = 0; n < 2; ++n) acc[a][b][m][n] = (f32x4){0.f, 0.f, 0.f, 0.f};
        cur = nxt; cA = nA; cB = nB; ++ui;
        if constexpr (ALIGN_EPI) { if (wr == 1) PG8_BAR; }
    }
    PG8_WAIT_V(0);
    if constexpr (!ALIGN_EPI) { if (wr == 0) PG8_BAR; }
    PG8_BAR;
    if constexpr (Epi::AFTER_DRAIN) { E.fused(acc, cur, wr, wc, fr, fq, lds, wid, lane); S.done(cur); }
#undef PG8_SA
#undef PG8_SB
#undef PG8_STAGE
#undef PG8_LDA
#undef PG8_LDB
#undef PG8_MMA
#undef PG8_WAIT_V
#undef PG8_WAIT_L
#undef PG8_BAR
#undef PG8_SCHED
}
}
#include <hip/hip_bf16.h>
#include <cmath>
namespace attn_body {
using bf16=__hip_bfloat16;
using bf16x8=__attribute__((ext_vector_type(8)))short;
using s16x4=__attribute__((ext_vector_type(4)))short;
using f32x16=__attribute__((ext_vector_type(16)))float;
using u32x4=__attribute__((ext_vector_type(4)))unsigned;
constexpr int D=64,DM=1024;
constexpr int NW=8,QBLK=32,QB=QBLK*NW,KVBLK=64;
constexpr int ATTN_PITCH=DM, ATTN_UNIT_ROWS=QB;
__device__ __forceinline__ int crow(int r,int hi){return (r&3)+8*(r>>2)+4*hi;}
#define SBAR() __builtin_amdgcn_sched_barrier(0)
__device__ __forceinline__ void cmask(f32x16&p0,f32x16&p1,int jb,int qchunk){
  const float NEG=-INFINITY;
  if(jb>qchunk){
  #pragma unroll
  for(int r=0;r<16;++r){p0[r]=NEG;p1[r]=NEG;} }
}
constexpr int NSLOT=3, SLOTB=8192;
constexpr int LDS_K=0, LDS_V=NSLOT*SLOTB, LDS_WS=2*NSLOT*SLOTB, LDS_OST=LDS_WS+NW*64*4, LDS_BYTES=LDS_OST+NW*8192;
constexpr float C2=0.125f*1.4426950408889634f;
__device__ __forceinline__ void glds16(const void*gsrc,unsigned lds_dst){unsigned keep;
  asm volatile("s_mov_b32 %0, m0\n\ts_mov_b32 m0, %2\n\ts_nop 0\n\tglobal_load_lds_dwordx4 %1, off\n\ts_mov_b32 m0, %0":"=&s"(keep):"v"(gsrc),"s"(lds_dst):"memory");}
__device__ __forceinline__ float max3f(float a,float b,float c){float r;asm("v_max3_f32 %0, %1, %2, %3":"=v"(r):"v"(a),"v"(b),"v"(c));return r;}
__device__ __forceinline__ float max2f(float a,float b){float r;asm("v_max_f32_e32 %0, %1, %2":"=v"(r):"v"(a),"v"(b));return r;}
__device__ __forceinline__ float fadd_s(float a,float b){float r;asm("v_add_f32_e32 %0, %1, %2":"=v"(r):"v"(a),"v"(b));return r;}
__device__ __forceinline__ float fsub_s(float a,float b){float r;asm("v_sub_f32_e32 %0, %1, %2":"=v"(r):"v"(a),"v"(b));return r;}
typedef float f32x2_t __attribute__((ext_vector_type(2))); typedef __bf16 bf16x2_t __attribute__((ext_vector_type(2)));
__device__ __forceinline__ unsigned cvtpk_s(float lo,float hi){f32x2_t v={lo,hi};bf16x2_t b=__builtin_convertvector(v,bf16x2_t);return __builtin_bit_cast(unsigned,b);}
#define WAIT_BAR(N) asm volatile("s_waitcnt vmcnt(" #N ") lgkmcnt(0)\n\ts_barrier":::"memory")

__device__ __forceinline__ void qkt(f32x16&p0,f32x16&p1,const char*Kslot,const bf16x8*qr,const f32x16&negm,int r32,int hi){
  const char*kb=Kslot+hi*1024+r32*16;
  #pragma unroll
  for(int d0=0;d0<4;++d0){
    const bf16x8 b0=*reinterpret_cast<const bf16x8*>(kb+d0*2048);
    const bf16x8 b1=*reinterpret_cast<const bf16x8*>(kb+d0*2048+512);
    if(d0==0){p0=__builtin_amdgcn_mfma_f32_32x32x16_bf16(b0,qr[0],negm,0,0,0);p1=__builtin_amdgcn_mfma_f32_32x32x16_bf16(b1,qr[0],negm,0,0,0);}
    else{p0=__builtin_amdgcn_mfma_f32_32x32x16_bf16(b0,qr[d0],p0,0,0,0);p1=__builtin_amdgcn_mfma_f32_32x32x16_bf16(b1,qr[d0],p1,0,0,0);}}
}
typedef __attribute__((address_space(3))) const char* lds_cptr;
typedef short v4i16_t __attribute__((ext_vector_type(4)));
__device__ __forceinline__ void kload8(bf16x8*kf,lds_cptr kp){
  kf[0]=*(const __attribute__((address_space(3))) bf16x8*)(kp);      kf[1]=*(const __attribute__((address_space(3))) bf16x8*)(kp+512);
  kf[2]=*(const __attribute__((address_space(3))) bf16x8*)(kp+2048); kf[3]=*(const __attribute__((address_space(3))) bf16x8*)(kp+2560);
  kf[4]=*(const __attribute__((address_space(3))) bf16x8*)(kp+4096); kf[5]=*(const __attribute__((address_space(3))) bf16x8*)(kp+4608);
  kf[6]=*(const __attribute__((address_space(3))) bf16x8*)(kp+6144); kf[7]=*(const __attribute__((address_space(3))) bf16x8*)(kp+6656);
}
__device__ __forceinline__ void kload2(bf16x8*kf,lds_cptr kp,int j){ kf[2*j]=*(const __attribute__((address_space(3))) bf16x8*)(kp+j*2048); kf[2*j+1]=*(const __attribute__((address_space(3))) bf16x8*)(kp+j*2048+512); }
__device__ __forceinline__ s16x4 vtr(lds_cptr p){ return __builtin_bit_cast(s16x4,__builtin_amdgcn_ds_read_tr16_b64_v4i16((__attribute__((address_space(3))) v4i16_t*)p)); }
__device__ __forceinline__ float rowmax(const f32x16&p0,const f32x16&p1){
  float a=max3f(p0[0],p0[1],p1[0]),b=max3f(p0[2],p0[3],p1[1]);a=max3f(a,p1[2],p1[3]);
  #pragma unroll
  for(int r=4;r<16;r+=4){a=max3f(a,p0[r],p0[r+1]);b=max3f(b,p0[r+2],p0[r+3]);a=max3f(a,p1[r],p1[r+1]);b=max3f(b,p1[r+2],p1[r+3]);}
  const float m=max2f(a,b);
  auto rr=__builtin_amdgcn_permlane32_swap(__float_as_uint(m),__float_as_uint(m),false,false);
  return max2f(__uint_as_float(rr[0]),__uint_as_float(rr[1]));
}
__device__ __forceinline__ void pv(f32x16*o,int vb,bf16x8 pa0,bf16x8 pa1,bf16x8 pa2,bf16x8 pa3){
  #pragma unroll
  for(int d0=0;d0<2;++d0){s16x4 lo[4],hi[4];
    #pragma unroll
    for(int ks=0;ks<4;++ks){
      asm volatile("ds_read_b64_tr_b16 %0,%1 offset:%c2":"=&v"(lo[ks]):"v"(vb),"i"(d0*4096+ks*1024):"memory");
      asm volatile("ds_read_b64_tr_b16 %0,%1 offset:%c2":"=&v"(hi[ks]):"v"(vb),"i"(d0*4096+ks*1024+512):"memory");}
    asm volatile("s_waitcnt lgkmcnt(0)":::"memory");SBAR();
    #define PK(k) (bf16x8){lo[k][0],lo[k][1],lo[k][2],lo[k][3],hi[k][0],hi[k][1],hi[k][2],hi[k][3]}
    o[d0]=__builtin_amdgcn_mfma_f32_32x32x16_bf16(pa0,PK(0),o[d0],0,0,0);
    o[d0]=__builtin_amdgcn_mfma_f32_32x32x16_bf16(pa1,PK(1),o[d0],0,0,0);
    o[d0]=__builtin_amdgcn_mfma_f32_32x32x16_bf16(pa2,PK(2),o[d0],0,0,0);
    o[d0]=__builtin_amdgcn_mfma_f32_32x32x16_bf16(pa3,PK(3),o[d0],0,0,0);
    #undef PK
  }
}

#ifndef ATTN_STORE16
#define ATTN_STORE16(p,v) (*(u32x4*)(p)=(v))
#endif
template<int THRL> __device__ __forceinline__ void attn_unit(int qb,const bf16*Q,const bf16*__restrict__ K,const bf16*__restrict__ V,float*O,char*shm){
  int tid_o=threadIdx.x; asm volatile("":"+v"(tid_o));
  const int tid=tid_o,lane=tid&63,r32=lane&31,hi=lane>>5; const int wid=__builtin_amdgcn_readfirstlane(tid>>6);
  const int q0=qb*QB;
  const bf16*Qw=Q+(long)(q0+wid*QBLK)*DM;
  const bf16*Kh=K,*Vh=V;
  const unsigned lds0=(unsigned)(uintptr_t)shm;
  float*wsf=(float*)(shm+LDS_WS)+wid*64;
  const bf16*ksrc=Kh+(long)lane*DM+wid*8;
  const bf16*vsrc=Vh+(long)(16*(wid&3)+(lane>>2))*DM+(wid>>2)*32+(lane&3)*8;
  const unsigned kdst=lds0+LDS_K+wid*1024, vdst=lds0+LDS_V+wid*1024;
  #define DMA_K(t,slot) glds16(ksrc+(long)(t)*KVBLK*DM,(unsigned)__builtin_amdgcn_readfirstlane(kdst+(slot)))
  #define DMA_V(t,slot) glds16(vsrc+(long)(t)*KVBLK*DM,(unsigned)__builtin_amdgcn_readfirstlane(vdst+(slot)))
  const int vb0=(int)(lds0+LDS_V)+((lane>>4)&1)*32+(lane&3)*8+(4*hi+((lane&15)>>2))*64;
  const char*Kbase=shm+LDS_K; bf16x8 kf[8];
  const lds_cptr shm3=(lds_cptr)shm; const lds_cptr kp0=shm3+LDS_K+hi*1024+r32*16; const lds_cptr vp0=shm3+LDS_V+((lane>>4)&1)*32+(lane&3)*8+(4*hi+((lane&15)>>2))*64;
  const int NT=(q0+QB)/KVBLK;
  DMA_K(0,0);DMA_V(0,0);DMA_K(1,SLOTB);
  bf16x8 qr[4];
  #pragma unroll
  for(int d0=0;d0<4;++d0)qr[d0]=*reinterpret_cast<const bf16x8*>(&Qw[(long)r32*DM+d0*16+hi*8]);
  float mhat=0.f,l_reg=0.f;f32x16 o[2];o[0]=f32x16{};o[1]=f32x16{};f32x16 negm=f32x16{};asm volatile("":"+v"(negm));

  #define CMASK(P0,P1,t) do{int jb_=(t)-(NT-4); if(jb_>=0)cmask(P0,P1,jb_,wid>>1);}while(0)
  bool resc=false;
  #define START(P0,P1) do{ const float rm=rowmax(P0,P1); resc=false; \
    { const float dl=rm; mhat=fadd_s(mhat,dl); \
      _Pragma("unroll") for(int r=0;r<16;++r){P0[r]=fsub_s(P0[r],dl);P1[r]=fsub_s(P1[r],dl);} \
      _Pragma("unroll") for(int r=0;r<16;++r)negm[r]=-mhat; asm volatile("":"+v"(negm)); } \
    _Pragma("unroll") for(int r=0;r<16;++r)P0[r]=__builtin_amdgcn_exp2f(P0[r]); }while(0)
  #define RESC() do{ if(resc){ asm volatile("s_waitcnt lgkmcnt(0)":::"memory"); \
      _Pragma("unroll") for(int d_=0;d_<2;++d_) _Pragma("unroll") for(int r=0;r<16;++r)o[d_][r]*=wsf[crow(r,hi)]; } }while(0)
  f32x16 pA0,pA1,pB0,pB1;
  int sl_prev=0,sl_cur=0,sl_next=SLOTB;
  #define ROT() do{sl_prev=sl_cur;sl_cur=sl_next;sl_next=(sl_next==(NSLOT-1)*SLOTB)?0:sl_next+SLOTB;}while(0)
  DMA_K(2,2*SLOTB);
  WAIT_BAR(3);
  qkt(pA0,pA1,Kbase,qr,negm,r32,hi);asm volatile("s_nop 15\n\ts_nop 7":"+v"(pA0),"+v"(pA1));CMASK(pA0,pA1,0);
  START(pA0,pA1);
  _Pragma("unroll") for(int r=0;r<16;++r)pA1[r]=__builtin_amdgcn_exp2f(pA1[r]);
  WAIT_BAR(0);
  DMA_K(3,0);DMA_V(1,SLOTB);
  ROT();
  kload8(kf,kp0+sl_cur);
  WAIT_BAR(2);
  s16x4 vlo[8],vhi[8]; u32x4 pw0,pw1,pw2,pw3;
  #define PKW(P,B) cvtpk_s(P[B],P[B+1])
  #define PAF(k) __builtin_bit_cast(bf16x8,pw##k)
  #define VFR(i) (bf16x8){vlo[i][0],vlo[i][1],vlo[i][2],vlo[i][3],vhi[i][0],vhi[i][1],vhi[i][2],vhi[i][3]}
  #define PIN(x) asm volatile("":"+v"(x))
  #define MX3(a,b,c) __builtin_fmaxf(__builtin_fmaxf((a),(b)),(c))
  #define GAPA(MF,A0,A1,A2,A3,W0,W1,PW) do{ MF; sacc+=A0; sacc+=A1; sacc+=A2; sacc+=A3; PIN(sacc); W0; W1; PIN(PW); SBAR(); }while(0)
  #define EX(v) __builtin_amdgcn_exp2f(v)
  #define GAPB(MF,X,B) do{ MF; X[B]=EX(X[B]); X[B+1]=EX(X[B+1]); X[B+2]=EX(X[B+2]); X[B+3]=EX(X[B+3]); PIN(X); SBAR(); }while(0)
  #define VRD(i) do{ vlo[i]=vtr(vp_+(((i)>>2)*4096+((i)&3)*1024)); vhi[i]=vtr(vp_+(((i)>>2)*4096+((i)&3)*1024+512)); }while(0)
  #define KRD(G,j) do{ if(G){ kload2(kf,kp0+sl_next,j); SBAR(); } }while(0)
  #define STEP(C0,C1,P0,P1,t,GK,GV,GL) do{ SBAR(); \
    const lds_cptr vp_=vp0+sl_prev; \
    VRD(0); SBAR(); float sacc=(P0[0]+P0[1]); \
    GAPA(C0=__builtin_amdgcn_mfma_f32_32x32x16_bf16(kf[0],qr[0],negm,0,0,0), P0[2],P0[3],P0[4],P0[5],     pw0[0]=PKW(P0,0), pw0[1]=PKW(P0,2), pw0); \
    VRD(4); SBAR(); GAPA(C1=__builtin_amdgcn_mfma_f32_32x32x16_bf16(kf[1],qr[0],negm,0,0,0), P0[6],P0[7],P0[8],P0[9],     pw0[2]=PKW(P0,4), pw0[3]=PKW(P0,6), pw0); \
    VRD(1); SBAR(); GAPA(C0=__builtin_amdgcn_mfma_f32_32x32x16_bf16(kf[2],qr[1],C0,0,0,0),   P0[10],P0[11],P0[12],P0[13], pw1[0]=PKW(P0,8), pw1[1]=PKW(P0,10), pw1); \
    VRD(5); SBAR(); GAPA(C1=__builtin_amdgcn_mfma_f32_32x32x16_bf16(kf[3],qr[1],C1,0,0,0),   P0[14],P0[15],P1[0],P1[1],   pw1[2]=PKW(P0,12),pw1[3]=PKW(P0,14), pw1); \
    VRD(2); SBAR(); GAPA(C0=__builtin_amdgcn_mfma_f32_32x32x16_bf16(kf[4],qr[2],C0,0,0,0),   P1[2],P1[3],P1[4],P1[5],     pw2[0]=PKW(P1,0), pw2[1]=PKW(P1,2), pw2); \
    VRD(6); SBAR(); GAPA(C1=__builtin_amdgcn_mfma_f32_32x32x16_bf16(kf[5],qr[2],C1,0,0,0),   P1[6],P1[7],P1[8],P1[9],     pw2[2]=PKW(P1,4), pw2[3]=PKW(P1,6), pw2); \
    VRD(3); SBAR(); GAPA(C0=__builtin_amdgcn_mfma_f32_32x32x16_bf16(kf[6],qr[3],C0,0,0,0),   P1[10],P1[11],P1[12],P1[13], pw3[0]=PKW(P1,8), pw3[1]=PKW(P1,10), pw3); \
    VRD(7); SBAR(); GAPA(C1=__builtin_amdgcn_mfma_f32_32x32x16_bf16(kf[7],qr[3],C1,0,0,0),   P1[14],P1[15],0.f,0.f,       pw3[2]=PKW(P1,12),pw3[3]=PKW(P1,14), pw3); \
    l_reg+=sacc; \
    if(GK){DMA_K((t)+3,sl_cur);} if(GV){DMA_V((t)+1,sl_next);} \
    CMASK(C0,C1,t); \
    { float a=MX3(C0[0],C0[1],C1[0]),b=MX3(C0[2],C0[3],C1[1]); a=MX3(a,C1[2],C1[3]); \
      _Pragma("unroll") for(int r=4;r<16;r+=4){a=MX3(a,C0[r],C0[r+1]);b=MX3(b,C0[r+2],C0[r+3]);a=MX3(a,C1[r],C1[r+1]);b=MX3(b,C1[r+2],C1[r+3]);} \
      float rm=__builtin_fmaxf(a,b); { auto rr=__builtin_amdgcn_permlane32_swap(__float_as_uint(rm),__float_as_uint(rm),false,false); rm=__builtin_fmaxf(__uint_as_float(rr[0]),__uint_as_float(rr[1])); } \
      resc=false; \
      if(__builtin_expect(__any(rm>(float)THRL),0)){ const float dl=__builtin_fmaxf(rm,0.f); mhat+=dl; \
        _Pragma("unroll") for(int r=0;r<16;++r){C0[r]-=dl;C1[r]-=dl;} \
        _Pragma("unroll") for(int r=0;r<16;++r)negm[r]=-mhat; asm volatile("":"+v"(negm)); \
        const float f=__builtin_amdgcn_exp2f(-dl); l_reg*=f; if(hi==0)wsf[r32]=f; resc=true; } } \
    SBAR(); \
    GAPB(o[0]=__builtin_amdgcn_mfma_f32_32x32x16_bf16(PAF(0),VFR(0),o[0],0,0,0), C0,0); \
    GAPB(o[1]=__builtin_amdgcn_mfma_f32_32x32x16_bf16(PAF(0),VFR(4),o[1],0,0,0), C0,4); \
    KRD(GL,0); GAPB(o[0]=__builtin_amdgcn_mfma_f32_32x32x16_bf16(PAF(1),VFR(1),o[0],0,0,0), C0,8); \
    KRD(GL,1); GAPB(o[1]=__builtin_amdgcn_mfma_f32_32x32x16_bf16(PAF(1),VFR(5),o[1],0,0,0), C0,12); \
    KRD(GL,2); GAPB(o[0]=__builtin_amdgcn_mfma_f32_32x32x16_bf16(PAF(2),VFR(2),o[0],0,0,0), C1,0); \
    KRD(GL,3); GAPB(o[1]=__builtin_amdgcn_mfma_f32_32x32x16_bf16(PAF(2),VFR(6),o[1],0,0,0), C1,4); \
    GAPB(o[0]=__builtin_amdgcn_mfma_f32_32x32x16_bf16(PAF(3),VFR(3),o[0],0,0,0), C1,8); \
    GAPB(o[1]=__builtin_amdgcn_mfma_f32_32x32x16_bf16(PAF(3),VFR(7),o[1],0,0,0), C1,12); \
    }while(0)
  int t=1;
  #undef CMASK
  #define CMASK(P0,P1,t) do{}while(0)
  for(;t+5<NT;t+=2){
    STEP(pB0,pB1,pA0,pA1,t,true,true,true);     WAIT_BAR(2); RESC(); ROT();
    STEP(pA0,pA1,pB0,pB1,t+1,true,true,true);   WAIT_BAR(2); RESC(); ROT();
  }
  #undef CMASK
  #define CMASK(P0,P1,t) do{int jb_=(t)-(NT-4); if(jb_>=0)cmask(P0,P1,jb_,wid>>1);}while(0)
  #define ENDW(tt) do{ if((tt)+3<NT){WAIT_BAR(2);} else if((tt)+2<NT){WAIT_BAR(1);} else {WAIT_BAR(0);} }while(0)
  for(;t+1<NT;t+=2){
    STEP(pB0,pB1,pA0,pA1,t,(t+3<NT),(t+1<NT),(t+1<NT));       ENDW(t);   RESC(); ROT();
    STEP(pA0,pA1,pB0,pB1,t+1,(t+4<NT),(t+2<NT),(t+2<NT));     ENDW(t+1); RESC(); ROT();
  }
  STEP(pB0,pB1,pA0,pA1,NT-1,false,false,false); RESC();
  { float sacc=pB0[0]+pB0[1]; _Pragma("unroll") for(int r=2;r<16;++r)sacc+=pB0[r]; _Pragma("unroll") for(int r=0;r<16;++r)sacc+=pB1[r]; l_reg+=sacc;
    pw0=(u32x4){PKW(pB0,0),PKW(pB0,2),PKW(pB0,4),PKW(pB0,6)};pw1=(u32x4){PKW(pB0,8),PKW(pB0,10),PKW(pB0,12),PKW(pB0,14)};pw2=(u32x4){PKW(pB1,0),PKW(pB1,2),PKW(pB1,4),PKW(pB1,6)};pw3=(u32x4){PKW(pB1,8),PKW(pB1,10),PKW(pB1,12),PKW(pB1,14)};
    SBAR(); pv(o,vb0+sl_cur,PAF(0),PAF(1),PAF(2),PAF(3)); }
  #undef PKW
  #undef PAF
  #undef VFR
  #undef PIN
  #undef MX3
  #undef GAPA
  #undef GAPB
  #undef EX
  #undef VRD
  #undef KRD
  #undef STEP
  #undef ENDW
  {auto rr=__builtin_amdgcn_permlane32_swap(__float_as_uint(l_reg),__float_as_uint(l_reg),false,false);l_reg=__uint_as_float(rr[0])+__uint_as_float(rr[1]);}
  if(hi==0)wsf[32+r32]=l_reg;asm volatile("s_waitcnt lgkmcnt(0)":::"memory");
  float rli[16];
  #pragma unroll
  for(int r=0;r<16;++r)rli[r]=__builtin_amdgcn_rcpf(wsf[32+crow(r,hi)]);
  float*Ow=O+(long)(q0+wid*QBLK)*DM;
  { float*stg=(float*)(shm+LDS_OST)+wid*2048;
    #pragma unroll
    for(int r=0;r<16;++r){const int orow=crow(r,hi);
      #pragma unroll
      for(int d0=0;d0<2;++d0)stg[orow*64+d0*32+r32]=o[d0][r]*rli[r];}
    asm volatile("s_waitcnt lgkmcnt(0)":::"memory");
    #pragma unroll
    for(int i=0;i<8;++i){const int row=i*4+(lane>>4),ch=lane&15; const u32x4 v=*(const u32x4*)(stg+row*64+ch*4); *(u32x4*)(Ow+(long)row*DM+ch*4)=v;} }
  asm volatile("s_waitcnt lgkmcnt(0)\n\ts_barrier":::"memory");
  #undef DMA_K
  #undef DMA_V
  #undef CMASK
  #undef START
  #undef RESC
  #undef ROT
}

constexpr int W_LDS_K=0, W_LDS_V=3*8192, W_LDS_WS=W_LDS_V+3*16384, W_LDS_OST=W_LDS_WS+NW*64*4, W_LDS_BYTES=W_LDS_OST+NW*4096;
__device__ __forceinline__ void glds16s(const void*sbase,unsigned voff,unsigned lds_dst){unsigned keep;
  asm volatile("s_mov_b32 %0, m0\n\ts_mov_b32 m0, %3\n\ts_nop 0\n\tglobal_load_lds_dwordx4 %1, %2\n\ts_mov_b32 m0, %0":"=&s"(keep):"v"(voff),"s"(sbase),"s"(lds_dst):"memory");}
template<int THRL> __device__ __forceinline__ void attn_unit128(int qb,const bf16*Q,const bf16*__restrict__ K,const bf16*__restrict__ V,float*O,char*shm,const int wave_id){
  int tid_o; asm volatile("v_mbcnt_lo_u32_b32 %0, -1, 0\n\tv_mbcnt_hi_u32_b32 %0, -1, %0":"=v"(tid_o)); tid_o+=wave_id*64;
  const int tid=tid_o,lane=tid&63,r32=lane&31,hi=lane>>5; const int wid=__builtin_amdgcn_readfirstlane(tid>>6);
  const int q0=qb*QB;
  const bf16*Qw=Q+(long)(q0+wid*QBLK)*DM;
  const unsigned lds0=(unsigned)(uintptr_t)shm;
  const unsigned kvoff=(unsigned)((lane*DM+wid*8)*2);
  const unsigned vvoff=(unsigned)(((16*(wid&3)+(lane>>2))*DM+(wid>>2)*32+(lane&3)*8)*2);
  const unsigned kdst=lds0+W_LDS_K+wid*1024, vdst=lds0+W_LDS_V+wid*1024;
  #define DMA_K(t,slot) glds16s((const char*)K+(long)(t)*(KVBLK*DM*2),kvoff,(unsigned)__builtin_amdgcn_readfirstlane(kdst+(slot)))
  #define DMA_V(t,slot) do{ glds16s((const char*)V+(long)(t)*(KVBLK*DM*2),vvoff,(unsigned)__builtin_amdgcn_readfirstlane(vdst+2*(slot))); glds16s((const char*)V+(long)(t)*(KVBLK*DM*2)+128,vvoff,(unsigned)__builtin_amdgcn_readfirstlane(vdst+2*(slot)+8192)); }while(0)
  const char*Kbase=shm+W_LDS_K; bf16x8 kf[8];
  const lds_cptr shm3=(lds_cptr)shm; __attribute__((address_space(3))) float*const wsf=(__attribute__((address_space(3))) float*)(shm3+W_LDS_WS)+wid*64;
  const lds_cptr kp0=shm3+W_LDS_K+hi*1024+r32*16; const lds_cptr vp0=shm3+W_LDS_V+((lane>>4)&1)*32+(lane&3)*8+(4*hi+((lane&15)>>2))*64;
  const int NT=(q0+QB)/KVBLK;
  DMA_K(0,0);DMA_V(0,0);DMA_K(1,SLOTB);
  bf16x8 qr[4];
  #pragma unroll
  for(int d0=0;d0<4;++d0)qr[d0]=*reinterpret_cast<const bf16x8*>(&Qw[(long)r32*DM+d0*16+hi*8]);
  float mhat=0.f,l_reg=0.f;f32x16 o[4];o[0]=f32x16{};o[1]=f32x16{};o[2]=f32x16{};o[3]=f32x16{};f32x16 negm; { float z_=0.f; asm volatile("":"+v"(z_)); _Pragma("unroll") for(int r=0;r<16;++r)negm[r]=z_; }
  #define CMASK(P0,P1,t) do{int jb_=(t)-(NT-4); if(jb_>=0)cmask(P0,P1,jb_,wid>>1);}while(0)
  bool resc=false;
  #define RESC() do{ if(resc){ asm volatile("s_waitcnt lgkmcnt(0)":::"memory"); \
      _Pragma("unroll") for(int d_=0;d_<4;++d_) _Pragma("unroll") for(int r=0;r<16;++r)o[d_][r]*=wsf[crow(r,hi)]; } }while(0)
  f32x16 c0,c1;
  u32x4 pa0,pa1,pa2,pa3,pb0,pb1,pb2,pb3;
  int sl_prev=0,sl_cur=0,sl_next=SLOTB;
  #define ROT() do{sl_prev=sl_cur;sl_cur=sl_next;sl_next=(sl_next==(NSLOT-1)*SLOTB)?0:sl_next+SLOTB;}while(0)
  #define PKW(P,B) cvtpk_s(P[B],P[B+1])
  DMA_K(2,2*SLOTB);
  WAIT_BAR(3);
  qkt(c0,c1,Kbase,qr,negm,r32,hi);asm volatile("s_nop 15\n\ts_nop 7":"+v"(c0),"+v"(c1));CMASK(c0,c1,0);
  { const float rm=rowmax(c0,c1); mhat=fadd_s(mhat,rm);
    _Pragma("unroll") for(int r=0;r<16;++r){c0[r]=fsub_s(c0[r],rm);c1[r]=fsub_s(c1[r],rm);}
    _Pragma("unroll") for(int r=0;r<16;++r)negm[r]=-mhat; asm volatile("":"+v"(negm));
    _Pragma("unroll") for(int r=0;r<16;++r){c0[r]=__builtin_amdgcn_exp2f(c0[r]);c1[r]=__builtin_amdgcn_exp2f(c1[r]);}
    float sacc=c0[0]+c0[1]; _Pragma("unroll") for(int r=2;r<16;++r)sacc+=c0[r]; _Pragma("unroll") for(int r=0;r<16;++r)sacc+=c1[r]; l_reg+=sacc;
    pa0=(u32x4){PKW(c0,0),PKW(c0,2),PKW(c0,4),PKW(c0,6)};pa1=(u32x4){PKW(c0,8),PKW(c0,10),PKW(c0,12),PKW(c0,14)};pa2=(u32x4){PKW(c1,0),PKW(c1,2),PKW(c1,4),PKW(c1,6)};pa3=(u32x4){PKW(c1,8),PKW(c1,10),PKW(c1,12),PKW(c1,14)}; }
  WAIT_BAR(0);
  DMA_K(3,0);DMA_V(1,SLOTB);
  ROT();
  kload8(kf,kp0+sl_cur);
  WAIT_BAR(3);
  s16x4 vlo[8],vhi[8];
  #define PAFX(x) __builtin_bit_cast(bf16x8,x)
  #define VFR(i) (bf16x8){vlo[i][0],vlo[i][1],vlo[i][2],vlo[i][3],vhi[i][0],vhi[i][1],vhi[i][2],vhi[i][3]}
  #define PIN(x) asm volatile("":"+v"(x))
  #define MX3(a,b,c) __builtin_fmaxf(__builtin_fmaxf((a),(b)),(c))
  #define EX(v) __builtin_amdgcn_exp2f(v)
  #define MFM(a,b,c) __builtin_amdgcn_mfma_f32_32x32x16_bf16(a,b,c,0,0,0)
  #define VRDQ(i,qoff) do{ vlo[i]=vtr(vp_+((qoff)+(((i)>>2)*4096+((i)&3)*1024))); vhi[i]=vtr(vp_+((qoff)+(((i)>>2)*4096+((i)&3)*1024+512))); }while(0)
  #define KRD(G,j) do{ if(G){ kload2(kf,kp0+sl_next,j); SBAR(); } }while(0)
  #define GAPA(MF) do{ MF; SBAR(); }while(0)
  #define GAPB(MF,X,B,I) do{ MF; X[B]=EX(X[B]); X[B+1]=EX(X[B+1]); X[B+2]=EX(X[B+2]); X[B+3]=EX(X[B+3]); PIN(X); VRDQ(I,8192); SBAR(); }while(0)
  #define GAPC(MF,A0,A1,A2,A3,W0,W1,PW) do{ MF; sacc+=A0; sacc+=A1; sacc+=A2; sacc+=A3; PIN(sacc); W0; W1; PIN(PW); SBAR(); }while(0)
  #define STEPW(PO0,PO1,PO2,PO3,PN0,PN1,PN2,PN3,t,GK,GV,GL) do{ SBAR(); \
    const lds_cptr vp_=vp0+2*sl_prev; \
    VRDQ(0,0); SBAR(); GAPA(c0=MFM(kf[0],qr[0],negm)); \
    VRDQ(4,0); SBAR(); GAPA(c1=MFM(kf[1],qr[0],negm)); \
    VRDQ(1,0); SBAR(); GAPA(c0=MFM(kf[2],qr[1],c0)); \
    VRDQ(5,0); SBAR(); GAPA(c1=MFM(kf[3],qr[1],c1)); \
    VRDQ(2,0); SBAR(); GAPA(c0=MFM(kf[4],qr[2],c0)); \
    VRDQ(6,0); SBAR(); GAPA(c1=MFM(kf[5],qr[2],c1)); \
    VRDQ(3,0); SBAR(); GAPA(c0=MFM(kf[6],qr[3],c0)); \
    VRDQ(7,0); SBAR(); GAPA(c1=MFM(kf[7],qr[3],c1)); \
    if(GK){DMA_K((t)+3,sl_cur);} if(GV){DMA_V((t)+1,sl_next);} \
    CMASK(c0,c1,t); \
    { float a=MX3(c0[0],c0[1],c1[0]),b=MX3(c0[2],c0[3],c1[1]); a=MX3(a,c1[2],c1[3]); \
      _Pragma("unroll") for(int r=4;r<16;r+=4){a=MX3(a,c0[r],c0[r+1]);b=MX3(b,c0[r+2],c0[r+3]);a=MX3(a,c1[r],c1[r+1]);b=MX3(b,c1[r+2],c1[r+3]);} \
      float rm=__builtin_fmaxf(a,b); { auto rr=__builtin_amdgcn_permlane32_swap(__float_as_uint(rm),__float_as_uint(rm),false,false); rm=__builtin_fmaxf(__uint_as_float(rr[0]),__uint_as_float(rr[1])); } \
      resc=false; \
      if(__builtin_expect(__any(rm>(float)THRL),0)){ const float dl=__builtin_fmaxf(rm,0.f); mhat+=dl; \
        _Pragma("unroll") for(int r=0;r<16;++r){c0[r]-=dl;c1[r]-=dl;} \
        _Pragma("unroll") for(int r=0;r<16;++r)negm[r]=-mhat; asm volatile("":"+v"(negm)); \
        const float f=__builtin_amdgcn_exp2f(-dl); l_reg*=f; if(hi==0)wsf[r32]=f; resc=true; } } \
    SBAR(); \
    GAPB(o[0]=MFM(PAFX(PO0),VFR(0),o[0]), c0,0, 0); \
    GAPB(o[1]=MFM(PAFX(PO0),VFR(4),o[1]), c0,4, 4); \
    KRD(GL,0); GAPB(o[0]=MFM(PAFX(PO1),VFR(1),o[0]), c0,8, 1); \
    KRD(GL,1); GAPB(o[1]=MFM(PAFX(PO1),VFR(5),o[1]), c0,12, 5); \
    KRD(GL,2); GAPB(o[0]=MFM(PAFX(PO2),VFR(2),o[0]), c1,0, 2); \
    KRD(GL,3); GAPB(o[1]=MFM(PAFX(PO2),VFR(6),o[1]), c1,4, 6); \
    GAPB(o[0]=MFM(PAFX(PO3),VFR(3),o[0]), c1,8, 3); \
    GAPB(o[1]=MFM(PAFX(PO3),VFR(7),o[1]), c1,12, 7); \
    float sacc=(c0[0]+c0[1]); \
    GAPC(o[2]=MFM(PAFX(PO0),VFR(0),o[2]), c0[2],c0[3],c0[4],c0[5],     PN0[0]=PKW(c0,0), PN0[1]=PKW(c0,2), PN0); \
    GAPC(o[3]=MFM(PAFX(PO0),VFR(4),o[3]), c0[6],c0[7],c0[8],c0[9],     PN0[2]=PKW(c0,4), PN0[3]=PKW(c0,6), PN0); \
    GAPC(o[2]=MFM(PAFX(PO1),VFR(1),o[2]), c0[10],c0[11],c0[12],c0[13], PN1[0]=PKW(c0,8), PN1[1]=PKW(c0,10), PN1); \
    GAPC(o[3]=MFM(PAFX(PO1),VFR(5),o[3]), c0[14],c0[15],c1[0],c1[1],   PN1[2]=PKW(c0,12),PN1[3]=PKW(c0,14), PN1); \
    GAPC(o[2]=MFM(PAFX(PO2),VFR(2),o[2]), c1[2],c1[3],c1[4],c1[5],     PN2[0]=PKW(c1,0), PN2[1]=PKW(c1,2), PN2); \
    GAPC(o[3]=MFM(PAFX(PO2),VFR(6),o[3]), c1[6],c1[7],c1[8],c1[9],     PN2[2]=PKW(c1,4), PN2[3]=PKW(c1,6), PN2); \
    GAPC(o[2]=MFM(PAFX(PO3),VFR(3),o[2]), c1[10],c1[11],c1[12],c1[13], PN3[0]=PKW(c1,8), PN3[1]=PKW(c1,10), PN3); \
    GAPC(o[3]=MFM(PAFX(PO3),VFR(7),o[3]), c1[14],c1[15],0.f,0.f,       PN3[2]=PKW(c1,12),PN3[3]=PKW(c1,14), PN3); \
    l_reg+=sacc; \
    }while(0)
  int t=1;
  #undef CMASK
  #define CMASK(P0,P1,t) do{}while(0)
  for(;t+5<NT;t+=2){
    STEPW(pa0,pa1,pa2,pa3,pb0,pb1,pb2,pb3,t,true,true,true);     WAIT_BAR(3); RESC(); ROT();
    STEPW(pb0,pb1,pb2,pb3,pa0,pa1,pa2,pa3,t+1,true,true,true);   WAIT_BAR(3); RESC(); ROT();
  }
  #undef CMASK
  #define CMASK(P0,P1,t) do{int jb_=(t)-(NT-4); if(jb_>=0)cmask(P0,P1,jb_,wid>>1);}while(0)
  #define ENDW(tt) do{ if((tt)+3<NT){WAIT_BAR(3);} else if((tt)+2<NT){WAIT_BAR(2);} else {WAIT_BAR(0);} }while(0)
  for(;t+1<NT;t+=2){
    STEPW(pa0,pa1,pa2,pa3,pb0,pb1,pb2,pb3,t,(t+3<NT),(t+1<NT),(t+1<NT));       ENDW(t);   RESC(); ROT();
    STEPW(pb0,pb1,pb2,pb3,pa0,pa1,pa2,pa3,t+1,(t+4<NT),(t+2<NT),(t+2<NT));     ENDW(t+1); RESC(); ROT();
  }
  STEPW(pa0,pa1,pa2,pa3,pb0,pb1,pb2,pb3,NT-1,false,false,false); RESC();
  { SBAR();
    #pragma unroll
    for(int q=0;q<4;++q){ s16x4 lo[4],hh[4]; const int vb=(int)(unsigned)(uintptr_t)vp0+2*sl_cur;
      #pragma unroll
      for(int ks=0;ks<4;++ks){
        asm volatile("ds_read_b64_tr_b16 %0,%1 offset:%c2":"=&v"(lo[ks]):"v"(vb),"i"(q*4096+ks*1024):"memory");
        asm volatile("ds_read_b64_tr_b16 %0,%1 offset:%c2":"=&v"(hh[ks]):"v"(vb),"i"(q*4096+ks*1024+512):"memory");}
      asm volatile("s_waitcnt lgkmcnt(0)":::"memory");SBAR();
      #define PK(k) (bf16x8){lo[k][0],lo[k][1],lo[k][2],lo[k][3],hh[k][0],hh[k][1],hh[k][2],hh[k][3]}
      o[q]=MFM(PAFX(pb0),PK(0),o[q]); o[q]=MFM(PAFX(pb1),PK(1),o[q]); o[q]=MFM(PAFX(pb2),PK(2),o[q]); o[q]=MFM(PAFX(pb3),PK(3),o[q]);
      #undef PK
    } }
  #undef PKW
  #undef PAFX
  #undef VFR
  #undef PIN
  #undef MX3
  #undef EX
  #undef MFM
  #undef VRDQ
  #undef KRD
  #undef GAPA
  #undef GAPB
  #undef GAPC
  #undef STEPW
  #undef ENDW
  {auto rr=__builtin_amdgcn_permlane32_swap(__float_as_uint(l_reg),__float_as_uint(l_reg),false,false);l_reg=__uint_as_float(rr[0])+__uint_as_float(rr[1]);}
  if(hi==0)wsf[32+r32]=l_reg;asm volatile("s_waitcnt lgkmcnt(0)":::"memory");
  float rli[16];
  #pragma unroll
  for(int r=0;r<16;++r)rli[r]=__builtin_amdgcn_rcpf(wsf[32+crow(r,hi)]);
  float*Ow=O+(long)(q0+wid*QBLK)*DM;
  { float*stg=(float*)(shm+W_LDS_OST)+wid*1024;
    #pragma unroll
    for(int q=0;q<4;++q){
      #pragma unroll
      for(int r=0;r<16;++r)stg[crow(r,hi)*32+r32]=o[q][r]*rli[r];
      asm volatile("s_waitcnt lgkmcnt(0)":::"memory");
      #pragma unroll
      for(int i=0;i<4;++i){const int row=i*8+(lane>>3),ch=lane&7; const u32x4 v=*(const u32x4*)(stg+row*32+ch*4); *(u32x4*)(Ow+(long)row*DM+q*32+ch*4)=v;}
      asm volatile("s_waitcnt lgkmcnt(0)":::"memory");
    } }
  asm volatile("s_waitcnt lgkmcnt(0)\n\ts_barrier":::"memory");
  #undef DMA_K
  #undef DMA_V
  #undef CMASK
  #undef RESC
  #undef ROT
}
constexpr int ATTN_LDS_BYTES=W_LDS_BYTES>LDS_BYTES?W_LDS_BYTES:LDS_BYTES;
#undef SBAR
#undef WAIT_BAR
}
#define GAS __attribute__((address_space(1)))
#define LAS __attribute__((address_space(3)))
typedef unsigned short bf16;
typedef unsigned v4u __attribute__((ext_vector_type(4)));
typedef float f32x4 __attribute__((ext_vector_type(4)));
typedef short bf16x8 __attribute__((ext_vector_type(8)));
typedef GAS unsigned gu32;
typedef GAS unsigned long long gu64;
#define RLX_AGENT __ATOMIC_RELAXED, __HIP_MEMORY_SCOPE_AGENT
#define LDS_WAIT() asm volatile("s_waitcnt lgkmcnt(0)" ::: "memory")
#define VM_WAIT() asm volatile("s_waitcnt vmcnt(0)" ::: "memory")
__device__ __forceinline__ unsigned long long rt() { return __builtin_amdgcn_s_memrealtime(); }
__device__ __forceinline__ unsigned f2bf(float f) { unsigned u = __builtin_bit_cast(unsigned, f); return (u + 0x7fffu + ((u >> 16) & 1u)) >> 16; }
__device__ __forceinline__ unsigned pk2(float lo, float hi) { return f2bf(lo) | (f2bf(hi) << 16); }

#define XB_TMO      128
#define XB_XCNT(j)  (256  + 64 * (j))
#define XB_XSUB(j)  (1280 + 64 * (j))
#define XB_XGEN(j)  (2304 + 64 * (j))
#define XB_TOP      3328
#define XB_TOPGEN   3392
#define XCD_BAR_WORDS 3456
#define XB_SPIN_CAP (1u << 18)

__device__ __forceinline__ unsigned xb_ld(unsigned* p)              { return __hip_atomic_load(p, __ATOMIC_RELAXED, __HIP_MEMORY_SCOPE_AGENT); }
__device__ __forceinline__ unsigned xb_add(unsigned* p, unsigned v) { return __hip_atomic_fetch_add(p, v, __ATOMIC_RELAXED, __HIP_MEMORY_SCOPE_AGENT); }
__device__ __forceinline__ unsigned xb_xcc_id() { return (unsigned)__builtin_amdgcn_s_getreg((3 << 11) | 20) & 0xFu; }
#define XB_SPIN(cond, bar) do { unsigned _sp = 0; while (cond) { __builtin_amdgcn_s_sleep(1); \
    if ((++_sp & 255u) == 0u) { if (xb_ld(&(bar)[XB_TMO])) break; if (_sp > XB_SPIN_CAP) { atomicAdd(&(bar)[XB_TMO], 1u); break; } } } } while (0)

struct XcdBarrier {
    unsigned* bar; unsigned x;
    volatile LAS unsigned* st;
};

__device__ __forceinline__ XcdBarrier xcd_barrier_post(unsigned* bar, volatile LAS unsigned* st) {
    XcdBarrier b; b.bar = bar; b.x = xb_xcc_id(); b.st = st;
    if (threadIdx.x == 0) (void)xb_add(&bar[XB_XCNT(b.x)], 1u);
    return b;
}
__device__ __forceinline__ void xcd_barrier_complete(unsigned* bar, unsigned x, unsigned& nloc, unsigned& nx) {
    const unsigned G = gridDim.x * gridDim.y * gridDim.z;
    unsigned sum, cnt, mine, sp = 0u;
    for (;;) {
        sum = 0u; cnt = 0u; mine = 0u;
#pragma unroll
        for (unsigned j = 0; j < 16; ++j) { const unsigned c = xb_ld(&bar[XB_XCNT(j)]); sum += c; cnt += (c > 0u) ? 1u : 0u; mine = (j == x) ? c : mine; }
        if (sum == G) break;
        __builtin_amdgcn_s_sleep(1);
        if ((++sp & 255u) == 0u) { if (xb_ld(&bar[XB_TMO])) break; if (sp > XB_SPIN_CAP) { atomicAdd(&bar[XB_TMO], 1u); break; } }
    }
    nloc = mine > 0u ? mine : 1u; nx = cnt > 0u ? cnt : 1u;
}

__device__ __forceinline__ void xcd_barrier(const XcdBarrier& b) {
    asm volatile("s_waitcnt vmcnt(0)" ::: "memory");
    __syncthreads();
    if (threadIdx.x == 0) {
        unsigned* bar = b.bar;
        __builtin_amdgcn_s_waitcnt(0);
        unsigned nloc = b.st[0], nx = b.st[1];
        if (nloc == 0u) { xcd_barrier_complete(bar, b.x, nloc, nx); b.st[0] = nloc; b.st[1] = nx; }
        const unsigned old = xb_add(&bar[XB_XSUB(b.x)], 1u);
        const unsigned gen = old / nloc;
        if (old + 1u == (gen + 1u) * nloc) {
            __builtin_amdgcn_fence(__ATOMIC_RELEASE, "agent");
            asm volatile("s_waitcnt vmcnt(0)" ::: "memory");
            const unsigned og = xb_add(&bar[XB_TOP], 1u);
            const unsigned tg = og / nx;
            if (og + 1u == (tg + 1u) * nx) xb_add(&bar[XB_TOPGEN], 1u);
            else XB_SPIN(xb_ld(&bar[XB_TOPGEN]) == tg, bar);
            __builtin_amdgcn_fence(__ATOMIC_ACQUIRE, "agent");
            xb_add(&bar[XB_XGEN(b.x)], 1u);
            asm volatile("s_waitcnt vmcnt(0)" ::: "memory");
        } else {
            XB_SPIN(xb_ld(&bar[XB_XGEN(b.x)]) == gen, bar);
            __builtin_amdgcn_fence(__ATOMIC_ACQUIRE, "agent");
            asm volatile("s_waitcnt vmcnt(0)" ::: "memory");
        }
    }
    __syncthreads();
}
typedef unsigned short bf16_t;
typedef float f32x4 __attribute__((ext_vector_type(4)));
typedef float f32x16 __attribute__((ext_vector_type(16)));
typedef unsigned u32x2 __attribute__((ext_vector_type(2)));
typedef unsigned u32x4v __attribute__((ext_vector_type(4)));
typedef short bf16x8 __attribute__((ext_vector_type(8)));
__device__ __forceinline__ float bflo(unsigned w) { return __uint_as_float(w << 16); }
__device__ __forceinline__ float bfhi(unsigned w) { return __uint_as_float(w & 0xffff0000u); }
__device__ __forceinline__ unsigned pkbf(float lo, float hi) { return pg8::cvt_pk_bf16(lo, hi); }
__device__ __forceinline__ float sigm(float x) { return __builtin_amdgcn_rcpf(1.f + __builtin_amdgcn_exp2f(-1.4426950408889634f * x)); }
template <int MSK> __device__ __forceinline__ float xor_swz(float v) { return __int_as_float(__builtin_amdgcn_ds_swizzle(__float_as_int(v), (MSK << 10) | 0x1f)); }
__device__ __forceinline__ float sum_halves(float v) { auto rr = __builtin_amdgcn_permlane32_swap(__float_as_uint(v), __float_as_uint(v), false, false); return __uint_as_float(rr[0]) + __uint_as_float(rr[1]); }
__device__ __forceinline__ float max_halves(float v) { auto rr = __builtin_amdgcn_permlane32_swap(__float_as_uint(v), __float_as_uint(v), false, false); return fmaxf(__uint_as_float(rr[0]), __uint_as_float(rr[1])); }
__device__ __forceinline__ float wave_sum(float v) { v += xor_swz<1>(v); v += xor_swz<2>(v); v += xor_swz<4>(v); v += xor_swz<8>(v); v += xor_swz<16>(v); return sum_halves(v); }
__device__ __forceinline__ int fresh_tid(int wave) { int l_; asm volatile("v_mbcnt_lo_u32_b32 %0, -1, 0\n\tv_mbcnt_hi_u32_b32 %0, -1, %0" : "=v"(l_)); return wave * 64 + l_; }
__device__ __forceinline__ int crow16(int r, int hi) { return (r & 3) + 8 * (r >> 2) + 4 * hi; }

struct EpiIn {
    static constexpr bool PERM = false, AFTER_DRAIN = false; static constexpr int MIDK = 0;
    bf16_t *PXB, *SPG, *QB, *KB, *VB, *SAG, *SGA, *SGB, *RSB; float* out; const float* rc; const float* rs; int layer;
    __device__ __forceinline__ void operator()(const pg8::f32x4 (&acc)[2][2][4][2], const pg8::Unit& u, int wr, int wc, int fr, int fq) const {
        const int pn = u.pn, row0 = u.pm * 256 + wr * 64 + fr;
        const bool samp = u.pm >= MP / 256;
        if (pn >= 4 && pn < 12) {
            const bool isk = pn >= 8;
            const int cbase = (pn - (isk ? 8 : 4)) * 256 + (wc >> 1) * 64 + (wc & 1) * 16 + 4 * fq;
            const int i0 = (wc & 1) * 16 + 4 * fq;
            bf16_t* dstb = isk ? KB : QB; const float sc = isk ? 1.f : C2;
#pragma unroll
            for (int ai = 0; ai < 2; ++ai)
#pragma unroll
                for (int m = 0; m < 4; ++m) {
                    const int row = row0 + ai * 128 + m * 16;
                    const int pos = samp ? PAST + ((row - MP) & 15) : (row & (SEQ - 1));
                    const f32x4 c = *(const f32x4*)(rc + pos * 32 + i0), s = *(const f32x4*)(rs + pos * 32 + i0);
                    float* ko = samp ? out + O_KS + ((size_t)layer * MS + (row - MP)) * 1024 : out + O_KP + ((size_t)layer * MP + row) * 1024;
#pragma unroll
                    for (int bj = 0; bj < 2; ++bj) {
                        const f32x4 x1 = acc[ai][bj][m][0], x2 = acc[ai][bj][m][1];
                        const f32x4 r1 = x1 * c - x2 * s, r2 = x2 * c + x1 * s;
                        const int col = cbase + bj * 128;
                        if (isk) { *(f32x4*)(ko + col) = r1; *(f32x4*)(ko + col + 32) = r2; }
                        u32x2 w1, w2; w1.x = pkbf(r1[0] * sc, r1[1] * sc); w1.y = pkbf(r1[2] * sc, r1[3] * sc); w2.x = pkbf(r2[0] * sc, r2[1] * sc); w2.y = pkbf(r2[2] * sc, r2[3] * sc);
                        *(u32x2*)(dstb + (size_t)row * 1024 + col) = w1; *(u32x2*)(dstb + (size_t)row * 1024 + col + 32) = w2;
                    }
                }
        } else {
            int mode, ld, cb; bf16_t* dst;
            if (pn < 2) { dst = PXB; ld = 512; cb = pn * 256; mode = 0; }
            else if (pn < 4) { dst = SPG; ld = 512; cb = (pn - 2) * 256; mode = 1; }
            else if (pn < 16) { dst = VB; ld = 1024; cb = (pn - 12) * 256; mode = 0; }
            else if (pn < 20) { dst = SAG; ld = 1024; cb = (pn - 16) * 256; mode = 1; }
            else if (pn < 24) { dst = SGA; ld = 1024; cb = (pn - 20) * 256; mode = 2; }
            else { dst = SGB; ld = 1024; cb = (pn - 24) * 256; mode = 3; }
            cb += 32 * wc + 8 * fq;
            const bool isv = pn >= 12 && pn < 16, ispx = pn < 2;
#pragma unroll
            for (int ai = 0; ai < 2; ++ai)
#pragma unroll
                for (int m = 0; m < 4; ++m) {
                    const int row = row0 + ai * 128 + m * 16;
                    float* fo = nullptr;
                    if (isv) fo = samp ? out + O_VS + ((size_t)layer * MS + (row - MP)) * 1024 : out + O_VP + ((size_t)layer * MP + row) * 1024;
                    else if (ispx) {
                        if (!samp) { const int t = row & (SEQ - 1); if (t >= SEQ - 15) fo = out + O_PP + (((size_t)layer * BATCH + (row >> 12)) * 15 + (t - (SEQ - 15))) * 512; }
                        else { const int rs_ = row - MP, j = rs_ & 15; if (j >= 1) fo = out + O_PS + (((size_t)layer * DEC_BATCH + (rs_ >> 4)) * 15 + (j - 1)) * 512; }
                    }
#pragma unroll
                    for (int bj = 0; bj < 2; ++bj) {
                        f32x4 v0 = acc[ai][bj][m][0], v1 = acc[ai][bj][m][1];
                        const int col = cb + bj * 128;
                        if (fo) { *(f32x4*)(fo + col) = v0; *(f32x4*)(fo + col + 4) = v1; }
                        if (mode == 1) {
#pragma unroll
                            for (int k = 0; k < 4; ++k) { v0[k] = v0[k] * sigm(v0[k]); v1[k] = v1[k] * sigm(v1[k]); }
                        } else if (mode == 2) {
#pragma unroll
                            for (int k = 0; k < 4; ++k) { v0[k] = sigm(v0[k]); v1[k] = sigm(v1[k]); }
                        } else if (mode == 3) {
                            f32x4 e0, e1;
#pragma unroll
                            for (int k = 0; k < 4; ++k) { e0[k] = 1.f + __builtin_amdgcn_exp2f(-1.4426950408889634f * v0[k]); e1[k] = 1.f + __builtin_amdgcn_exp2f(-1.4426950408889634f * v1[k]);
                                v0[k] = __builtin_amdgcn_rcpf(e0[k]); v1[k] = __builtin_amdgcn_rcpf(e1[k]); }
                            u32x4v w2; w2.x = pkbf(e0[0], e0[1]); w2.y = pkbf(e0[2], e0[3]); w2.z = pkbf(e1[0], e1[1]); w2.w = pkbf(e1[2], e1[3]);
                            *(u32x4v*)(RSB + (size_t)row * ld + col) = w2;
                        }
                        u32x4v w; w.x = pkbf(v0[0], v0[1]); w.y = pkbf(v0[2], v0[3]); w.z = pkbf(v1[0], v1[1]); w.w = pkbf(v1[2], v1[3]);
                        *(u32x4v*)(dst + (size_t)row * ld + col) = w;
                    }
                }
        }
    }
};
struct EpiMerge {
    static constexpr bool PERM = false, AFTER_DRAIN = false; static constexpr int MIDK = 8;
    const bf16_t *SGA, *SGB, *RSB; bf16_t* MG;
    __device__ __forceinline__ void mid(pg8::f32x4 (&acc)[2][2][4][2], const pg8::Unit& u, int wr, int wc, int fr, int fq) const {
        asm volatile("" : "+v"(fr), "+v"(fq));
        const int row0 = u.pm * 256 + wr * 64 + fr, col0 = u.pn * 256 + wc * 32 + 4 * fq;
#pragma unroll
        for (int ai = 0; ai < 2; ++ai)
#pragma unroll
            for (int m = 0; m < 4; ++m) { const size_t ro = (size_t)(row0 + ai * 128 + m * 16) * 1024 + col0;
                u32x2 ga[2][2], rb[2][2];
#pragma unroll
                for (int bj = 0; bj < 2; ++bj)
#pragma unroll
                    for (int n = 0; n < 2; ++n) { const size_t o = ro + bj * 128 + n * 16; ga[bj][n] = *(const u32x2*)(SGA + o); rb[bj][n] = *(const u32x2*)(RSB + o); }
#pragma unroll
                for (int bj = 0; bj < 2; ++bj)
#pragma unroll
                    for (int n = 0; n < 2; ++n) { pg8::f32x4& a = acc[ai][bj][m][n]; const u32x2 g = ga[bj][n], r = rb[bj][n];
                        a[0] *= bflo(g.x) * bflo(r.x); a[1] *= bfhi(g.x) * bfhi(r.x); a[2] *= bflo(g.y) * bflo(r.y); a[3] *= bfhi(g.y) * bfhi(r.y); } }
    }
    __device__ __forceinline__ void operator()(const pg8::f32x4 (&acc)[2][2][4][2], const pg8::Unit& u, int wr, int wc, int fr, int fq) const {
        const int row0 = u.pm * 256 + wr * 64 + fr, col0 = u.pn * 256 + wc * 32 + 4 * fq;
#pragma unroll
        for (int ai = 0; ai < 2; ++ai)
#pragma unroll
            for (int m = 0; m < 4; ++m) { const size_t ro = (size_t)(row0 + ai * 128 + m * 16) * 1024 + col0;
#pragma unroll
                for (int bj = 0; bj < 2; ++bj)
#pragma unroll
                    for (int n = 0; n < 2; ++n) { const size_t o = ro + bj * 128 + n * 16; const u32x2 g = *(const u32x2*)(SGB + o);
                        const pg8::f32x4 a = acc[ai][bj][m][n];
                        u32x2 w; w.x = pkbf(a[0] * bflo(g.x), a[1] * bfhi(g.x)); w.y = pkbf(a[2] * bflo(g.y), a[3] * bfhi(g.y)); *(u32x2*)(MG + o) = w; } }
    }
};
struct EpiOut {
    static constexpr bool PERM = false, AFTER_DRAIN = false; static constexpr int MIDK = 0;
    float* Xr;
    __device__ __forceinline__ void operator()(const pg8::f32x4 (&acc)[2][2][4][2], const pg8::Unit& u, int wr, int wc, int fr, int fq) const {
        const int row0 = u.pm * 256 + wr * 64 + fr, col0 = u.pn * 256 + wc * 32 + 4 * fq;
#pragma unroll
        for (int ai = 0; ai < 2; ++ai)
#pragma unroll
            for (int m = 0; m < 4; ++m) { const size_t ro = (size_t)(row0 + ai * 128 + m * 16) * 1024 + col0;
#pragma unroll
                for (int bj = 0; bj < 2; ++bj)
#pragma unroll
                    for (int n = 0; n < 2; ++n) { const size_t o = ro + bj * 128 + n * 16; const f32x4 x = *(const f32x4*)(Xr + o); *(f32x4*)(Xr + o) = x * ALPHA + acc[ai][bj][m][n]; } }
    }
};

__device__ __forceinline__ int inv_perm_S(int a) { const int bj = a >> 7, wc = (a >> 5) & 3, fq = (a >> 3) & 3, n = (a >> 2) & 1, j = a & 3; return 128 * bj + 32 * wc + 16 * n + 4 * fq + j; }
__device__ __forceinline__ int inv_perm_R(int a) { const int bj = a >> 7, wch = (a >> 6) & 1, n = (a >> 5) & 1, wcl = (a >> 4) & 1, fq = (a >> 2) & 3, j = a & 3; return 128 * bj + 32 * (2 * wch + wcl) + 16 * n + 4 * fq + j; }
template <int PM>
__device__ __forceinline__ void p0_transpose_item(const float* W, int K, int N, bf16_t* WT, int ldt, LAS float* scr, int item, int lane) {
    const int nblk = N / 32, kb = item / nblk, nb = item % nblk, k0 = 64 * kb, n0 = 32 * nb;
#pragma unroll 8
    for (int i = 0; i < 32; ++i) { const int kk = 2 * i + (lane >> 5); scr[kk * 33 + (lane & 31)] = W[(size_t)(k0 + kk) * N + n0 + (lane & 31)]; }
    LDS_WAIT(); asm volatile("" ::: "memory");
    const int c = lane & 7;
#pragma unroll
    for (int j = 0; j < 4; ++j) { const int n = (lane >> 3) + 8 * j; const LAS float* s = scr + (8 * c) * 33 + n;
        v4u o; o.x = pkbf(s[0 * 33], s[1 * 33]); o.y = pkbf(s[2 * 33], s[3 * 33]); o.z = pkbf(s[4 * 33], s[5 * 33]); o.w = pkbf(s[6 * 33], s[7 * 33]);
        int nr = n0 + n;
        if (PM == 1) { const int tile = nr >> 8, a = nr & 255; nr = (nr & ~255) + ((tile >= 4 && tile < 12) ? inv_perm_R(a) : inv_perm_S(a)); }
        *(GAS v4u*)(WT + (size_t)nr * ldt + k0 + 8 * c) = o; }
    LDS_WAIT(); asm volatile("" ::: "memory");
}
__device__ __forceinline__ void ln_row(const float* xrow, const float* g, const float* b, float* of, bf16_t* ob) {
    const int lane = fresh_tid(0);
    const GAS f32x4* xr = (const GAS f32x4*)xrow + lane;
    f32x4 v[4]; float s = 0.f;
#pragma unroll
    for (int j = 0; j < 4; ++j) { v[j] = xr[64 * j]; s += (v[j].x + v[j].y) + (v[j].z + v[j].w); }
    const float mean = wave_sum(s) * (1.f / 1024.f); float s2 = 0.f;
#pragma unroll
    for (int j = 0; j < 4; ++j) { v[j] = v[j] - mean; s2 += (v[j].x * v[j].x + v[j].y * v[j].y) + (v[j].z * v[j].z + v[j].w * v[j].w); }
    const float rstd = 1.f / sqrtf(wave_sum(s2) * (1.f / 1024.f) + LN_EPS);
    GAS f32x4* o4 = (GAS f32x4*)of + lane; GAS u32x2* o8 = (GAS u32x2*)ob + lane;
#pragma unroll
    for (int j = 0; j < 4; ++j) { const f32x4 gg = ((const GAS f32x4*)g + lane)[64 * j], bb = ((const GAS f32x4*)b + lane)[64 * j];
        const f32x4 y = v[j] * rstd * gg + bb; o4[64 * j] = y; u32x2 w; w.x = pkbf(y.x, y.y); w.y = pkbf(y.z, y.w); o8[64 * j] = w; }
}

__device__ __forceinline__ void phase_stagger(long first_short, int c, unsigned step) {
#ifndef NO_STAGGER
    asm volatile("" : "+s"(c));
    if ((long)c >= first_short) { const unsigned long long t0 = __builtin_amdgcn_s_memrealtime(); const unsigned long long d = (unsigned long long)((unsigned)(c & 3) * step);
        while (__builtin_amdgcn_s_memrealtime() - t0 < d) __builtin_amdgcn_s_sleep(8); }
#endif
}
struct Params { const float* in[17]; float* out; unsigned char* ws; int l_lo, l_hi, do_pro, bar_region; };
enum { I_XP = 0, I_XS, I_CK, I_CV, I_SP, I_LIG, I_LIB, I_WIN, I_WPOOL, I_PSC, I_LQK, I_SUBLN, I_WA, I_WB, I_WO, I_LNG, I_LNB };

constexpr int POOL_TILE_PITCH = 272, POOL_TILE_BYTES = 12800, POOL_NITEMS = (MP / 32) * 4 + DEC_BATCH * 4;
__device__ __forceinline__ void pool_item(int item, int layer, const Params& P, LAS unsigned char* tile) {
    const int lane = fresh_tid(0);
    constexpr int NPI = (MP / 32) * 4;
    const bool samp = item >= NPI;
    int g, R0, nrows;
    if (!samp) { g = item / (MP / 32); R0 = (item % (MP / 32)) * 32; nrows = 32; } else { const int si = item - NPI; g = si / DEC_BATCH; R0 = MP + (si % DEC_BATCH) * 16; nrows = 16; }
    const int w = 2 << g, ntr = 15 + nrows;
    const bf16_t* PXB = (const bf16_t*)(P.ws + WS_PXB); const bf16_t* SPG = (const bf16_t*)(P.ws + WS_SPG); bf16_t* YA = (bf16_t*)(P.ws + WS_YAB);
    const bf16_t* WpT = (const bf16_t*)(P.ws + WS_WP) + (size_t)(layer * 4 + g) * 128 * 128;
    if (!samp) {
        const int t0 = R0 & (SEQ - 1);
        u32x4v v[12];
#pragma unroll
        for (int i = 0; i < 12; ++i) { const int p = i * 64 + lane, trow = p >> 4, c16 = p & 15; const bool ok = trow < ntr && (t0 + trow - 15) >= 0;
            const int grow = ok ? (R0 - 15 + trow) : R0; v[i] = *(const u32x4v*)(PXB + (size_t)grow * 512 + g * 128 + c16 * 8); if (!ok) v[i] = (u32x4v){0u, 0u, 0u, 0u}; }
#pragma unroll
        for (int i = 0; i < 12; ++i) { const int p = i * 64 + lane, trow = p >> 4, c16 = p & 15; if (trow < ntr) *(LAS u32x4v*)(tile + trow * POOL_TILE_PITCH + c16 * 16) = v[i]; }
    } else {
        const float* hist = P.in[I_SP] + ((size_t)layer * DEC_BATCH + ((R0 - MP) >> 4)) * 15 * 512 + g * 128;
#pragma unroll
        for (int i = 0; i < 8; ++i) { const int p = i * 64 + lane, trow = p >> 4, c16 = p & 15;
            if (trow < ntr) { u32x4v v;
                if (trow >= 15) v = *(const u32x4v*)(PXB + (size_t)(R0 + trow - 15) * 512 + g * 128 + c16 * 8);
                else { const float* hp = hist + (size_t)trow * 512 + c16 * 8; const f32x4 h0 = *(const f32x4*)hp, h1 = *(const f32x4*)(hp + 4);
                    v.x = pkbf(h0[0], h0[1]); v.y = pkbf(h0[2], h0[3]); v.z = pkbf(h1[0], h1[1]); v.w = pkbf(h1[2], h1[3]); }
                *(LAS u32x4v*)(tile + trow * POOL_TILE_PITCH + c16 * 16) = v; } }
    }
    asm volatile("s_waitcnt lgkmcnt(0)" ::: "memory");
    const int r = lane & 31, hi = lane >> 5, rl = r & (nrows - 1), row = R0 + rl;
    bf16x8 afirst[8];
#pragma unroll
    for (int s = 0; s < 8; ++s) afirst[s] = *(const bf16x8*)(WpT + (size_t)r * 128 + 16 * s + 8 * hi);
    int cnt = w; if (!samp) { const int navail = (row & (SEQ - 1)) + 1; cnt = navail < w ? navail : w; }
    const float rcnt = 1.f / (float)cnt;
    bf16x8 bfr[8];
#pragma unroll
    for (int s = 0; s < 8; ++s) {
        const LAS unsigned char* bp = tile + (15 + rl) * POOL_TILE_PITCH + (16 * s + 8 * hi) * 2;
        const u32x4v tk = *(const LAS u32x4v*)bp;
        const float t0[8] = {bflo(tk.x), bfhi(tk.x), bflo(tk.y), bfhi(tk.y), bflo(tk.z), bfhi(tk.z), bflo(tk.w), bfhi(tk.w)};
        float a[8];
#pragma unroll
        for (int k = 0; k < 8; ++k) a[k] = t0[k];
#pragma unroll 4
        for (int d = 1; d < w; ++d) { const u32x4v v = *(const LAS u32x4v*)(bp - d * POOL_TILE_PITCH);
            a[0] += bflo(v.x); a[1] += bfhi(v.x); a[2] += bflo(v.y); a[3] += bfhi(v.y); a[4] += bflo(v.z); a[5] += bfhi(v.z); a[6] += bflo(v.w); a[7] += bfhi(v.w); }
        u32x4v pk; pk.x = pkbf(a[0] * rcnt - t0[0], a[1] * rcnt - t0[1]); pk.y = pkbf(a[2] * rcnt - t0[2], a[3] * rcnt - t0[3]);
        pk.z = pkbf(a[4] * rcnt - t0[4], a[5] * rcnt - t0[5]); pk.w = pkbf(a[6] * rcnt - t0[6], a[7] * rcnt - t0[7]);
        bfr[s] = __builtin_bit_cast(bf16x8, pk);
    }
    const float* psc = P.in[I_PSC] + (size_t)layer * 512 + g * 128;
    bf16x8 af[2][8];
#pragma unroll
    for (int db = 0; db < 4; ++db) {
        if (db == 0) {
#pragma unroll
            for (int s = 0; s < 8; ++s) af[0][s] = afirst[s];
        }
        if (db < 3) {
#pragma unroll
            for (int s = 0; s < 8; ++s) af[(db + 1) & 1][s] = *(const bf16x8*)(WpT + (size_t)(32 * (db + 1) + r) * 128 + 16 * s + 8 * hi);
        }
        f32x4 sc[4]; u32x2 gt[4];
#pragma unroll
        for (int q = 0; q < 4; ++q) { const int d0 = 32 * db + 8 * q + 4 * hi; sc[q] = *(const f32x4*)(psc + d0); gt[q] = *(const u32x2*)(SPG + (size_t)row * 512 + g * 128 + d0); }
        f32x16 acc = {};
#pragma unroll
        for (int s = 0; s < 8; ++s) acc = __builtin_amdgcn_mfma_f32_32x32x16_bf16(af[db & 1][s], bfr[s], acc, 0, 0, 0);
        if (r < nrows) {
#pragma unroll
        for (int q = 0; q < 4; ++q) { const int d0 = 32 * db + 8 * q + 4 * hi;
            u32x2 o; o.x = pkbf(acc[4 * q] * sc[q][0] * bflo(gt[q].x), acc[4 * q + 1] * sc[q][1] * bfhi(gt[q].x)); o.y = pkbf(acc[4 * q + 2] * sc[q][2] * bflo(gt[q].y), acc[4 * q + 3] * sc[q][3] * bfhi(gt[q].y));
            *(u32x2*)(YA + (size_t)row * 1536 + g * 128 + d0) = o; }
        }
    }
    asm volatile("s_waitcnt lgkmcnt(0)" ::: "memory");
}

__device__ __forceinline__ void combine_rows(size_t rowbase, int h, int layer, const Params& P, int wave) {
    const int tid = fresh_tid(wave);
    const float* O1 = (const float*)(P.ws + WS_O1); const float* O2 = (const float*)(P.ws + WS_O2);
    const bf16_t* SAG = (const bf16_t*)(P.ws + WS_SAG); bf16_t* YB = (bf16_t*)(P.ws + WS_YAB) + 512;
    const float* LAM = (const float*)(P.ws + WS_LAM); const float lam = LAM[layer], li = LAM[4 + layer];
    const int rsub = tid >> 4, c8 = (tid & 15) * 8;
    const float* sl = P.in[I_SUBLN] + (size_t)layer * 128 + c8;
    const f32x4 s0 = *(const f32x4*)sl, s1 = *(const f32x4*)(sl + 4);
#pragma unroll 2
    for (int p = 0; p < 8; ++p) {
        const size_t rowi = rowbase + p * 32 + rsub, base = rowi * 1024 + h * 128 + c8;
        const f32x4 a0 = *(const f32x4*)(O1 + base) - lam * *(const f32x4*)(O2 + base), a1 = *(const f32x4*)(O1 + base + 4) - lam * *(const f32x4*)(O2 + base + 4);
        float ss = (a0[0] * a0[0] + a0[1] * a0[1]) + (a0[2] * a0[2] + a0[3] * a0[3]) + (a1[0] * a1[0] + a1[1] * a1[1]) + (a1[2] * a1[2] + a1[3] * a1[3]);
        ss += xor_swz<1>(ss); ss += xor_swz<2>(ss); ss += xor_swz<4>(ss); ss += xor_swz<8>(ss);
        const float rr = (1.f - li) / sqrtf(ss * (1.f / 128.f) + RMS_EPS);
        const u32x4v gt = *(const u32x4v*)(SAG + base);
        u32x4v o; o.x = pkbf(a0[0] * rr * s0[0] * bflo(gt.x), a0[1] * rr * s0[1] * bfhi(gt.x)); o.y = pkbf(a0[2] * rr * s0[2] * bflo(gt.y), a0[3] * rr * s0[3] * bfhi(gt.y));
        o.z = pkbf(a1[0] * rr * s1[0] * bflo(gt.z), a1[1] * rr * s1[1] * bfhi(gt.z)); o.w = pkbf(a1[2] * rr * s1[2] * bflo(gt.w), a1[3] * rr * s1[3] * bfhi(gt.w));
        *(u32x4v*)(YB + rowi * 1536 + h * 128 + c8) = o;
    }
}

__device__ __forceinline__ void sample_unit(int b, int h, int layer, const Params& P, LAS unsigned char* L, int wave) {
    const int tid = fresh_tid(wave), lane = tid & 63;
    const int r = lane & 31, hi = lane >> 5;
    const bf16_t* QB = (const bf16_t*)(P.ws + WS_QB);
    const bf16_t* qrow = QB + (size_t)(MP + b * 16 + (r & 15)) * 1024 + h * 128 + 8 * hi;
    bf16x8 qf[8];
#pragma unroll
    for (int s = 0; s < 8; ++s) { const bool nz = (s < 4) ? (r < 16) : (r >= 16); bf16x8 z = {}; qf[s] = nz ? *(const bf16x8*)(qrow + 16 * s) : z; }
    f32x16 ot[4]; ot[0] = f32x16{}; ot[1] = f32x16{}; ot[2] = f32x16{}; ot[3] = f32x16{};
    float mrun = -INFINITY, lrun = 0.f;
    const float* ck = P.in[I_CK] + ((size_t)(layer * DEC_BATCH + b) * PAST) * 1024 + h * 128;
    const float* cv = P.in[I_CV] + ((size_t)(layer * DEC_BATCH + b) * PAST) * 1024 + h * 128;
    const float* nk = P.out + O_KS + ((size_t)layer * MS + b * 16) * 1024 + h * 128;
    const float* nv = P.out + O_VS + ((size_t)layer * MS + b * 16) * 1024 + h * 128;
    const int ntile = (wave == 0) ? 5 : 4;
    for (int ti = 0; ti < ntile; ++ti) {
        const bool newt = ti == 4;
        const float* kb = newt ? nk : ck + (size_t)(32 * (wave + 8 * ti)) * 1024;
        const float* vb = newt ? nv : cv + (size_t)(32 * (wave + 8 * ti)) * 1024;
        const int rmask = newt ? 15 : 31;
        const float* kr = kb + (size_t)(r & rmask) * 1024 + 8 * hi;
        f32x4 kraw[16];
#pragma unroll
        for (int s = 0; s < 8; ++s) { kraw[2 * s] = *(const f32x4*)(kr + 16 * s); kraw[2 * s + 1] = *(const f32x4*)(kr + 16 * s + 4); }
        float vraw[32];
#pragma unroll
        for (int c = 0; c < 4; ++c)
#pragma unroll
            for (int j = 0; j < 8; ++j) { const int key = (8 * (j >> 2) + 4 * hi + (j & 3)) & rmask; vraw[c * 8 + j] = vb[(size_t)key * 1024 + 32 * c + r]; }
        __builtin_amdgcn_sched_barrier(0);
        f32x16 st = {};
#pragma unroll
        for (int s = 0; s < 8; ++s) { const f32x4 k0 = kraw[2 * s], k1 = kraw[2 * s + 1];
            u32x4v pk; pk.x = pkbf(k0[0], k0[1]); pk.y = pkbf(k0[2], k0[3]); pk.z = pkbf(k1[0], k1[1]); pk.w = pkbf(k1[2], k1[3]);
            st = __builtin_amdgcn_mfma_f32_32x32x16_bf16(__builtin_bit_cast(bf16x8, pk), qf[s], st, 0, 0, 0); }
        float vraw2[32];
#pragma unroll
        for (int c = 0; c < 4; ++c)
#pragma unroll
            for (int j = 0; j < 8; ++j) { const int key = (16 + 8 * (j >> 2) + 4 * hi + (j & 3)) & rmask; vraw2[c * 8 + j] = vb[(size_t)key * 1024 + 32 * c + r]; }
        __builtin_amdgcn_sched_barrier(0);
        if (newt) {
#pragma unroll
            for (int q = 8; q < 16; ++q) st[q] = -INFINITY;
        }
        float tm = st[0];
#pragma unroll
        for (int q = 1; q < 16; ++q) tm = fmaxf(tm, st[q]);
        tm = max_halves(tm);
        const float mnew = fmaxf(mrun, tm), f = __builtin_amdgcn_exp2f(mrun - mnew);
        mrun = mnew; lrun *= f;
#pragma unroll
        for (int c = 0; c < 4; ++c) ot[c] = ot[c] * f;
        float ps = 0.f;
#pragma unroll
        for (int q = 0; q < 16; ++q) { st[q] = __builtin_amdgcn_exp2f(st[q] - mnew); ps += st[q]; }
        lrun += ps;
        bf16x8 pf[2];
#pragma unroll
        for (int sp = 0; sp < 2; ++sp) { u32x4v pk; pk.x = pkbf(st[8 * sp], st[8 * sp + 1]); pk.y = pkbf(st[8 * sp + 2], st[8 * sp + 3]); pk.z = pkbf(st[8 * sp + 4], st[8 * sp + 5]); pk.w = pkbf(st[8 * sp + 6], st[8 * sp + 7]);
            pf[sp] = __builtin_bit_cast(bf16x8, pk); }
#pragma unroll
        for (int c = 0; c < 4; ++c) { u32x4v pk; pk.x = pkbf(vraw[c * 8], vraw[c * 8 + 1]); pk.y = pkbf(vraw[c * 8 + 2], vraw[c * 8 + 3]); pk.z = pkbf(vraw[c * 8 + 4], vraw[c * 8 + 5]); pk.w = pkbf(vraw[c * 8 + 6], vraw[c * 8 + 7]);
            ot[c] = __builtin_amdgcn_mfma_f32_32x32x16_bf16(__builtin_bit_cast(bf16x8, pk), pf[0], ot[c], 0, 0, 0); }
#pragma unroll
        for (int c = 0; c < 4; ++c) { u32x4v pk; pk.x = pkbf(vraw2[c * 8], vraw2[c * 8 + 1]); pk.y = pkbf(vraw2[c * 8 + 2], vraw2[c * 8 + 3]); pk.z = pkbf(vraw2[c * 8 + 4], vraw2[c * 8 + 5]); pk.w = pkbf(vraw2[c * 8 + 6], vraw2[c * 8 + 7]);
            ot[c] = __builtin_amdgcn_mfma_f32_32x32x16_bf16(__builtin_bit_cast(bf16x8, pk), pf[1], ot[c], 0, 0, 0); }
    }
    lrun = sum_halves(lrun);
    LAS float* SM_M = (LAS float*)(L + RING_OFF);
    LAS float* SM_R = (LAS float*)(L + RING_OFF + 1024);
    LAS float* SM_O = (LAS float*)(L + RING_OFF + 1024 + 4 * 64 * 65 * 4);
    if (hi == 0) SM_M[wave * 32 + r] = mrun;
    __syncthreads();
    float mfin = SM_M[r];
#pragma unroll
    for (int w2 = 1; w2 < 8; ++w2) mfin = fmaxf(mfin, SM_M[w2 * 32 + r]);
    { const float sc = __builtin_amdgcn_exp2f(mrun - mfin); lrun *= sc;
#pragma unroll
      for (int c = 0; c < 4; ++c) ot[c] = ot[c] * sc; }
#pragma unroll
    for (int step = 4; step >= 1; step >>= 1) {
        if (wave >= step && wave < 2 * step) { LAS float* dst = SM_R + ((wave - step) * 64 + lane) * 65; dst[64] = lrun;
#pragma unroll
            for (int c = 0; c < 4; ++c)
#pragma unroll
                for (int q = 0; q < 16; ++q) dst[c * 16 + q] = ot[c][q]; }
        __syncthreads();
        if (wave < step) { const LAS float* src = SM_R + (wave * 64 + lane) * 65; lrun += src[64];
#pragma unroll
            for (int c = 0; c < 4; ++c)
#pragma unroll
                for (int q = 0; q < 16; ++q) ot[c][q] += src[c * 16 + q]; }
        __syncthreads();
    }
    if (wave == 0) { const float il = 1.f / lrun;
#pragma unroll
        for (int c = 0; c < 4; ++c)
#pragma unroll
            for (int q = 0; q < 16; ++q) SM_O[r * 129 + 32 * c + crow16(q, hi)] = ot[c][q] * il; }
    __syncthreads();
    {
        const float* LAM = (const float*)(P.ws + WS_LAM); const float lam = LAM[layer], li = LAM[4 + layer];
        const int q = tid >> 5, vd0 = (tid & 31) * 4;
        float a[4]; float ss = 0.f;
#pragma unroll
        for (int k = 0; k < 4; ++k) { a[k] = SM_O[q * 129 + vd0 + k] - lam * SM_O[(q + 16) * 129 + vd0 + k]; ss += a[k] * a[k]; }
        ss += xor_swz<1>(ss); ss += xor_swz<2>(ss); ss += xor_swz<4>(ss); ss += xor_swz<8>(ss); ss += xor_swz<16>(ss);
        const float rr = (1.f - li) / sqrtf(ss * (1.f / 128.f) + RMS_EPS);
        const size_t base = (size_t)(MP + b * 16 + q) * 1024 + h * 128 + vd0;
        const f32x4 sl = *(const f32x4*)(P.in[I_SUBLN] + (size_t)layer * 128 + vd0);
        const u32x2 gt = *(const u32x2*)((const bf16_t*)(P.ws + WS_SAG) + base);
        u32x2 o; o.x = pkbf(a[0] * rr * sl[0] * bflo(gt.x), a[1] * rr * sl[1] * bfhi(gt.x)); o.y = pkbf(a[2] * rr * sl[2] * bflo(gt.y), a[3] * rr * sl[3] * bfhi(gt.y));
        *(u32x2*)((bf16_t*)(P.ws + WS_YAB) + (size_t)(MP + b * 16 + q) * 1536 + 512 + h * 128 + vd0) = o;
    }
    __syncthreads();
}


template <int NC, int MIDK, class FM>
__device__ __forceinline__ void sg_tile(const bf16_t* Xa, int lda, int row0, const bf16_t* Wt, int ldw, int c0, int K, int r, int hi, f32x16 (&acc)[NC], FM&& mid) {
    const bf16_t* xp = Xa + (size_t)(row0 + r) * lda + 8 * hi;
    const bf16_t* wp = Wt + (size_t)(c0 + r) * ldw + 8 * hi;
#pragma unroll
    for (int j = 0; j < NC; ++j) acc[j] = f32x16{};
    for (int k0 = 0; k0 < K; k0 += 128) {
        if (MIDK > 0 && k0 == MIDK) mid(acc);
        bf16x8 xb[8], wb[NC][8];
#pragma unroll
        for (int s8 = 0; s8 < 8; ++s8) xb[s8] = *(const bf16x8*)(xp + k0 + 16 * s8);
#pragma unroll
        for (int j = 0; j < NC; ++j)
#pragma unroll
            for (int s8 = 0; s8 < 8; ++s8) wb[j][s8] = *(const bf16x8*)(wp + (size_t)(32 * j) * ldw + k0 + 16 * s8);
#pragma unroll
        for (int s8 = 0; s8 < 8; ++s8)
#pragma unroll
            for (int j = 0; j < NC; ++j) acc[j] = __builtin_amdgcn_mfma_f32_32x32x16_bf16(wb[j][s8], xb[s8], acc[j], 0, 0, 0);
    }
}
__device__ __forceinline__ void sg_epi_in(const f32x16& a, int row, int v0, int hi, int layer, const Params& P, unsigned char* ws) {
    const int pn = v0 >> 8, bj = (v0 >> 7) & 1, wc = (v0 >> 5) & 3, rs_ = row - MP, jf = rs_ & 15;
    float* out = P.out;
    if (pn >= 4 && pn < 12) {
        const bool isk = pn >= 8; bf16_t* dstb = (bf16_t*)(ws + (isk ? WS_KB : WS_QB)); const float sc = isk ? 1.f : C2;
        const int pos = PAST + jf;
        float* ko = out + O_KS + ((size_t)layer * MS + rs_) * 1024;
#pragma unroll
        for (int q = 0; q < 2; ++q) {
            const int i0 = 16 * (wc & 1) + 4 * (2 * q + hi), col = (pn - (isk ? 8 : 4)) * 256 + bj * 128 + 64 * (wc >> 1) + i0;
            const f32x4 c = *(const f32x4*)((const float*)(ws + WS_ROPEC) + pos * 32 + i0), s = *(const f32x4*)((const float*)(ws + WS_ROPES) + pos * 32 + i0);
            const f32x4 x1 = {a[4 * q], a[4 * q + 1], a[4 * q + 2], a[4 * q + 3]}, x2 = {a[4 * q + 8], a[4 * q + 9], a[4 * q + 10], a[4 * q + 11]};
            const f32x4 r1 = x1 * c - x2 * s, r2 = x2 * c + x1 * s;
            if (isk) { *(f32x4*)(ko + col) = r1; *(f32x4*)(ko + col + 32) = r2; }
            u32x2 w1, w2; w1.x = pkbf(r1[0] * sc, r1[1] * sc); w1.y = pkbf(r1[2] * sc, r1[3] * sc); w2.x = pkbf(r2[0] * sc, r2[1] * sc); w2.y = pkbf(r2[2] * sc, r2[3] * sc);
            *(u32x2*)(dstb + (size_t)row * 1024 + col) = w1; *(u32x2*)(dstb + (size_t)row * 1024 + col + 32) = w2;
        }
    } else {
        int mode, ld, cb; bf16_t* dst;
        if (pn < 2) { dst = (bf16_t*)(ws + WS_PXB); ld = 512; cb = pn * 256; mode = 0; }
        else if (pn < 4) { dst = (bf16_t*)(ws + WS_SPG); ld = 512; cb = (pn - 2) * 256; mode = 1; }
        else if (pn < 16) { dst = (bf16_t*)(ws + WS_VB); ld = 1024; cb = (pn - 12) * 256; mode = 0; }
        else if (pn < 20) { dst = (bf16_t*)(ws + WS_SAG); ld = 1024; cb = (pn - 16) * 256; mode = 1; }
        else if (pn < 24) { dst = (bf16_t*)(ws + WS_SGA); ld = 1024; cb = (pn - 20) * 256; mode = 2; }
        else { dst = (bf16_t*)(ws + WS_SGB); ld = 1024; cb = (pn - 24) * 256; mode = 3; }
        cb += bj * 128 + 32 * wc;
        float* fo = nullptr;
        if (pn >= 12 && pn < 16) fo = out + O_VS + ((size_t)layer * MS + rs_) * 1024;
        else if (pn < 2 && jf >= 1) fo = out + O_PS + (((size_t)layer * DEC_BATCH + (rs_ >> 4)) * 15 + (jf - 1)) * 512;
#pragma unroll
        for (int q = 0; q < 4; ++q) {
            const int col = cb + 8 * (2 * (q & 1) + hi) + 4 * (q >> 1);
            f32x4 v = {a[4 * q], a[4 * q + 1], a[4 * q + 2], a[4 * q + 3]};
            if (fo) *(f32x4*)(fo + col) = v;
            if (mode == 1) {
#pragma unroll
                for (int k = 0; k < 4; ++k) v[k] = v[k] * sigm(v[k]);
            } else if (mode == 2) {
#pragma unroll
                for (int k = 0; k < 4; ++k) v[k] = sigm(v[k]);
            } else if (mode == 3) {
                f32x4 e;
#pragma unroll
                for (int k = 0; k < 4; ++k) { e[k] = 1.f + __builtin_amdgcn_exp2f(-1.4426950408889634f * v[k]); v[k] = __builtin_amdgcn_rcpf(e[k]); }
                u32x2 w2; w2.x = pkbf(e[0], e[1]); w2.y = pkbf(e[2], e[3]); *(u32x2*)((bf16_t*)(ws + WS_RSB) + (size_t)row * ld + col) = w2;
            }
            u32x2 w; w.x = pkbf(v[0], v[1]); w.y = pkbf(v[2], v[3]); *(u32x2*)(dst + (size_t)row * ld + col) = w;
        }
    }
}
__device__ __forceinline__ void sg_inproj(int layer, const Params& P, unsigned char* ws, int gw, int NGW) {
    const int lane = fresh_tid(0), r = lane & 31, hi = lane >> 5;
    for (int it = gw; it < (MS / 32) * (D_IN / 64); it += NGW) {
        const int rb = it % (MS / 32), cb = it / (MS / 32);
        f32x16 acc[2];
        sg_tile<2, 0>((const bf16_t*)(ws + WS_XB), 1024, MP + rb * 32, (const bf16_t*)(ws + WS_WIN) + (size_t)layer * D_IN * 1024, 1024, cb * 64, 1024, r, hi, acc, [](f32x16 (&)[2]) {});
        sg_epi_in(acc[0], MP + rb * 32 + r, cb * 64, hi, layer, P, ws);
        sg_epi_in(acc[1], MP + rb * 32 + r, cb * 64 + 32, hi, layer, P, ws);
    }
}
__device__ __forceinline__ void sg_merge(int layer, unsigned char* ws, int gw, int NGW) {
    const int lane = fresh_tid(0), r = lane & 31, hi = lane >> 5;
    for (int it = gw; it < (MS / 32) * 32; it += NGW) {
        const int rb = it % (MS / 32), c0 = (it / (MS / 32)) * 32, row = MP + rb * 32 + r;
        const size_t ro = (size_t)row * 1024 + c0 + 4 * hi;
        f32x16 acc[1];
        sg_tile<1, 512>((const bf16_t*)(ws + WS_YAB), 1536, MP + rb * 32, (const bf16_t*)(ws + WS_WAB) + (size_t)layer * 1024 * 1536, 1536, c0, 1536, r, hi, acc,
            [&](f32x16 (&a)[1]) {
#pragma unroll
                for (int q = 0; q < 4; ++q) { const u32x2 g = *(const u32x2*)((const bf16_t*)(ws + WS_SGA) + ro + 8 * q), rr = *(const u32x2*)((const bf16_t*)(ws + WS_RSB) + ro + 8 * q);
                    a[0][4 * q] *= bflo(g.x) * bflo(rr.x); a[0][4 * q + 1] *= bfhi(g.x) * bfhi(rr.x); a[0][4 * q + 2] *= bflo(g.y) * bflo(rr.y); a[0][4 * q + 3] *= bfhi(g.y) * bfhi(rr.y); } });
#pragma unroll
        for (int q = 0; q < 4; ++q) { const u32x2 g = *(const u32x2*)((const bf16_t*)(ws + WS_SGB) + ro + 8 * q);
            u32x2 w; w.x = pkbf(acc[0][4 * q] * bflo(g.x), acc[0][4 * q + 1] * bfhi(g.x)); w.y = pkbf(acc[0][4 * q + 2] * bflo(g.y), acc[0][4 * q + 3] * bfhi(g.y));
            *(u32x2*)((bf16_t*)(ws + WS_MG) + ro + 8 * q) = w; }
    }
}
__device__ __forceinline__ void sg_out(int layer, unsigned char* ws, int gw, int NGW) {
    const int lane = fresh_tid(0), r = lane & 31, hi = lane >> 5;
    for (int it = gw; it < (MS / 32) * 32; it += NGW) {
        const int rb = it % (MS / 32), c0 = (it / (MS / 32)) * 32, row = MP + rb * 32 + r;
        f32x16 acc[1];
        sg_tile<1, 0>((const bf16_t*)(ws + WS_MG), 1024, MP + rb * 32, (const bf16_t*)(ws + WS_WO) + (size_t)layer * 1024 * 1024, 1024, c0, 1024, r, hi, acc, [](f32x16 (&)[1]) {});
        float* xr = (float*)(ws + WS_X) + (size_t)row * 1024 + c0 + 4 * hi;
#pragma unroll
        for (int q = 0; q < 4; ++q) { const f32x4 x = *(const f32x4*)(xr + 8 * q); const f32x4 a = {acc[0][4 * q], acc[0][4 * q + 1], acc[0][4 * q + 2], acc[0][4 * q + 3]}; *(f32x4*)(xr + 8 * q) = x * ALPHA + a; }
    }
}

__global__ void __launch_bounds__(NWAVES * 64, 2) mk_fwd(Params P) {
    extern __shared__ __attribute__((aligned(16))) unsigned char lds[];
    LAS unsigned char* L = (LAS unsigned char*)lds;
    const int wave = __builtin_amdgcn_readfirstlane(threadIdx.x >> 6);
    const int G = gridDim.x, bx = blockIdx.x, vcu = (G % 8 == 0) ? (bx % 8) * (G / 8) + bx / 8 : bx;
    const int gw = vcu * NWAVES + wave, NGW = G * NWAVES;
    for (int u = fresh_tid(wave); u < (LDS_BYTES - LDSCTL_OFF) / 4; u += NWAVES * 64) ((LAS unsigned*)(L + LDSCTL_OFF))[u] = 0u;
    __syncthreads();
    unsigned char* const ws0 = P.ws; unsigned char* ws = ws0;
    XcdBarrier bar = xcd_barrier_post((unsigned*)(ws + WS_CTL) + CW_BAR + P.bar_region * XCD_BAR_WORDS, (volatile LAS unsigned*)(L + MISC_OFF) + 8);
#define WinT ((bf16_t*)(ws + WS_WIN))
#define WabT ((bf16_t*)(ws + WS_WAB))
#define WoT ((bf16_t*)(ws + WS_WO))
#define WpT ((bf16_t*)(ws + WS_WP))
#define X ((float*)(ws + WS_X))
#define XB ((bf16_t*)(ws + WS_XB))
#define ropec ((float*)(ws + WS_ROPEC))
#define ropes ((float*)(ws + WS_ROPES))

#if defined(STAMP_A)
#define STAMP(k) do { if (l == 1 && bx == 0 && wave == 0) { if (fresh_tid(0) == 0) ((volatile LAS unsigned*)(L + MISC_OFF))[16 + (k)] = (unsigned)__builtin_amdgcn_s_memrealtime(); } } while (0)
#else
#define STAMP(k) do {} while (0)
#endif
#ifndef NO_P0
    if (P.do_pro) for (int rp_ = 0; rp_ < REP_P0; ++rp_) {
        const int tid = fresh_tid(wave), lane = tid & 63;
        LAS float* scr = (LAS float*)(L + RING_OFF + wave * 16384);
        constexpr int I_IN = 16 * (D_IN / 32), I_A = 8 * 32, I_B = 16 * 32, I_P = 2 * 4;
        constexpr int N_IN = DEPTH * I_IN, N_A = DEPTH * I_A, N_B = DEPTH * I_B, N_P = DEPTH * 4 * I_P;
        constexpr int NITEMS = N_IN + N_A + 2 * N_B + N_P;
        for (int it = gw; it < NITEMS; it += NGW) {
            int rr = it;
            if (rr < N_IN) { const int l = rr / I_IN; p0_transpose_item<1>(P.in[I_WIN] + (size_t)l * 1024 * D_IN, 1024, D_IN, WinT + (size_t)l * D_IN * 1024, 1024, scr, rr % I_IN, lane); continue; } rr -= N_IN;
            if (rr < N_A) { const int l = rr / I_A; p0_transpose_item<0>(P.in[I_WA] + (size_t)l * 512 * 1024, 512, 1024, WabT + (size_t)l * 1024 * 1536, 1536, scr, rr % I_A, lane); continue; } rr -= N_A;
            if (rr < N_B) { const int l = rr / I_B; p0_transpose_item<0>(P.in[I_WB] + (size_t)l * 1024 * 1024, 1024, 1024, WabT + (size_t)l * 1024 * 1536 + 512, 1536, scr, rr % I_B, lane); continue; } rr -= N_B;
            if (rr < N_B) { const int l = rr / I_B; p0_transpose_item<0>(P.in[I_WO] + (size_t)l * 1024 * 1024, 1024, 1024, WoT + (size_t)l * 1024 * 1024, 1024, scr, rr % I_B, lane); continue; } rr -= N_B;
            { const int lg = rr / I_P; p0_transpose_item<0>(P.in[I_WPOOL] + (size_t)lg * 128 * 128, 128, 128, WpT + (size_t)lg * 128 * 128, 128, scr, rr % I_P, lane); }
        }
        for (int e = gw * 64 + lane; e < SEQ * 32; e += NGW * 64) {
            const int pos = e >> 5, i = e & 31;
            const double inv = exp(-(double)i * (9.210340371976184 / 32.0)), ang = (double)pos * inv;
            ropec[e] = (float)cos(ang); ropes[e] = (float)sin(ang);
        }
        if (bx == 0 && tid < DEPTH) {
            const float* lq = P.in[I_LQK] + tid * 256; float s1 = 0.f, s2 = 0.f;
            for (int i = 0; i < 64; ++i) { s1 += lq[i] * lq[64 + i]; s2 += lq[128 + i] * lq[192 + i]; }
            const float li = 0.8f - 0.6f * expf(-0.3f * (float)tid);
            float* LAM = (float*)(ws + WS_LAM); LAM[tid] = expf(s1) - expf(s2) + li; LAM[4 + tid] = li;
        }
        for (int m = gw; m < M; m += NGW) {
            const float* xr = (m < MP) ? P.in[I_XP] + (size_t)m * 1024 : P.in[I_XS] + (size_t)(m - MP) * 1024;
            ln_row(xr, P.in[I_LIG], P.in[I_LIB], X + (size_t)m * 1024, XB + (size_t)m * 1024);
        }
        xcd_barrier(bar);
    }
#endif

    for (int l = P.l_lo; l < P.l_hi; ++l) {
        STAMP(0);
        { unsigned char* ws = ws0; asm volatile("" : "+s"(ws)); int bxo = bx; asm volatile("" : "+s"(bxo));
#ifndef NO_P1
        for (int rp_ = 0; rp_ < REP_P1; ++rp_) {
            if (rp_) xcd_barrier(bar);
            sg_inproj(l, P, ws, gw, NGW);
            pg8::Gemm g{XB, WinT + (size_t)l * D_IN * 1024, MP, D_IN, 1024}; pg8::StaticOrder S; S.init(MP, D_IN, G, bxo);
            EpiIn E{(bf16_t*)(ws + WS_PXB), (bf16_t*)(ws + WS_SPG), (bf16_t*)(ws + WS_QB), (bf16_t*)(ws + WS_KB), (bf16_t*)(ws + WS_VB), (bf16_t*)(ws + WS_SAG), (bf16_t*)(ws + WS_SGA), (bf16_t*)(ws + WS_SGB), (bf16_t*)(ws + WS_RSB),
                    P.out, ropec, ropes, l};
            pg8::gemm_phase<EpiIn, pg8::StaticOrder, true, true>(L + RING_OFF, g, S, E, wave);
        }
#endif
        }
        xcd_barrier(bar);
        STAMP(1);
        { unsigned char* ws = ws0; asm volatile("" : "+s"(ws)); int bxo = bx; asm volatile("" : "+s"(bxo));
#ifndef NO_SAMPLE
        for (int rp_ = 0; rp_ < REP_SAMPLE; ++rp_)
        for (int su = vcu; su < DEC_BATCH * 8; su += G) sample_unit(su >> 3, su & 7, l, P, L, wave);
#endif
        STAMP(2);
#ifndef NO_POOL
        for (int rp_ = 0; rp_ < REP_POOL; ++rp_)
        for (int it = gw; it < POOL_NITEMS; it += NGW) pool_item(it, l, P, L + RING_OFF + wave * POOL_TILE_BYTES);
        __syncthreads();
#endif
        STAMP(3);
#ifndef NO_ATTN
        for (int rp_ = 0; rp_ < REP_ATTN; ++rp_)
        for (int su = vcu; su < 256; su += G) {
            const int bh = su >> 2, s4 = su & 3, b = bh >> 3, h = bh & 7;
            const size_t bo = (size_t)b * SEQ * 1024 + h * 128;
            for (int i = 0; i < 4; ++i) {
                const int qb = (i == 0) ? s4 : (i == 1) ? 7 - s4 : (i == 2) ? 8 + s4 : 15 - s4;
                for (int mp = 0; mp < 2; ++mp)
                    attn_body::attn_unit128<8>(qb, (const attn_body::bf16*)(ws + WS_QB) + bo + mp * 64, (const attn_body::bf16*)(ws + WS_KB) + bo + mp * 64,
                                               (const attn_body::bf16*)(ws + WS_VB) + bo, (float*)(ws + (mp ? WS_O2 : WS_O1)) + bo, (char*)lds + RING_OFF, wave);
                asm volatile("s_waitcnt vmcnt(0)" ::: "memory"); __syncthreads();
                combine_rows((size_t)b * SEQ + (size_t)qb * 256, h, l, P, wave);
            }
        }
#endif
        }
        STAMP(4);
        xcd_barrier(bar);
        STAMP(5);
        { unsigned char* ws = ws0; asm volatile("" : "+s"(ws)); int bxo = bx; asm volatile("" : "+s"(bxo));
#ifndef NO_P3
        for (int rp_ = 0; rp_ < REP_P3; ++rp_) {
        if (rp_) xcd_barrier(bar);
        {
            sg_merge(l, ws, gw, NGW);
            pg8::Gemm g{(const bf16_t*)(ws + WS_YAB), WabT + (size_t)l * 1024 * 1536, MP, 1024, 1536}; pg8::StaticOrder S; S.init(MP, 1024, G, bxo);
            EpiMerge E{(const bf16_t*)(ws + WS_SGA), (const bf16_t*)(ws + WS_SGB), (const bf16_t*)(ws + WS_RSB), (bf16_t*)(ws + WS_MG)};
            pg8::gemm_phase<EpiMerge, pg8::StaticOrder, true, true>(L + RING_OFF, g, S, E, wave);
        }
        }
#endif
        }
        STAMP(6);
        xcd_barrier(bar);
        STAMP(7);
        { unsigned char* ws = ws0; asm volatile("" : "+s"(ws)); int bxo = bx; asm volatile("" : "+s"(bxo));
#ifndef NO_P4
        {
            sg_out(l, ws, gw, NGW);
            pg8::Gemm g{(const bf16_t*)(ws + WS_MG), WoT + (size_t)l * 1024 * 1024, MP, 1024, 1024}; pg8::StaticOrder S; S.init(MP, 1024, G, bxo);
            EpiOut E{X};
            pg8::gemm_phase<EpiOut, pg8::StaticOrder, true, true>(L + RING_OFF, g, S, E, wave);
        }
#endif
        }
        STAMP(8);
        xcd_barrier(bar);
        STAMP(9);
        { unsigned char* ws = ws0; asm volatile("" : "+s"(ws)); int bxo = bx; asm volatile("" : "+s"(bxo));
        {
            float* dst = (l == DEPTH - 1) ? P.out + O_Y : X;
            for (int m = gw; m < M; m += NGW) ln_row(X + (size_t)m * 1024, P.in[I_LNG] + (size_t)l * 1024, P.in[I_LNB] + (size_t)l * 1024, dst + (size_t)m * 1024, XB + (size_t)m * 1024);
        }
        }
        STAMP(10);
        if (l + 1 < P.l_hi) xcd_barrier(bar);
        STAMP(11);
    }
#if defined(STAMP_A)
    xcd_barrier(bar);
    if (bx == 0) {
        volatile LAS unsigned* st = (volatile LAS unsigned*)(L + MISC_OFF) + 16;
        __syncthreads();
        const float da = (float)(st[STAMP_A1] - st[STAMP_A]) * 0.01f;
        const float db = (float)(st[STAMP_B1] - st[STAMP_B0]) * 0.01f;
        const float sc = 1.05f + da * 1e-4f;
        float* ps = P.out + O_PS;
        for (int i = fresh_tid(wave); i < DEPTH * DEC_BATCH * 15 * 512; i += NWAVES * 64) ps[i] *= sc;
        if (fresh_tid(wave) == 0) P.out[O_Y + (size_t)MP * 1024] += db * 0.01f + 1.0f;
    }
#endif
}
static int mk_grid_setup() {
    static int grid = 0;
    if (grid == 0) {
        int dev = 0, cus = 0;
        if (hipGetDevice(&dev) != hipSuccess || hipDeviceGetAttribute(&cus, hipDeviceAttributeMultiprocessorCount, dev) != hipSuccess || cus < 8) { fprintf(stderr, "kernel_launch: device query failed\n"); grid = -1; return grid; }
        if (hipFuncSetAttribute((const void*)mk_fwd, hipFuncAttributeMaxDynamicSharedMemorySize, LDS_BYTES) != hipSuccess) { fprintf(stderr, "kernel_launch: hipFuncSetAttribute failed\n"); grid = -1; return grid; }
        int per_cu = 0;
        if (hipOccupancyMaxActiveBlocksPerMultiprocessor(&per_cu, (const void*)mk_fwd, NWAVES * 64, LDS_BYTES) != hipSuccess || per_cu < 1) fprintf(stderr, "kernel_launch: occupancy query reports %d\n", per_cu);
        (void)hipGetLastError();
        grid = cus;
    }
    return grid;
}
static void mk_launch(void* const* d_in, float* out, void* d_ws, int l_lo, int l_hi, int do_pro, int region, hipStream_t stream) {
    const int grid = mk_grid_setup(); if (grid < 0) return;
    Params p{};
    for (int i = 0; i < 17; ++i) p.in[i] = (const float*)d_in[i];
    p.out = out; p.ws = (unsigned char*)d_ws; p.l_lo = l_lo; p.l_hi = l_hi; p.do_pro = do_pro; p.bar_region = region;
    hipLaunchKernelGGL(mk_fwd, dim3(grid), dim3(NWAVES * 64), LDS_BYTES, stream, p);
    const hipError_t le = hipPeekAtLastError();
    if (le != hipSuccess) fprintf(stderr, "kernel_launch: launch failed: %s\n", hipGetErrorName(le));
}

#if !DEBUG_CHECK
extern "C" void kernel_launch(void* const* d_in, const int* in_sizes, int n_in, void* d_out, int out_size, void* d_ws, size_t ws_size, hipStream_t stream) {
    if (n_in != 17 || (size_t)out_size != O_END || ws_size < WS_END || in_sizes[0] != MP * 1024) { fprintf(stderr, "kernel_launch: unexpected sizes n_in %d out %d ws %zu\n", n_in, out_size, ws_size); return; }
    if (hipMemsetAsync((char*)d_ws + WS_CTL, 0, CTL_ZERO_BYTES, stream) != hipSuccess) return;
    mk_launch(d_in, (float*)d_out, d_ws, 0, DEPTH, 1, 0, stream);
}
#else
constexpr int C_PX = 0, C_PG = 512, C_Q = 1024, C_K = 2048, C_V = 3072, C_AG = 4096, C_GA = 5120, C_GB = 6144;
__device__ __forceinline__ float silu_f(float x) { return x / (1.f + __expf(-x)); }
__device__ __forceinline__ float sigmoid_f(float x) { return 1.f / (1.f + __expf(-x)); }
__global__ void __launch_bounds__(256) nv_ln(const float* in, const float* add, float alpha, const float* g, const float* b, float* out, int rows) {
    const int row = blockIdx.x * 4 + (threadIdx.x >> 6), lane = threadIdx.x & 63;
    if (row >= rows) return;
    const float4* xi = (const float4*)(in + (size_t)row * 1024) + lane;
    float4 v[4]; float s = 0.f;
#pragma unroll
    for (int j = 0; j < 4; ++j) {
        v[j] = xi[64 * j];
        if (add) { const float4 a = ((const float4*)(add + (size_t)row * 1024) + lane)[64 * j]; v[j].x = alpha * v[j].x + a.x; v[j].y = alpha * v[j].y + a.y; v[j].z = alpha * v[j].z + a.z; v[j].w = alpha * v[j].w + a.w; }
        s += (v[j].x + v[j].y) + (v[j].z + v[j].w);
    }
    const float mean = wave_sum(s) * (1.f / 1024.f); float s2 = 0.f;
#pragma unroll
    for (int j = 0; j < 4; ++j) { v[j].x -= mean; v[j].y -= mean; v[j].z -= mean; v[j].w -= mean; s2 += (v[j].x * v[j].x + v[j].y * v[j].y) + (v[j].z * v[j].z + v[j].w * v[j].w); }
    const float rstd = 1.f / sqrtf(wave_sum(s2) * (1.f / 1024.f) + LN_EPS);
    float4* o = (float4*)(out + (size_t)row * 1024) + lane;
#pragma unroll
    for (int j = 0; j < 4; ++j) { const float4 gg = ((const float4*)g + lane)[64 * j], bb = ((const float4*)b + lane)[64 * j];
        float4 r; r.x = v[j].x * rstd * gg.x + bb.x; r.y = v[j].y * rstd * gg.y + bb.y; r.z = v[j].z * rstd * gg.z + bb.z; r.w = v[j].w * rstd * gg.w + bb.w; o[64 * j] = r; }
}
__global__ void __launch_bounds__(256) nv_gemm(const float* __restrict__ A, int lda, const float* __restrict__ W, int ldw, float* __restrict__ C, int ldc, int K) {
    __shared__ float As[8][132];
    __shared__ float Ws[8][128];
    const int bm = blockIdx.y * 128, bn = blockIdx.x * 128, tid = threadIdx.x, tx = tid & 15, ty = tid >> 4;
    float acc[8][8];
#pragma unroll
    for (int i = 0; i < 8; ++i)
#pragma unroll
        for (int j = 0; j < 8; ++j) acc[i][j] = 0.f;
    const float* Ap = A + (size_t)(bm + (tid >> 1)) * lda + (tid & 1) * 4;
    const float* Wp = W + (size_t)(tid >> 5) * ldw + bn + (tid & 31) * 4;
    for (int k0 = 0; k0 < K; k0 += 8) {
        const float4 a = *(const float4*)(Ap + k0);
        const float4 w = *(const float4*)(Wp + (size_t)k0 * ldw);
        As[(tid & 1) * 4 + 0][tid >> 1] = a.x; As[(tid & 1) * 4 + 1][tid >> 1] = a.y; As[(tid & 1) * 4 + 2][tid >> 1] = a.z; As[(tid & 1) * 4 + 3][tid >> 1] = a.w;
        *(float4*)&Ws[tid >> 5][(tid & 31) * 4] = w;
        __syncthreads();
#pragma unroll
        for (int kk = 0; kk < 8; ++kk) {
            float av[8], bv[8];
#pragma unroll
            for (int i = 0; i < 8; ++i) av[i] = As[kk][ty * 8 + i];
#pragma unroll
            for (int j = 0; j < 8; ++j) bv[j] = Ws[kk][tx * 8 + j];
#pragma unroll
            for (int i = 0; i < 8; ++i)
#pragma unroll
                for (int j = 0; j < 8; ++j) acc[i][j] += av[i] * bv[j];
        }
        __syncthreads();
    }
#pragma unroll
    for (int i = 0; i < 8; ++i) {
        float* cp = C + (size_t)(bm + ty * 8 + i) * ldc + bn + tx * 8;
        *(float4*)cp = make_float4(acc[i][0], acc[i][1], acc[i][2], acc[i][3]);
        *(float4*)(cp + 4) = make_float4(acc[i][4], acc[i][5], acc[i][6], acc[i][7]);
    }
}
__global__ void nv_lambda(const float* lq, float* lam) {
    const int l = threadIdx.x;
    if (l < DEPTH) {
        float s1 = 0.f, s2 = 0.f;
        for (int i = 0; i < 64; ++i) { s1 += lq[l * 256 + i] * lq[l * 256 + 64 + i]; s2 += lq[l * 256 + 128 + i] * lq[l * 256 + 192 + i]; }
        const float li = 0.8f - 0.6f * expf(-0.3f * (float)l);
        lam[l] = expf(s1) - expf(s2) + li; lam[4 + l] = li;
    }
}
__global__ void __launch_bounds__(256) nv_rope_split(float* H, float* out, int layer) {
    const int row = blockIdx.x;
    const bool samp = row >= MP;
    const int pos = samp ? PAST + ((row - MP) & 15) : (row & (SEQ - 1));
    float* h = H + (size_t)row * D_IN;
    float* ko = samp ? out + O_KS + ((size_t)layer * MS + (row - MP)) * 1024 : out + O_KP + ((size_t)layer * MP + row) * 1024;
    float* vo = samp ? out + O_VS + ((size_t)layer * MS + (row - MP)) * 1024 : out + O_VP + ((size_t)layer * MP + row) * 1024;
    for (int p = threadIdx.x; p < 1024; p += 256) {
        const int pp = p & 511, blk = pp >> 5, i = pp & 31;
        const int c = (p < 512 ? C_Q : C_K) + blk * 64 + i;
        const double inv = exp(-(double)i / 32.0 * 9.210340371976184);
        const double ang = (double)pos * inv;
        const float cs = (float)cos(ang), sn = (float)sin(ang);
        const float x1 = h[c], x2 = h[c + 32];
        const float r1 = x1 * cs - x2 * sn, r2 = x2 * cs + x1 * sn;
        h[c] = r1; h[c + 32] = r2;
        if (p >= 512) { ko[blk * 64 + i] = r1; ko[blk * 64 + i + 32] = r2; }
    }
    for (int c = threadIdx.x; c < 1024; c += 256) vo[c] = h[C_V + c];
    if (!samp) { const int t = row & (SEQ - 1), b = row >> 12;
        if (t >= SEQ - 15) { float* po = out + O_PP + (((size_t)layer * BATCH + b) * 15 + (t - (SEQ - 15))) * 512; for (int c = threadIdx.x; c < 512; c += 256) po[c] = h[C_PX + c]; }
    } else { const int j = (row - MP) & 15, b = (row - MP) >> 4;
        if (j >= 1) { float* po = out + O_PS + (((size_t)layer * DEC_BATCH + b) * 15 + (j - 1)) * 512; for (int c = threadIdx.x; c < 512; c += 256) po[c] = h[C_PX + c]; }
    }
}
__global__ void __launch_bounds__(256) nv_pool(const float* H, const float* state_pool_l, float* pooled) {
    const int row = blockIdx.x;
    const bool samp = row >= MP;
    for (int c = threadIdx.x; c < 512; c += 256) {
        const int g = c >> 7, w = 2 << g;
        float s = 0.f; int cnt;
        if (!samp) { const int t = row & (SEQ - 1); cnt = (t + 1 < w) ? t + 1 : w;
            for (int d = 0; d < cnt; ++d) s += H[(size_t)(row - d) * D_IN + C_PX + c];
        } else { const int j = (row - MP) & 15, b = (row - MP) >> 4; cnt = w;
            for (int d = 0; d < w; ++d) { const int jj = j - d;
                s += (jj >= 0) ? H[(size_t)(row - d) * D_IN + C_PX + c] : state_pool_l[((size_t)b * 15 + (15 + jj)) * 512 + c]; }
        }
        pooled[(size_t)row * 512 + c] = s / (float)cnt - H[(size_t)row * D_IN + C_PX + c];
    }
}
__global__ void __launch_bounds__(256) nv_ya_gate(float* ya, const float* H, const float* pool_scale_l) {
    const int row = blockIdx.x;
    for (int c = threadIdx.x; c < 512; c += 256) ya[(size_t)row * 512 + c] *= pool_scale_l[c] * silu_f(H[(size_t)row * D_IN + C_PG + c]);
}
__global__ void __launch_bounds__(64) nv_attn(const float* __restrict__ H, int rowbase0, int rows_per_batch, int nq,
                                             const float* __restrict__ cK, const float* __restrict__ cV, int n1, int causal, float* O1, float* O2) {
    __shared__ float Ks[16][64];
    __shared__ float Vs[16][128];
    const int qb = blockIdx.x, hm = blockIdx.y, b = blockIdx.z, h = hm >> 1, mp = hm & 1, t = threadIdx.x;
    const int rowb = rowbase0 + b * rows_per_batch;
    const int qrow = rowb + qb * 64 + t;
    const bool act = t < nq;
    float q[64];
#pragma unroll
    for (int d = 0; d < 64; ++d) q[d] = act ? H[(size_t)qrow * D_IN + C_Q + h * 128 + mp * 64 + d] * 0.125f : 0.f;
    float o[128];
#pragma unroll
    for (int d = 0; d < 128; ++d) o[d] = 0.f;
    float mx = -INFINITY, l = 0.f;
    const int n2 = causal ? (qb + 1) * 64 : rows_per_batch;
    const int ntot = n1 + n2;
    for (int k0 = 0; k0 < ntot; k0 += 16) {
        __syncthreads();
#pragma unroll
        for (int i = 0; i < 16; ++i) { const int idx = i * 64 + t, kj = idx >> 6, d = idx & 63, key = k0 + kj;
            float v = 0.f;
            if (key < ntot) v = (key < n1) ? cK[((size_t)b * n1 + key) * 1024 + h * 128 + mp * 64 + d] : H[(size_t)(rowb + key - n1) * D_IN + C_K + h * 128 + mp * 64 + d];
            Ks[kj][d] = v; }
#pragma unroll
        for (int i = 0; i < 32; ++i) { const int idx = i * 64 + t, kj = idx >> 7, d = idx & 127, key = k0 + kj;
            float v = 0.f;
            if (key < ntot) v = (key < n1) ? cV[((size_t)b * n1 + key) * 1024 + h * 128 + d] : H[(size_t)(rowb + key - n1) * D_IN + C_V + h * 128 + d];
            Vs[kj][d] = v; }
        __syncthreads();
        const int kend = (ntot - k0 < 16) ? ntot - k0 : 16;
        for (int kj = 0; kj < kend; ++kj) {
            float s = 0.f;
#pragma unroll
            for (int d = 0; d < 64; ++d) s += q[d] * Ks[kj][d];
            const float mn = fmaxf(mx, s), f = __expf(mx - mn), p = __expf(s - mn);
            l = l * f + p; mx = mn;
#pragma unroll
            for (int d = 0; d < 128; ++d) o[d] = o[d] * f + p * Vs[kj][d];
        }
    }
    if (act) { float* O = (mp ? O2 : O1) + (size_t)qrow * 1024 + h * 128; const float il = 1.f / l;
#pragma unroll
        for (int d = 0; d < 128; d += 4) *(float4*)(O + d) = make_float4(o[d] * il, o[d + 1] * il, o[d + 2] * il, o[d + 3] * il); }
}
__global__ void __launch_bounds__(256) nv_combine(const float* O1, const float* O2, const float* lam, int layer, const float* subln_l, const float* H, float* YB) {
    const int idx = blockIdx.x * 4 + (threadIdx.x >> 6), lane = threadIdx.x & 63;
    const int row = idx >> 3, h = idx & 7;
    const float lm = lam[layer], li = lam[4 + layer];
    const size_t base = (size_t)row * 1024 + h * 128;
    const float a0 = O1[base + lane] - lm * O2[base + lane], a1 = O1[base + 64 + lane] - lm * O2[base + 64 + lane];
    const float ms = wave_sum(a0 * a0 + a1 * a1) * (1.f / 128.f);
    const float r = 1.f / sqrtf(ms + RMS_EPS) * (1.f - li);
    YB[base + lane] = a0 * r * subln_l[lane] * silu_f(H[(size_t)row * D_IN + C_AG + h * 128 + lane]);
    YB[base + 64 + lane] = a1 * r * subln_l[64 + lane] * silu_f(H[(size_t)row * D_IN + C_AG + h * 128 + 64 + lane]);
}
__global__ void __launch_bounds__(256) nv_merge(float* TA, const float* TB, const float* H) {
    const int row = blockIdx.x;
    for (int c = threadIdx.x; c < 1024; c += 256) { const size_t i = (size_t)row * 1024 + c;
        TA[i] = sigmoid_f(H[(size_t)row * D_IN + C_GA + c]) * TA[i] + sigmoid_f(H[(size_t)row * D_IN + C_GB + c]) * TB[i]; }
}
__global__ void __launch_bounds__(256) dbg_cmp(const void* a, int a_bf16, int lda, const float* b, int ldb, int rows, int cols, float ascale, int bact, float* err, int slot) {
    __shared__ float red[2][4];
    float num = 0.f, den = 0.f;
    const size_t n = (size_t)rows * cols;
    for (size_t i = (size_t)blockIdx.x * 256 + threadIdx.x; i < n; i += (size_t)gridDim.x * 256) {
        const size_t r = i / cols, c = i % cols;
        float av = a_bf16 ? __uint_as_float((unsigned)((const unsigned short*)a)[r * lda + c] << 16) : ((const float*)a)[r * lda + c];
        float bv = b[r * ldb + c];
        if (bact == 1) bv = silu_f(bv); else if (bact == 2) bv = sigmoid_f(bv);
        const float d = av * ascale - bv; num += d * d; den += bv * bv;
    }
    num = wave_sum(num); den = wave_sum(den);
    if ((threadIdx.x & 63) == 0) { red[0][threadIdx.x >> 6] = num; red[1][threadIdx.x >> 6] = den; }
    __syncthreads();
    if (threadIdx.x == 0) { atomicAdd(err + 2 * slot, red[0][0] + red[0][1] + red[0][2] + red[0][3]); atomicAdd(err + 2 * slot + 1, red[1][0] + red[1][1] + red[1][2] + red[1][3]); }
}
#ifndef DBG_SLOT
#define DBG_SLOT -1
#endif
__global__ void dbg_final(const float* err, int nslots, float tol, float* pool_sample, int n) {
    __shared__ float sc;
    if (threadIdx.x == 0) {
        float s = 1.f;
        if (DBG_SLOT >= 0) { const float e = err[2 * DBG_SLOT] / fmaxf(err[2 * DBG_SLOT + 1], 1e-30f); s = 1.f + sqrtf(fminf(e, 4.f)); }
        else { for (int i = 0; i < nslots; ++i) { const float e = err[2 * i] / fmaxf(err[2 * i + 1], 1e-30f); if (!(e <= tol)) { s = 1.f + 0.01f * (float)(i + 1); break; } } }
        sc = s;
    }
    __syncthreads();
    for (int i = blockIdx.x * 256 + threadIdx.x; i < n; i += gridDim.x * 256) pool_sample[i] *= sc;
}
#define NSLOT_L 24
extern "C" void kernel_launch(void* const* d_in, const int* in_sizes, int n_in, void* d_out, int out_size, void* d_ws, size_t ws_size, hipStream_t stream) {
    const float* x_prompt = (const float*)d_in[0]; const float* x_sample = (const float*)d_in[1];
    const float* cache_k = (const float*)d_in[2]; const float* cache_v = (const float*)d_in[3]; const float* state_pool = (const float*)d_in[4];
    const float* ln_in_g = (const float*)d_in[5]; const float* ln_in_b = (const float*)d_in[6]; const float* w_in = (const float*)d_in[7];
    const float* w_pool = (const float*)d_in[8]; const float* pool_scale = (const float*)d_in[9]; const float* lambda_qk = (const float*)d_in[10];
    const float* subln_w = (const float*)d_in[11]; const float* w_a = (const float*)d_in[12]; const float* w_b = (const float*)d_in[13];
    const float* w_o = (const float*)d_in[14]; const float* ln_g = (const float*)d_in[15]; const float* ln_b = (const float*)d_in[16];
    float* out = (float*)d_out;
    const size_t R = RB4;
    const size_t NV0 = 1300 * MiB;
    const size_t NV_END = NV0 + 4096 + R + (size_t)M * D_IN * 4 + 7 * R;
    const size_t OUT2 = NV_END;
    const size_t need = OUT2 + O_END * 4;
    if (n_in != 17 || (size_t)out_size != O_END || ws_size < need) { fprintf(stderr, "kernel_launch: unexpected sizes n_in %d out %d ws %zu need %zu\n", n_in, out_size, ws_size, need); return; }
    unsigned char* ws = (unsigned char*)d_ws;
    hipMemsetAsync(ws + WS_CTL, 0, CTL_ZERO_BYTES, stream);
    float* ERR = (float*)(ws + WS_CTL + 512 * 1024);
    float* LAM = (float*)(ws + NV0);
    float* X = (float*)(ws + NV0 + 4096);
    float* H = (float*)(ws + NV0 + 4096 + R);
    unsigned char* p = ws + NV0 + 4096 + R + (size_t)M * D_IN * 4;
    float* POOLED = (float*)p; float* YA = (float*)(p + R / 2);
    float* O1 = (float*)(p + R); float* O2 = (float*)(p + 2 * R); float* YB = (float*)(p + 3 * R);
    float* TA = (float*)(p + 4 * R); float* TB = (float*)(p + 5 * R); float* OUTB = (float*)(p + 6 * R);
    float* out2 = (float*)(ws + OUT2);
    const void* oXB = ws + WS_XB; const void* oPXB = ws + WS_PXB; const void* oSPG = ws + WS_SPG; const void* oQB = ws + WS_QB; const void* oKB = ws + WS_KB; const void* oVB = ws + WS_VB;
    const void* oSAG = ws + WS_SAG; const void* oSGA = ws + WS_SGA; const void* oSGB = ws + WS_SGB; const void* oO1 = ws + WS_O1; const void* oO2 = ws + WS_O2;
    const void* oYA = ws + WS_YAB; const void* oYB = (const unsigned short*)(ws + WS_YAB) + 512; const void* oMG = ws + WS_MG; const void* oX = ws + WS_X;
#define CMP(slot, a, abf, lda, b, ldb, rows, cols, asc, bact) dbg_cmp<<<1024, 256, 0, stream>>>(a, abf, lda, b, ldb, rows, cols, asc, bact, ERR, slot)

    nv_lambda<<<1, 64, 0, stream>>>(lambda_qk, LAM);
    nv_ln<<<MP / 4, 256, 0, stream>>>(x_prompt, nullptr, 1.f, ln_in_g, ln_in_b, X, MP);
    nv_ln<<<MS / 4, 256, 0, stream>>>(x_sample, nullptr, 1.f, ln_in_g, ln_in_b, X + (size_t)MP * 1024, MS);
    for (int l = 0; l < DEPTH; ++l) {
        const int s0 = l * NSLOT_L;
        mk_launch(d_in, out2, d_ws, l, l + 1, l == 0, l, stream);
        nv_gemm<<<dim3(D_IN / 128, M / 128), 256, 0, stream>>>(X, 1024, w_in + (size_t)l * 1024 * D_IN, D_IN, H, D_IN, 1024);
        nv_rope_split<<<M, 256, 0, stream>>>(H, out, l);
        nv_pool<<<M, 256, 0, stream>>>(H, state_pool + (size_t)l * DEC_BATCH * 15 * 512, POOLED);
        for (int g = 0; g < 4; ++g)
            nv_gemm<<<dim3(1, M / 128), 256, 0, stream>>>(POOLED + g * 128, 512, w_pool + ((size_t)l * 4 + g) * 128 * 128, 128, YA + g * 128, 512, 128);
        nv_ya_gate<<<M, 256, 0, stream>>>(YA, H, pool_scale + (size_t)l * 512);
        nv_attn<<<dim3(SEQ / 64, 16, BATCH), 64, 0, stream>>>(H, 0, SEQ, 64, nullptr, nullptr, 0, 1, O1, O2);
        nv_attn<<<dim3(1, 16, DEC_BATCH), 64, 0, stream>>>(H, MP, DEC_SEQ, DEC_SEQ, cache_k + (size_t)l * DEC_BATCH * PAST * 1024, cache_v + (size_t)l * DEC_BATCH * PAST * 1024, PAST, 0, O1, O2);
        nv_combine<<<M * 8 / 4, 256, 0, stream>>>(O1, O2, LAM, l, subln_w + (size_t)l * 128, H, YB);
        nv_gemm<<<dim3(1024 / 128, M / 128), 256, 0, stream>>>(YA, 512, w_a + (size_t)l * 512 * 1024, 1024, TA, 1024, 512);
        nv_gemm<<<dim3(1024 / 128, M / 128), 256, 0, stream>>>(YB, 1024, w_b + (size_t)l * 1024 * 1024, 1024, TB, 1024, 1024);
        nv_merge<<<M, 256, 0, stream>>>(TA, TB, H);
        nv_gemm<<<dim3(1024 / 128, M / 128), 256, 0, stream>>>(TA, 1024, w_o + (size_t)l * 1024 * 1024, 1024, OUTB, 1024, 1024);
        nv_ln<<<M / 4, 256, 0, stream>>>(X, OUTB, ALPHA, ln_g + (size_t)l * 1024, ln_b + (size_t)l * 1024, (l == DEPTH - 1) ? out + O_Y : X, M);
        CMP(s0 + 1, oPXB, 1, 512, H + C_PX, D_IN, M, 512, 1.f, 0);
        CMP(s0 + 2, oSPG, 1, 512, H + C_PG, D_IN, M, 512, 1.f, 1);
        CMP(s0 + 3, oVB, 1, 1024, H + C_V, D_IN, M, 1024, 1.f, 0);
        CMP(s0 + 4, oSAG, 1, 1024, H + C_AG, D_IN, M, 1024, 1.f, 1);
        CMP(s0 + 5, oSGA, 1, 1024, H + C_GA, D_IN, M, 1024, 1.f, 2);
        CMP(s0 + 6, oSGB, 1, 1024, H + C_GB, D_IN, M, 1024, 1.f, 2);
        CMP(s0 + 7, oKB, 1, 1024, H + C_K, D_IN, M, 1024, 1.f, 0);
        CMP(s0 + 8, oQB, 1, 1024, H + C_Q, D_IN, M, 1024, 1.f / C2, 0);
        CMP(s0 + 9, out2 + O_KP + (size_t)l * MP * 1024, 0, 1024, out + O_KP + (size_t)l * MP * 1024, 1024, MP, 1024, 1.f, 0);
        CMP(s0 + 10, out2 + O_VP + (size_t)l * MP * 1024, 0, 1024, out + O_VP + (size_t)l * MP * 1024, 1024, MP, 1024, 1.f, 0);
        CMP(s0 + 11, out2 + O_PP + (size_t)l * BATCH * 15 * 512, 0, 512, out + O_PP + (size_t)l * BATCH * 15 * 512, 512, BATCH * 15, 512, 1.f, 0);
        CMP(s0 + 12, out2 + O_KS + (size_t)l * MS * 1024, 0, 1024, out + O_KS + (size_t)l * MS * 1024, 1024, MS, 1024, 1.f, 0);
        CMP(s0 + 13, out2 + O_VS + (size_t)l * MS * 1024, 0, 1024, out + O_VS + (size_t)l * MS * 1024, 1024, MS, 1024, 1.f, 0);
        CMP(s0 + 14, out2 + O_PS + (size_t)l * DEC_BATCH * 15 * 512, 0, 512, out + O_PS + (size_t)l * DEC_BATCH * 15 * 512, 512, DEC_BATCH * 15, 512, 1.f, 0);
        CMP(s0 + 15, oYA, 1, 1536, YA, 512, M, 512, 1.f, 0);
        CMP(s0 + 16, oO1, 0, 1024, O1, 1024, MP, 1024, 1.f, 0);
        CMP(s0 + 17, oO2, 0, 1024, O2, 1024, MP, 1024, 1.f, 0);
        CMP(s0 + 18, oYB, 1, 1536, YB, 1024, MP, 1024, 1.f, 0);
        CMP(s0 + 19, (const unsigned short*)oYB + (size_t)MP * 1536, 1, 1536, YB + (size_t)MP * 1024, 1024, MS, 1024, 1.f, 0);
        CMP(s0 + 20, oMG, 1, 1024, TA, 1024, M, 1024, 1.f, 0);
        CMP(s0 + 21, (l == DEPTH - 1) ? (const void*)(out2 + O_Y) : oX, 0, 1024, (l == DEPTH - 1) ? out + O_Y : X, 1024, M, 1024, 1.f, 0);
    }
    dbg_final<<<64, 256, 0, stream>>>(ERR, DEPTH * NSLOT_L, 1e-3f, out + O_PS, DEPTH * DEC_BATCH * 15 * 512);
}
#endif
```
